# Optimizing an MI355X kernel written in HIP

```python
import math
import jax, jax.numpy as jnp
from jax import lax
import numpy as np

D_MODEL = 1024
BATCH = 8
SEQ = 8192
DEPTH = 1

HEAD_DIM = 64
SB_HEADS = D_MODEL // 128
NSA_Q_HEADS = D_MODEL // 128
NSA_KV_GROUPS = 2
SB_W = SB_HEADS * HEAD_DIM
NSA_Q_W = NSA_Q_HEADS * HEAD_DIM
NSA_KV_W = NSA_KV_GROUPS * HEAD_DIM
N_BRANCHES = 2
IN_W = 3 * SB_W + NSA_Q_W + 6 * NSA_KV_W + 3 * NSA_Q_HEADS + N_BRANCHES * D_MODEL
Q_BLOCK = 128
CMP_BLOCK = 32
CMP_STRIDE = 16
SEL_BLOCK = 64
SEL_TOPK = 16
WINDOW = 512
ROPE_THETA = 10000.0
N_EXPERTS = 32
TOP_K = 4
D_FF = D_MODEL
SWIGLU_LIMIT = 7.0
SWIGLU_ALPHA = 1.702
MOE_CHUNK = 256
LN_EPS = 1e-5
NEG_INF = -1e30
FORCE_SCORE = 1e30
DEEPNORM_ALPHA = (2.0 * DEPTH) ** 0.25
DEEPNORM_BETA = (8.0 * DEPTH) ** -0.25

kernel_name = "hybrid_stickbreak_nsa_moe_block"


def layer_norm(x, g, b):
    xf = x.astype(jnp.float32)
    mu = xf.mean(-1, keepdims=True)
    var = jnp.square(xf - mu).mean(-1, keepdims=True)
    return ((xf - mu) * lax.rsqrt(var + LN_EPS) * g.astype(jnp.float32) + b.astype(jnp.float32)).astype(x.dtype)


def rope(x, pos):
    half = HEAD_DIM // 2
    inv_freq = ROPE_THETA ** (-jnp.arange(half, dtype=jnp.float32) / half)
    ang = pos.astype(jnp.float32)[:, None] * inv_freq[None, :]
    cos = jnp.cos(ang).astype(x.dtype)
    sin = jnp.sin(ang).astype(x.dtype)
    x1, x2 = x[..., :half], x[..., half:]
    return jnp.concatenate([x1 * cos - x2 * sin, x2 * cos + x1 * sin], axis=-1)


def masked_softmax(s, mask):
    p = jax.nn.softmax(jnp.where(mask, s, NEG_INF), axis=-1)
    return jnp.where(mask, p, 0.0)


def stick_breaking_attention(q, k, v):
    B, H, S, dh = q.shape
    nblk = S // Q_BLOCK
    qb = q.reshape(B, H, nblk, Q_BLOCK, dh).transpose(2, 0, 1, 3, 4)
    kpos = jnp.arange(S)
    scale = dh ** -0.5

    def block(args):
        qi, i = args
        qpos = i * Q_BLOCK + jnp.arange(Q_BLOCK)
        z = jnp.einsum('bhqd,bhkd->bhqk', qi, k).astype(jnp.float32) * scale
        past = kpos[None, :] < qpos[:, None]
        log_keep = jnp.where(past, jax.nn.log_sigmoid(-z), 0.0)
        tail = lax.cumsum(log_keep, axis=3, reverse=True) - log_keep
        a = jnp.where(past, jnp.exp(jax.nn.log_sigmoid(z) + tail), 0.0)
        return jnp.einsum('bhqk,bhkd->bhqd', a.astype(v.dtype), v)

    out = lax.map(block, (qb, jnp.arange(nblk)))
    return out.transpose(1, 2, 0, 3, 4).reshape(B, H, S, dh)


def compress_tokens(x, pe, w1, w2):
    B, G, S, dh = x.shape
    n_sub = CMP_BLOCK // CMP_STRIDE
    n_stride = S // CMP_STRIDE
    xs = x.reshape(B, G, n_stride, CMP_STRIDE, dh)
    blocks = jnp.concatenate([xs[:, :, j:n_stride - n_sub + 1 + j] for j in range(n_sub)], axis=3)
    blocks = blocks + pe
    flat = blocks.reshape(B, G, blocks.shape[2], CMP_BLOCK * dh)
    return jax.nn.gelu(flat @ w1) @ w2


def nsa_attention(q, kc, vc, ks, vs, kw, vw, gates):
    B, Hq, S, dh = q.shape
    G = ks.shape[1]
    R = Hq // G
    nblk = S // Q_BLOCK
    n_sel = S // SEL_BLOCK
    ratio = SEL_BLOCK // CMP_STRIDE
    n_sub = CMP_BLOCK // CMP_STRIDE
    topk = min(SEL_TOPK, n_sel)
    scale = dh ** -0.5
    cmp_end = jnp.arange(kc.shape[2]) * CMP_STRIDE + CMP_BLOCK - 1
    ks_blk = ks.reshape(B, G, n_sel, SEL_BLOCK, dh)
    vs_blk = vs.reshape(B, G, n_sel, SEL_BLOCK, dh)
    kw_pad = jnp.pad(kw, ((0, 0), (0, 0), (WINDOW, 0), (0, 0)))
    vw_pad = jnp.pad(vw, ((0, 0), (0, 0), (WINDOW, 0), (0, 0)))
    qb = q.reshape(B, G, R, nblk, Q_BLOCK, dh).transpose(3, 0, 1, 2, 4, 5)
    gather = jax.vmap(jax.vmap(lambda blk, ix: blk[ix]))
    sel_j = jnp.arange(n_sel)

    def block(args):
        qi, i = args
        qpos = i * Q_BLOCK + jnp.arange(Q_BLOCK)
        sc = jnp.einsum('bgrqd,bgnd->bgrqn', qi, kc).astype(jnp.float32) * scale
        p_cmp = masked_softmax(sc, cmp_end[None, :] <= qpos[:, None])
        o_cmp = jnp.einsum('bgrqn,bgnd->bgrqd', p_cmp.astype(vc.dtype), vc)
        imp = jnp.pad(p_cmp.sum(axis=2), ((0, 0), (0, 0), (0, 0), (n_sub - 1, n_sub - 1)))
        p_slc = sum(imp[..., m:m + n_sel * ratio:ratio] for m in range(ratio + n_sub - 1))
        blk_t = qpos // SEL_BLOCK
        visible = sel_j[None, :] <= blk_t[:, None]
        forced = (sel_j[None, :] == 0) | (sel_j[None, :] == blk_t[:, None]) | (sel_j[None, :] == blk_t[:, None] - 1)
        score = jnp.where(forced, FORCE_SCORE, jnp.where(visible, p_slc, NEG_INF))
        _, idx = lax.top_k(score, topk)
        k_sel = gather(ks_blk, idx).reshape(B, G, Q_BLOCK, topk * SEL_BLOCK, dh)
        v_sel = gather(vs_blk, idx).reshape(B, G, Q_BLOCK, topk * SEL_BLOCK, dh)
        sel_pos = (idx[..., None] * SEL_BLOCK + jnp.arange(SEL_BLOCK)).reshape(B, G, Q_BLOCK, topk * SEL_BLOCK)
        smask = (sel_pos <= qpos[None, None, :, None])[:, :, None]
        ss = jnp.einsum('bgrqd,bgqnd->bgrqn', qi, k_sel).astype(jnp.float32) * scale
        o_sel = jnp.einsum('bgrqn,bgqnd->bgrqd', masked_softmax(ss, smask).astype(v_sel.dtype), v_sel)
        kwin = lax.dynamic_slice_in_dim(kw_pad, i * Q_BLOCK, WINDOW + Q_BLOCK, axis=2)
        vwin = lax.dynamic_slice_in_dim(vw_pad, i * Q_BLOCK, WINDOW + Q_BLOCK, axis=2)
        wpos = i * Q_BLOCK - WINDOW + jnp.arange(WINDOW + Q_BLOCK)
        wmask = (wpos[None, :] >= 0) & (wpos[None, :] <= qpos[:, None]) & (qpos[:, None] - wpos[None, :] < WINDOW)
        sw = jnp.einsum('bgrqd,bgkd->bgrqk', qi, kwin).astype(jnp.float32) * scale
        o_win = jnp.einsum('bgrqk,bgkd->bgrqd', masked_softmax(sw, wmask).astype(vwin.dtype), vwin)
        return jnp.stack([o_cmp, o_sel, o_win])

    out = lax.map(block, (qb, jnp.arange(nblk)))
    out = out.transpose(1, 2, 3, 4, 0, 5, 6).reshape(3, B, Hq, S, dh)
    g = gates.transpose(3, 0, 2, 1)[..., None].astype(out.dtype)
    return (g * out).sum(axis=0)


def clamped_swiglu(gu):
    gate, up = jnp.split(gu, 2, axis=-1)
    gate = jnp.minimum(gate, SWIGLU_LIMIT)
    up = jnp.clip(up, -SWIGLU_LIMIT, SWIGLU_LIMIT)
    return gate * jax.nn.sigmoid(SWIGLU_ALPHA * gate) * (up + 1.0)


def moe_ffn(x, w_router, b_router, w_gate_up, b_gate_up, w_down, b_down):
    B, S, D = x.shape
    xt = x.reshape(-1, D)
    N = xt.shape[0]
    M = N * TOP_K
    logits = (xt @ w_router + b_router).astype(jnp.float32)
    top_vals, top_idx = lax.top_k(logits, TOP_K)
    gate_w = jax.nn.softmax(top_vals, axis=-1)
    e_flat = top_idx.reshape(M)
    order = jnp.argsort(e_flat)
    e_sorted = e_flat[order]
    tok_sorted = order // TOP_K
    w_sorted = gate_w.reshape(M)[order]
    counts = jax.ops.segment_sum(jnp.ones((M,), jnp.int32), e_flat, num_segments=N_EXPERTS)
    padded = (counts + MOE_CHUNK - 1) // MOE_CHUNK * MOE_CHUNK
    starts = jnp.cumsum(counts) - counts
    pends = jnp.cumsum(padded)
    pstarts = pends - padded
    dest = pstarts[e_sorted] + (jnp.arange(M) - starts[e_sorted])
    n_chunks = -(-M // MOE_CHUNK) + N_EXPERTS
    buf = jnp.zeros((n_chunks * MOE_CHUNK, D), x.dtype).at[dest].set(xt[tok_sorted])
    chunk_expert = jnp.clip(jnp.searchsorted(pends, jnp.arange(n_chunks) * MOE_CHUNK, side='right'), 0, N_EXPERTS - 1)

    def expert_block(args):
        xc, e = args
        h = clamped_swiglu(xc @ w_gate_up[e] + b_gate_up[e])
        return h @ w_down[e] + b_down[e]

    out = lax.map(expert_block, (buf.reshape(n_chunks, MOE_CHUNK, D), chunk_expert)).reshape(-1, D)
    y = jax.ops.segment_sum(out[dest] * w_sorted[:, None].astype(out.dtype), tok_sorted, num_segments=N)
    return y.reshape(B, S, D)


def setup_inputs(seed: int = 0) -> dict:
    key = jax.random.key(seed)
    ks = jax.random.split(key, 24)
    L = DEPTH
    flat = CMP_BLOCK * HEAD_DIM

    def nrm(k, shape, scale):
        return jax.random.normal(k, shape, jnp.float32) * scale

    return {
        "x": nrm(ks[0], (BATCH, SEQ, D_MODEL), 1.0),
        "w_in": nrm(ks[1], (L, D_MODEL, IN_W), D_MODEL ** -0.5),
        "cmp_pe_k": nrm(ks[2], (L, CMP_BLOCK, HEAD_DIM), 0.1),
        "cmp_w1_k": nrm(ks[3], (L, flat, HEAD_DIM), flat ** -0.5),
        "cmp_w2_k": nrm(ks[4], (L, HEAD_DIM, HEAD_DIM), HEAD_DIM ** -0.5),
        "cmp_pe_v": nrm(ks[5], (L, CMP_BLOCK, HEAD_DIM), 0.1),
        "cmp_w1_v": nrm(ks[6], (L, flat, HEAD_DIM), flat ** -0.5),
        "cmp_w2_v": nrm(ks[7], (L, HEAD_DIM, HEAD_DIM), HEAD_DIM ** -0.5),
        "w_proj_sb": nrm(ks[8], (L, SB_W, D_MODEL), SB_W ** -0.5),
        "w_proj_nsa": nrm(ks[9], (L, NSA_Q_W, D_MODEL), NSA_Q_W ** -0.5),
        "w_out": nrm(ks[10], (L, D_MODEL, D_MODEL), D_MODEL ** -0.5 * DEEPNORM_BETA),
        "ln1_g": 1.0 + nrm(ks[11], (L, D_MODEL), 0.01),
        "ln1_b": nrm(ks[12], (L, D_MODEL), 0.01),
        "w_router": nrm(ks[13], (L, D_MODEL, N_EXPERTS), D_MODEL ** -0.5),
        "b_router": nrm(ks[14], (L, N_EXPERTS), 0.01),
        "w_gate_up": nrm(ks[15], (L, N_EXPERTS, D_MODEL, 2 * D_FF), D_MODEL ** -0.5),
        "b_gate_up": nrm(ks[16], (L, N_EXPERTS, 2 * D_FF), 0.01),
        "w_down": nrm(ks[17], (L, N_EXPERTS, D_FF, D_MODEL), D_FF ** -0.5 * DEEPNORM_BETA),
        "b_down": nrm(ks[18], (L, N_EXPERTS, D_MODEL), 0.01),
        "ln2_g": 1.0 + nrm(ks[19], (L, D_MODEL), 0.01),
        "ln2_b": nrm(ks[20], (L, D_MODEL), 0.01),
    }


def reference(x, w_in, cmp_pe_k, cmp_w1_k, cmp_w2_k, cmp_pe_v, cmp_w1_v, cmp_w2_v,
              w_proj_sb, w_proj_nsa, w_out, ln1_g, ln1_b, w_router, b_router,
              w_gate_up, b_gate_up, w_down, b_down, ln2_g, ln2_b):
    B, S, D = x.shape
    pos = jnp.arange(S, dtype=jnp.int32)
    sizes = [SB_W, SB_W, SB_W, NSA_Q_W] + [NSA_KV_W] * 6 + [3 * NSA_Q_HEADS, N_BRANCHES * D_MODEL]
    split_at = [int(c) for c in np.cumsum(sizes)[:-1]]

    def heads(t, n):
        return t.reshape(B, S, n, HEAD_DIM).transpose(0, 2, 1, 3)

    def merge_heads(t):
        return t.transpose(0, 2, 1, 3).reshape(B, S, -1)

    h = x
    for l in range(DEPTH):
        proj = h @ w_in[l]
        sb_q, sb_k, sb_v, n_q, k_c, v_c, k_s, v_s, k_w, v_w, n_g, m_g = jnp.split(proj, split_at, axis=-1)
        y_sb = stick_breaking_attention(heads(sb_q, SB_HEADS), heads(sb_k, SB_HEADS), heads(sb_v, SB_HEADS))
        q_n = rope(heads(n_q, NSA_Q_HEADS), pos)
        kc = compress_tokens(rope(heads(k_c, NSA_KV_GROUPS), pos), cmp_pe_k[l], cmp_w1_k[l], cmp_w2_k[l])
        vc = compress_tokens(heads(v_c, NSA_KV_GROUPS), cmp_pe_v[l], cmp_w1_v[l], cmp_w2_v[l])
        ks_ = rope(heads(k_s, NSA_KV_GROUPS), pos)
        kw_ = rope(heads(k_w, NSA_KV_GROUPS), pos)
        nsa_gates = jax.nn.sigmoid(n_g).reshape(B, S, NSA_Q_HEADS, 3)
        y_nsa = nsa_attention(q_n, kc, vc, ks_, heads(v_s, NSA_KV_GROUPS), kw_, heads(v_w, NSA_KV_GROUPS), nsa_gates)
        mg = jax.nn.sigmoid(m_g).reshape(B, S, N_BRANCHES, D)
        merged = mg[:, :, 0] * (merge_heads(y_sb) @ w_proj_sb[l]) + mg[:, :, 1] * (merge_heads(y_nsa) @ w_proj_nsa[l])
        h = layer_norm(DEEPNORM_ALPHA * h + merged @ w_out[l], ln1_g[l], ln1_b[l])
        y_moe = moe_ffn(h, w_router[l], b_router[l], w_gate_up[l], b_gate_up[l], w_down[l], b_down[l])
        h = layer_norm(DEEPNORM_ALPHA * h + y_moe, ln2_g[l], ln2_b[l])
    return h
```

```cpp
#include <hip/hip_runtime.h>
#include <stdint.h>
#include <math.h>
constexpr int NB = 8, SEQ = 8192, DM = 1024, NTOK = NB * SEQ;
constexpr int IN_W = 4888;
constexpr int C_NG = 2816, C_MG = 2840;
constexpr int NEXP = 32, TOPK = 4, DFF = 1024;
constexpr int NCMP = 511;
constexpr float ALPHA = 1.189207115002721f;
constexpr float LN_EPS = 1e-5f;
constexpr float LOG2E = 1.4426950408889634f;
constexpr float C2 = 0.125f * LOG2E;
constexpr int NTILE_MAX = NTOK * TOPK / 256 + NEXP;
constexpr int NROUND = 2, TR = NTILE_MAX / NROUND;
constexpr int NWAVES = 8, NTHREADS = 512;

typedef float f32x16 __attribute__((ext_vector_type(16)));
typedef float f32x4 __attribute__((ext_vector_type(4)));
typedef float f32x2 __attribute__((ext_vector_type(2)));
typedef unsigned u32x4 __attribute__((ext_vector_type(4)));
typedef unsigned u32x2 __attribute__((ext_vector_type(2)));
typedef unsigned short bf16_t;
#define LAS __attribute__((address_space(3)))

__device__ __forceinline__ unsigned f2bf(float f) { unsigned u = __builtin_bit_cast(unsigned, f); return (u + 0x7fffu + ((u >> 16) & 1u)) >> 16; }
__device__ __forceinline__ unsigned pk2(float lo, float hi) { return f2bf(lo) | (f2bf(hi) << 16); }
__device__ __forceinline__ float bf2f(unsigned h) { return __builtin_bit_cast(float, h << 16); }
__device__ __forceinline__ float bflo(unsigned w) { return __builtin_bit_cast(float, w << 16); }
__device__ __forceinline__ float bfhi(unsigned w) { return __builtin_bit_cast(float, w & 0xffff0000u); }
__device__ __forceinline__ float sigmoidf_(float x) { return 1.f / (1.f + __expf(-x)); }
__device__ __forceinline__ float wave_sum(float v) {
#pragma unroll
    for (int o = 1; o < 64; o <<= 1) v += __shfl_xor(v, o);
    return v;
}

constexpr size_t MiB = 1u << 20;
constexpr size_t WS_CTL = 0;
constexpr size_t WS_ROPE = 1 * MiB;
constexpr size_t WS_WGU = 3 * MiB;
constexpr size_t WS_WDN = 131 * MiB;
constexpr size_t WS_WIN = 195 * MiB;
constexpr size_t WS_WSB = 205 * MiB;
constexpr size_t WS_WNSA = 206 * MiB;
constexpr size_t WS_WOUT = 207 * MiB;
constexpr size_t WS_CMPW = 209 * MiB;
constexpr size_t WS_XB = 210 * MiB;
constexpr size_t WS_SBQ = 338 * MiB, WS_SBK = 402 * MiB, WS_SBV = 466 * MiB, WS_NQ = 530 * MiB;
constexpr size_t WS_KV6 = 594 * MiB;
constexpr size_t WS_NG = 690 * MiB;
constexpr size_t WS_KCMP = 696 * MiB, WS_VCMP = 697 * MiB;
constexpr size_t WS_MASK = 698 * MiB;
constexpr size_t WS_YSB = 700 * MiB, WS_YNSA = 764 * MiB;
constexpr size_t WS_YPART = 828 * MiB;
constexpr size_t WS_MERGED = 210 * MiB;
constexpr size_t WS_U = 338 * MiB;
constexpr size_t WS_H1B = 594 * MiB;
constexpr size_t WS_TOPE = 722 * MiB, WS_TOPW = 723 * MiB, WS_SPOS = 724 * MiB;
constexpr size_t WS_LIST = 726 * MiB;
constexpr size_t WS_HID = 210 * MiB;
constexpr size_t WS_OUTR = 734 * MiB;
constexpr int CT_CNT = 0;
constexpr int CT_Q = 64;
namespace pg8 {
#define PG8_LAS __attribute__((address_space(3)))
typedef unsigned short bf16_t;
typedef short bf16x8 __attribute__((ext_vector_type(8)));
typedef float f32x4 __attribute__((ext_vector_type(4)));
typedef unsigned u32x4 __attribute__((ext_vector_type(4)));
constexpr int BM = 256, BK = 64, HALF = 128, HTB = HALF * BK * 2, STAGE_BYTES = 8 * HTB, NXCD = 8, WGM = 8;
__host__ __device__ __forceinline__ int lds_byte(int r, int c) { const int st = (r >> 4) * 2 + (c >> 5), rr = r & 15, cc = c & 31, ob = rr * 64 + cc * 2; return st * 1024 + (ob ^ (((ob >> 9) & 1) << 5)); }
__host__ __device__ __forceinline__ void stage_rc(int b, int& R, int& C) { const int st = b / 1024, sb = b % 1024, swz = sb ^ (((sb >> 9) & 1) << 5); R = (st >> 1) * 16 + swz / 64; C = (st & 1) * 32 + (swz % 64) / 2; }
__host__ __device__ __forceinline__ int perm32(int rho) { const int n = rho >> 4, i = rho & 15; return 8 * (i >> 2) + 4 * n + (i & 3); }
struct Unit { int pm, pn, e, r0; };
struct Gemm { const bf16_t* A; const bf16_t* Bt; int K; int pad; };
struct StaticOrder {
    int nM, nN, nwg, G, c;
    __host__ __device__ void init(int M, int N, int G_, int c_) { nM = M / BM; nN = N / BM; nwg = nM * nN; G = G_; c = c_; }
    __host__ __device__ bool next(int i, Unit& u) const {
        const long L = (long)i * G + c; if (L >= nwg) return false;
        int wgid = (int)L; { const int q = nwg / NXCD, r = nwg % NXCD, xcd = wgid % NXCD, off = wgid / NXCD; wgid = (xcd < r ? xcd * (q + 1) : r * (q + 1) + (xcd - r) * q) + off; }
        const int nig = WGM * nN, gid = wgid / nig, fm = gid * WGM, gsz = (nM - fm) < WGM ? (nM - fm) : WGM;
        u.pm = fm + ((wgid % nig) % gsz); u.pn = (wgid % nig) / gsz; u.e = 0; u.r0 = 0; return true;
    }
    __device__ __forceinline__ unsigned row_off(const Unit&, int) const { return 0u; }
};
__device__ __forceinline__ unsigned cvt_pk_bf16(float lo, float hi) { unsigned r; asm volatile("v_cvt_pk_bf16_f32 %0, %1, %2" : "=v"(r) : "v"(lo), "v"(hi)); return r; }

template <class Epi, class Sched, bool ALIGN_EPI, bool GATHER>
__device__ __forceinline__ void gemm_phase(PG8_LAS unsigned char* lds, const Gemm g, const Sched& S, const Epi& E) {
    const int tid = threadIdx.x, wid = __builtin_amdgcn_readfirstlane(tid >> 6), lane = tid & 63, wr = wid >> 2, wc = wid & 3, fr = lane & 15, fq = lane >> 4;
    const int K = g.K, nt = K / BK;
    unsigned voffA[2], voffB[2]; int Rrow[2];
#pragma unroll
    for (int i = 0; i < 2; ++i) { int R, C; stage_rc(tid * 16 + i * 8192, R, C); const int Rb = Epi::PERM ? ((R & ~31) + perm32(R & 31)) : R;
        voffA[i] = GATHER ? (unsigned)(C * 2) : (unsigned)(R * K + C) * 2u; voffB[i] = (unsigned)(Rb * K + C) * 2u; Rrow[i] = R; }
    const size_t kstep = (size_t)(BK * 2);
    const size_t hstep = (size_t)HALF * K * 2;
    const size_t hstepA = GATHER ? 0 : hstep;
    const size_t tstep = 2 * hstep;
    const unsigned ldsw = (unsigned)wid * 1024u;
    const int aoff = lds_byte(wr * 64 + fr, fq * 8), boff = lds_byte(wc * 32 + fr, fq * 8);
#define PG8_SA(b, h) (((b) * 2 + (h)) * HTB)
#define PG8_SB(b, h) ((4 + (b) * 2 + (h)) * HTB)
#define PG8_STAGE(bufoff, gbase, voff) do { _Pragma("unroll") for (int _i = 0; _i < 2; ++_i) \
        __builtin_amdgcn_global_load_lds((const unsigned*)((const char*)(gbase) + (voff)[_i]), (PG8_LAS unsigned*)(lds + (bufoff) + ldsw + _i * 8192), 16, 0, 0); } while (0)
#define PG8_STAGE_A(bufoff, gbase, h, nx) do { if constexpr (GATHER) { unsigned _o[2]; _o[0] = ((nx) ? gN[h][0] : gA[h][0]); _o[1] = ((nx) ? gN[h][1] : gA[h][1]); PG8_STAGE(bufoff, gbase, _o); } \
        else { PG8_STAGE(bufoff, (gbase) + (h) * hstepA, voffA); } } while (0)
#define PG8_LDA(dst, b, h) do { _Pragma("unroll") for (int m = 0; m < 4; ++m) _Pragma("unroll") for (int k = 0; k < 2; ++k) dst[m][k] = *(const PG8_LAS bf16x8*)(lds + PG8_SA(b, h) + aoff + m * 2048 + k * 1024); } while (0)
#define PG8_LDB(dst, b, h) do { _Pragma("unroll") for (int n = 0; n < 2; ++n) _Pragma("unroll") for (int k = 0; k < 2; ++k) dst[n][k] = *(const PG8_LAS bf16x8*)(lds + PG8_SB(b, h) + boff + n * 2048 + k * 1024); } while (0)
#define PG8_MMA(ai, bj, At, Bt) do { __builtin_amdgcn_s_setprio(1); _Pragma("unroll") for (int m = 0; m < 4; ++m) _Pragma("unroll") for (int n = 0; n < 2; ++n) _Pragma("unroll") for (int k = 0; k < 2; ++k) \
        acc[ai][bj][m][n] = __builtin_amdgcn_mfma_f32_16x16x32_bf16(Bt[n][k], At[m][k], acc[ai][bj][m][n], 0, 0, 0); __builtin_amdgcn_s_setprio(0); } while (0)
#define PG8_WAIT_V(n) asm volatile("s_waitcnt vmcnt(" #n ")" ::: "memory")
#define PG8_WAIT_L(n) asm volatile("s_waitcnt lgkmcnt(" #n ")" ::: "memory")
#define PG8_BAR __builtin_amdgcn_s_barrier()
#define PG8_SCHED __builtin_amdgcn_sched_barrier(0)
    Unit cur, nxt; int ui = 0;
    if (!S.next(0, cur)) return;
    f32x4 acc[2][2][4][2];
#pragma unroll
    for (int a = 0; a < 2; ++a)
#pragma unroll
        for (int b = 0; b < 2; ++b)
#pragma unroll
            for (int m = 0; m < 4; ++m)
#pragma unroll
                for (int n = 0; n < 2; ++n) acc[a][b][m][n] = (f32x4){0.f, 0.f, 0.f, 0.f};
    bf16x8 At[4][2], B0[2][2], B1[2][2];
    unsigned gA[2][2], gN[2][2];
#pragma unroll
    for (int h = 0; h < 2; ++h)
#pragma unroll
        for (int i = 0; i < 2; ++i) { gA[h][i] = GATHER ? S.row_off(cur, h * HALF + Rrow[i]) + voffA[i] : 0u; gN[h][i] = gA[h][i]; }
    const char* cA = (const char*)g.A + (GATHER ? (size_t)0 : (size_t)cur.pm * tstep); const char* cB = (const char*)g.Bt + (size_t)cur.pn * tstep;
    PG8_STAGE(PG8_SB(0, 0), cB, voffB); PG8_STAGE(PG8_SB(0, 1), cB + hstep, voffB); PG8_STAGE_A(PG8_SA(0, 0), cA, 0, false); PG8_STAGE_A(PG8_SA(0, 1), cA, 1, false);
    if (wr == 1) PG8_BAR;
    PG8_WAIT_V(2); PG8_BAR;
    PG8_STAGE(PG8_SB(1, 0), cB + kstep, voffB); PG8_STAGE_A(PG8_SA(1, 0), cA + kstep, 0, false); PG8_STAGE(PG8_SB(1, 1), cB + hstep + kstep, voffB);
    PG8_WAIT_V(6); PG8_BAR;
    for (;;) {
        const bool has_next = S.next(ui + 1, nxt);
        if constexpr (GATHER) {
#pragma unroll
            for (int h = 0; h < 2; ++h)
#pragma unroll
                for (int i = 0; i < 2; ++i) gN[h][i] = has_next ? S.row_off(nxt, h * HALF + Rrow[i]) + voffA[i] : gA[h][i];
        }
        const char* nA = (has_next && !GATHER) ? (const char*)g.A + (size_t)nxt.pm * tstep : cA; const char* nB = has_next ? (const char*)g.Bt + (size_t)nxt.pn * tstep : cB;
        for (int t = 0; t < nt; t += 2) {
            const bool last = (t == nt - 2);
            const char* a1 = cA + (size_t)(t + 1) * kstep;
            const char* a2 = last ? nA : cA + (size_t)(t + 2) * kstep; const char* b2 = last ? nB : cB + (size_t)(t + 2) * kstep;
            const char* a3 = a2 + kstep; const char* b3 = b2 + kstep;
            PG8_LDB(B0, 0, 0); PG8_LDB(B1, 0, 1); PG8_SCHED; PG8_LDA(At, 0, 0); PG8_STAGE_A(PG8_SA(1, 1), a1, 1, false);
            PG8_WAIT_V(8); PG8_WAIT_L(0); PG8_BAR; PG8_MMA(0, 0, At, B0); PG8_MMA(0, 1, At, B1); PG8_BAR; PG8_SCHED;
            PG8_LDA(At, 0, 1); PG8_STAGE(PG8_SB(0, 0), b2, voffB); PG8_STAGE(PG8_SB(0, 1), b2 + hstep, voffB); PG8_STAGE_A(PG8_SA(0, 0), a2, 0, last);
            PG8_WAIT_V(8); PG8_WAIT_L(0); PG8_BAR; PG8_MMA(1, 0, At, B0); PG8_MMA(1, 1, At, B1); PG8_BAR; PG8_SCHED;
            PG8_LDB(B0, 1, 0); PG8_LDB(B1, 1, 1); PG8_SCHED; PG8_LDA(At, 1, 0); PG8_STAGE_A(PG8_SA(0, 1), a2, 1, last);
            PG8_WAIT_V(8); PG8_WAIT_L(0); PG8_BAR; PG8_MMA(0, 0, At, B0); PG8_MMA(0, 1, At, B1); PG8_BAR; PG8_SCHED;
            PG8_LDA(At, 1, 1); PG8_STAGE(PG8_SB(1, 0), b3, voffB); PG8_STAGE(PG8_SB(1, 1), b3 + hstep, voffB); PG8_STAGE_A(PG8_SA(1, 0), a3, 0, last);
            PG8_WAIT_V(8); PG8_WAIT_L(0); PG8_BAR; PG8_MMA(1, 0, At, B0); PG8_MMA(1, 1, At, B1); PG8_BAR; PG8_SCHED;
        }
        if constexpr (ALIGN_EPI) { if (wr == 0) PG8_BAR; }
        E(acc, cur, wr, wc, fr, fq);
        if (!has_next) break;
#pragma unroll
        for (int a = 0; a < 2; ++a)
#pragma unroll
            for (int b = 0; b < 2; ++b)
#pragma unroll
                for (int m = 0; m < 4; ++m)
#pragma unroll
                    for (int n = 0; n < 2; ++n) acc[a][b][m][n] = (f32x4){0.f, 0.f, 0.f, 0.f};
        cur = nxt; cA = nA; cB = nB; ++ui;
#pragma unroll
        for (int h = 0; h < 2; ++h)
#pragma unroll
            for (int i = 0; i < 2; ++i) gA[h][i] = gN[h][i];
        if constexpr (ALIGN_EPI) { if (wr == 1) PG8_BAR; }
    }
    PG8_WAIT_V(0);
    if constexpr (!ALIGN_EPI) { if (wr == 0) PG8_BAR; }
    PG8_BAR;
#undef PG8_SA
#undef PG8_SB
#undef PG8_STAGE
#undef PG8_STAGE_A
#undef PG8_LDA
#undef PG8_LDB
#undef PG8_MMA
#undef PG8_WAIT_V
#undef PG8_WAIT_L
#undef PG8_BAR
#undef PG8_SCHED
}
}
using pg8::Unit; using pg8::cvt_pk_bf16;
struct EpiInProj {
    static constexpr bool PERM = true;
    bf16_t* sbq; bf16_t* sbk; bf16_t* sbv; bf16_t* nq; bf16_t* kv6; bf16_t* mg; const float* cosT; const float* sinT;
    __device__ __forceinline__ void operator()(const f32x4 (&acc)[2][2][4][2], const Unit& u, int wr, int wc, int fr, int fq) const {
        const int pn = u.pn; const int row0 = u.pm * 256 + wr * 64 + fr; const int x0 = wc * 32 + 8 * fq;
        if (pn < 6 || pn >= 11) {
            bf16_t* base; int ld, col; float sc = 1.f; const bool sig = pn >= 11;
            if (pn < 2) { base = sbq; ld = 512; col = pn * 256; sc = C2; } else if (pn < 4) { base = sbk; ld = 512; col = (pn - 2) * 256; }
            else if (pn < 6) { base = sbv; ld = 512; col = (pn - 4) * 256; } else { base = mg; ld = 2048; col = (pn - 11) * 256; }
#pragma unroll
            for (int ai = 0; ai < 2; ++ai)
#pragma unroll
                for (int m = 0; m < 4; ++m) { bf16_t* rp = base + (size_t)(row0 + ai * 128 + m * 16) * ld + col + x0;
#pragma unroll
                    for (int bj = 0; bj < 2; ++bj) { f32x4 v0 = acc[ai][bj][m][0] * sc, v1 = acc[ai][bj][m][1] * sc;
                        if (sig) {
#pragma unroll
                            for (int j = 0; j < 4; ++j) { v0[j] = sigmoidf_(v0[j]); v1[j] = sigmoidf_(v1[j]); } }
                        u32x4 w; w.x = cvt_pk_bf16(v0[0], v0[1]); w.y = cvt_pk_bf16(v0[2], v0[3]); w.z = cvt_pk_bf16(v1[0], v1[1]); w.w = cvt_pk_bf16(v1[2], v1[3]);
                        *(u32x4*)(rp + bj * 128) = w; } }
        } else {
            const bool rope = (pn < 8) || (wc < 2);
            bf16_t* base; int ld, c0, c1; float sc = 1.f;
            if (pn < 8) { base = nq; ld = 512; c0 = ((pn - 6) * 4 + wc) * 64 + 8 * fq; c1 = c0 + 32; sc = C2; }
            else { const int t = pn - 8; ld = 128;
                if (wc < 2) { base = kv6 + (size_t)(2 * t) * NTOK * 128; c0 = wc * 64 + 8 * fq; c1 = c0 + 32; }
                else { base = kv6 + (size_t)(2 * t + 1) * NTOK * 128; c0 = (wc - 2) * 32 + 8 * fq; c1 = 64 + c0; } }
#pragma unroll
            for (int ai = 0; ai < 2; ++ai)
#pragma unroll
                for (int m = 0; m < 4; ++m) { const int row = row0 + ai * 128 + m * 16; bf16_t* rp = base + (size_t)row * ld;
                    f32x4 a0 = acc[ai][0][m][0], a1 = acc[ai][0][m][1], b0 = acc[ai][1][m][0], b1 = acc[ai][1][m][1];
                    if (rope) { const int pos = row & (SEQ - 1); const f32x4 cA = *(const f32x4*)(cosT + pos * 32 + 8 * fq), cB = *(const f32x4*)(cosT + pos * 32 + 8 * fq + 4);
                        const f32x4 sA = *(const f32x4*)(sinT + pos * 32 + 8 * fq), sB = *(const f32x4*)(sinT + pos * 32 + 8 * fq + 4);
                        const f32x4 r0 = a0 * cA - b0 * sA, r1 = a1 * cB - b1 * sB, r2 = b0 * cA + a0 * sA, r3 = b1 * cB + a1 * sB;
                        a0 = r0 * sc; a1 = r1 * sc; b0 = r2 * sc; b1 = r3 * sc; }
                    u32x4 w; w.x = cvt_pk_bf16(a0[0], a0[1]); w.y = cvt_pk_bf16(a0[2], a0[3]); w.z = cvt_pk_bf16(a1[0], a1[1]); w.w = cvt_pk_bf16(a1[2], a1[3]);
                    *(u32x4*)(rp + c0) = w;
                    w.x = cvt_pk_bf16(b0[0], b0[1]); w.y = cvt_pk_bf16(b0[2], b0[3]); w.z = cvt_pk_bf16(b1[0], b1[1]); w.w = cvt_pk_bf16(b1[2], b1[3]);
                    *(u32x4*)(rp + c1) = w; }
        }
    }
};
struct EpiMerge {
    static constexpr bool PERM = true;
    const bf16_t* mg; bf16_t* merged; int pass; int pad;
    __device__ __forceinline__ void operator()(const f32x4 (&acc)[2][2][4][2], const Unit& u, int wr, int wc, int fr, int fq) const {
        const int row0 = u.pm * 256 + wr * 64 + fr; const int col0 = u.pn * 256 + wc * 32 + 8 * fq;
#pragma unroll
        for (int ai = 0; ai < 2; ++ai)
#pragma unroll
            for (int m = 0; m < 4; ++m) { const size_t row = (size_t)(row0 + ai * 128 + m * 16);
#pragma unroll
                for (int bj = 0; bj < 2; ++bj) { const int col = col0 + bj * 128;
                    const u32x4 g = *(const u32x4*)(mg + row * 2048 + pass * 1024 + col);
                    f32x4 v0 = acc[ai][bj][m][0], v1 = acc[ai][bj][m][1];
                    v0[0] *= bflo(g.x); v0[1] *= bfhi(g.x); v0[2] *= bflo(g.y); v0[3] *= bfhi(g.y); v1[0] *= bflo(g.z); v1[1] *= bfhi(g.z); v1[2] *= bflo(g.w); v1[3] *= bfhi(g.w);
                    bf16_t* op = merged + row * DM + col;
                    if (pass) { const u32x4 p = *(const u32x4*)op; v0[0] += bflo(p.x); v0[1] += bfhi(p.x); v0[2] += bflo(p.y); v0[3] += bfhi(p.y); v1[0] += bflo(p.z); v1[1] += bfhi(p.z); v1[2] += bflo(p.w); v1[3] += bfhi(p.w); }
                    u32x4 w; w.x = cvt_pk_bf16(v0[0], v0[1]); w.y = cvt_pk_bf16(v0[2], v0[3]); w.z = cvt_pk_bf16(v1[0], v1[1]); w.w = cvt_pk_bf16(v1[2], v1[3]);
                    *(u32x4*)op = w; } }
    }
};
struct EpiOut {
    static constexpr bool PERM = false;
    const float* x; float* u;
    __device__ __forceinline__ void operator()(const f32x4 (&acc)[2][2][4][2], const Unit& un, int wr, int wc, int fr, int fq) const {
        const int row0 = un.pm * 256 + wr * 64 + fr; const int col0 = un.pn * 256 + wc * 32 + 4 * fq;
#pragma unroll
        for (int ai = 0; ai < 2; ++ai)
#pragma unroll
            for (int m = 0; m < 4; ++m) { const size_t off = (size_t)(row0 + ai * 128 + m * 16) * DM + col0;
#pragma unroll
                for (int bj = 0; bj < 2; ++bj)
#pragma unroll
                    for (int n = 0; n < 2; ++n) { const f32x4 xv = *(const f32x4*)(x + off + bj * 128 + n * 16); *(f32x4*)(u + off + bj * 128 + n * 16) = xv * ALPHA + acc[ai][bj][m][n]; } }
    }
};
struct EpiGateUp {
    static constexpr bool PERM = true;
    const float* bgu; bf16_t* hid;
    __device__ __forceinline__ void operator()(const f32x4 (&acc)[2][2][4][2], const Unit& u, int wr, int wc, int fr, int fq) const {
        const int e = u.e, pnl = u.pn - e * 8; const int f0 = pnl * 128 + wc * 32 + 8 * fq;
        const float* bp = bgu + e * 2048 + f0;
        const f32x4 bg0 = *(const f32x4*)bp, bg1 = *(const f32x4*)(bp + 4), bu0 = *(const f32x4*)(bp + 1024), bu1 = *(const f32x4*)(bp + 1028);
        const int row0 = u.pm * 256 + wr * 64 + fr;
#pragma unroll
        for (int ai = 0; ai < 2; ++ai)
#pragma unroll
            for (int m = 0; m < 4; ++m) {
                f32x4 g0 = acc[ai][0][m][0] + bg0, g1 = acc[ai][0][m][1] + bg1, u0 = acc[ai][1][m][0] + bu0, u1 = acc[ai][1][m][1] + bu1;
                f32x4 h0, h1;
#pragma unroll
                for (int j = 0; j < 4; ++j) {
                    float g = fminf(g0[j], 7.f), uu = fminf(fmaxf(u0[j], -7.f), 7.f); h0[j] = g * sigmoidf_(1.702f * g) * (uu + 1.f);
                    g = fminf(g1[j], 7.f); uu = fminf(fmaxf(u1[j], -7.f), 7.f); h1[j] = g * sigmoidf_(1.702f * g) * (uu + 1.f); }
                u32x4 w; w.x = cvt_pk_bf16(h0[0], h0[1]); w.y = cvt_pk_bf16(h0[2], h0[3]); w.z = cvt_pk_bf16(h1[0], h1[1]); w.w = cvt_pk_bf16(h1[2], h1[3]);
                *(u32x4*)(hid + (size_t)(row0 + ai * 128 + m * 16) * DFF + f0) = w; }
    }
};
struct EpiDown {
    static constexpr bool PERM = true;
    const float* bd; bf16_t* outr;
    __device__ __forceinline__ void operator()(const f32x4 (&acc)[2][2][4][2], const Unit& u, int wr, int wc, int fr, int fq) const {
        const int e = u.e, pnl = u.pn - e * 4; const int col0 = pnl * 256 + wc * 32 + 8 * fq; const int row0 = u.pm * 256 + wr * 64 + fr;
        f32x4 b[2][2];
#pragma unroll
        for (int bj = 0; bj < 2; ++bj) { b[bj][0] = *(const f32x4*)(bd + e * DM + col0 + bj * 128); b[bj][1] = *(const f32x4*)(bd + e * DM + col0 + bj * 128 + 4); }
#pragma unroll
        for (int ai = 0; ai < 2; ++ai)
#pragma unroll
            for (int m = 0; m < 4; ++m) { bf16_t* rp = outr + (size_t)(row0 + ai * 128 + m * 16) * DM + col0;
#pragma unroll
                for (int bj = 0; bj < 2; ++bj) { const f32x4 v0 = acc[ai][bj][m][0] + b[bj][0], v1 = acc[ai][bj][m][1] + b[bj][1];
                    u32x4 w; w.x = cvt_pk_bf16(v0[0], v0[1]); w.y = cvt_pk_bf16(v0[2], v0[3]); w.z = cvt_pk_bf16(v1[0], v1[1]); w.w = cvt_pk_bf16(v1[2], v1[3]);
                    *(u32x4*)(rp + bj * 128) = w; } }
    }
};
constexpr int LDS_RING = 131072, LDS_TAB = LDS_RING, LDS_CNT = LDS_TAB + NTILE_MAX * 4, LDS_NT = LDS_CNT + 128, LDS_MISC = LDS_NT + 64, LDS_BYTES = 160 * 1024;
__device__ __forceinline__ void moe_build_table(LAS unsigned char* lds, const int* gcnt) {
    LAS int* tab = (LAS int*)(lds + LDS_TAB); LAS int* cnts = (LAS int*)(lds + LDS_CNT); LAS int* nt = (LAS int*)(lds + LDS_NT);
    LAS int* tstart = (LAS int*)(lds + LDS_MISC);
    const int tid = threadIdx.x;
    if (tid < 32) cnts[tid] = gcnt[tid];
    __syncthreads();
    if (tid == 0) { int a = 0; for (int e = 0; e < 32; ++e) { tstart[e] = a; a += (cnts[e] + 255) >> 8; } tstart[32] = a; nt[0] = a; }
    __syncthreads();
    const int ntl = nt[0];
    for (int t = tid; t < ntl; t += NTHREADS) { int e = 0; for (int k = 1; k < 32; ++k) if (tstart[k] <= t) e = k; tab[t] = (e << 16) | (t - tstart[e]); }
    __syncthreads();
}
template <int NPN> struct MoeOrder {
    LAS unsigned char* lds; const int* list; int r, G, c, ntr;
    __device__ __forceinline__ void init(LAS unsigned char* lds_, const int* list_, int r_, int G_, int c_) {
        lds = lds_; list = list_; r = r_; G = G_; c = c_; const int ntl = ((LAS int*)(lds + LDS_NT))[0]; int n = ntl - r * TR; ntr = n < 0 ? 0 : (n > TR ? TR : n); }
    __device__ __forceinline__ bool next(int i, Unit& u) const {
        const int nM = ntr, nN = NPN, nwg = nM * nN; const long L = (long)i * G + c; if (L >= nwg) return false;
        int wgid = (int)L; { const int q = nwg / 8, rr = nwg % 8, xcd = wgid % 8, off = wgid / 8; wgid = (xcd < rr ? xcd * (q + 1) : rr * (q + 1) + (xcd - rr) * q) + off; }
        const int nig = 8 * nN, gid = wgid / nig, fm = gid * 8, gsz = (nM - fm) < 8 ? (nM - fm) : 8;
        const int pm = fm + ((wgid % nig) % gsz), pnl = (wgid % nig) / gsz;
        const int pk = ((LAS int*)(lds + LDS_TAB))[r * TR + pm];
        u.pm = pm; u.e = pk >> 16; u.r0 = (pk & 0xffff) << 8; u.pn = u.e * NPN + pnl; return true;
    }
    __device__ __forceinline__ unsigned row_off(const Unit& u, int rr) const {
        const int pos = u.r0 + rr; const int cnt = ((LAS int*)(lds + LDS_CNT))[u.e];
        int tok = 0; if (pos < cnt) tok = list[(size_t)u.e * NTOK + pos] >> 2;
        return (unsigned)tok * (unsigned)(DM * 2);
    }
};
__device__ __forceinline__ int win_src_col(int n) {
    const int pn = n >> 8, c = n & 255, bj = c >> 7, x = c & 127;
    if (pn < 6) return n;
    if (pn < 8) return 1536 + ((pn - 6) * 4 + (x >> 5)) * 64 + (x & 31) + 32 * bj;
    if (pn < 11) { const int base = 2048 + (pn - 8) * 256; return x < 64 ? base + (x >> 5) * 64 + (x & 31) + 32 * bj : base + 128 + bj * 64 + (x - 64); }
    return C_MG + (n - 2816);
}
__device__ __forceinline__ int wgu_src_col(int n) { const int pnl = n >> 8, c = n & 255, bj = c >> 7, x = c & 127; return bj * 1024 + 128 * pnl + x; }
__device__ __forceinline__ void transpose_item(const float* W, int ldw, int K, int srccol0, bf16_t* WT, int n0, int k0, LAS float* scr, int lane) {
#pragma unroll 8
    for (int i = 0; i < 32; ++i) { const int kk = 2 * i + (lane >> 5); scr[kk * 33 + (lane & 31)] = W[(size_t)(k0 + kk) * ldw + srccol0 + (lane & 31)]; }
    asm volatile("s_waitcnt lgkmcnt(0)" ::: "memory");
    const int c = lane & 7;
#pragma unroll
    for (int j = 0; j < 4; ++j) { const int n = (lane >> 3) + 8 * j; const LAS float* s = scr + (8 * c) * 33 + n;
        u32x4 o; o.x = pk2(s[0 * 33], s[1 * 33]); o.y = pk2(s[2 * 33], s[3 * 33]); o.z = pk2(s[4 * 33], s[5 * 33]); o.w = pk2(s[6 * 33], s[7 * 33]);
        *(u32x4*)(WT + (size_t)(n0 + n) * K + k0 + 8 * c) = o; }
    asm volatile("s_waitcnt lgkmcnt(0)" ::: "memory");
}
struct PrepArgs { const float* x; const float* w_in; const float* w_sb; const float* w_nsa; const float* w_out; const float* w_gu; const float* w_dn;
                  bf16_t* wt_in; bf16_t* wt_sb; bf16_t* wt_nsa; bf16_t* wt_out; bf16_t* wt_gu; bf16_t* wt_dn; bf16_t* xb; float* ng; float* ropeT;
                  const float* pe_k; const float* w1_k; const float* w2_k; const float* pe_v; const float* w1_v; const float* w2_v; unsigned char* cmpw; };
constexpr int CW_WT1K = 0, CW_WT1V = 262144, CW_W2TK = 524288, CW_W2TV = 532480, CW_C1K = 540672, CW_C1V = 541696;
__device__ __forceinline__ void prep_phase(const PrepArgs& a, LAS unsigned char* lds, int vcu, int G) {
    const int tid = threadIdx.x, lane = tid & 63, wave = __builtin_amdgcn_readfirstlane(tid >> 6);
    const int gw = vcu * NWAVES + wave, NGW = G * NWAVES;
    for (int i = gw * 64 + lane; i < SEQ * 32; i += NGW * 64) { const int pos = i >> 5, d = i & 31;
        const float inv = (float)pow(10000.0, -(double)d / 32.0); const float ang = (float)pos * inv;
        a.ropeT[i] = (float)cos((double)ang); a.ropeT[SEQ * 32 + i] = (float)sin((double)ang); }
    LAS float* scr = (LAS float*)(lds + wave * 8448);
    constexpr int I_IN = 16 * (4864 / 32), I_SB = 8 * 32, I_OUT = 16 * 32, I_GU = 32 * 16 * 64, I_DN = 32 * 16 * 32;
    constexpr int I_W1 = 32 * 2, I_W2 = 2, I_C1 = 1;
    constexpr int NITEMS = I_IN + 2 * I_SB + I_OUT + I_GU + I_DN + 2 * I_W1 + 2 * I_W2 + 2 * I_C1;
    for (int it = gw; it < NITEMS; it += NGW) {
        int r = it;
        if (r < I_IN) { const int nb = r % 152, kb = r / 152; transpose_item(a.w_in, IN_W, 1024, win_src_col(nb * 32), a.wt_in, nb * 32, kb * 64, scr, lane); continue; } r -= I_IN;
        if (r < I_SB) { const int nb = r % 32, kb = r / 32; transpose_item(a.w_sb, 1024, 512, nb * 32, a.wt_sb, nb * 32, kb * 64, scr, lane); continue; } r -= I_SB;
        if (r < I_SB) { const int nb = r % 32, kb = r / 32; transpose_item(a.w_nsa, 1024, 512, nb * 32, a.wt_nsa, nb * 32, kb * 64, scr, lane); continue; } r -= I_SB;
        if (r < I_OUT) { const int nb = r % 32, kb = r / 32; transpose_item(a.w_out, 1024, 1024, nb * 32, a.wt_out, nb * 32, kb * 64, scr, lane); continue; } r -= I_OUT;
        if (r < I_GU) { const int e = r / (16 * 64), q = r % (16 * 64), nb = q % 64, kb = q / 64;
            transpose_item(a.w_gu + (size_t)e * 1024 * 2048, 2048, 1024, wgu_src_col(nb * 32), a.wt_gu + (size_t)e * 2048 * 1024, nb * 32, kb * 64, scr, lane); continue; } r -= I_GU;
        if (r < I_DN) { const int e = r / (16 * 32), q = r % (16 * 32), nb = q % 32, kb = q / 32;
            transpose_item(a.w_dn + (size_t)e * 1024 * 1024, 1024, 1024, nb * 32, a.wt_dn + (size_t)e * 1024 * 1024, nb * 32, kb * 64, scr, lane); continue; } r -= I_DN;
        if (r < I_W1) { transpose_item(a.w1_k, 64, 2048, (r & 1) * 32, (bf16_t*)(a.cmpw + CW_WT1K), (r & 1) * 32, (r >> 1) * 64, scr, lane); continue; } r -= I_W1;
        if (r < I_W1) { transpose_item(a.w1_v, 64, 2048, (r & 1) * 32, (bf16_t*)(a.cmpw + CW_WT1V), (r & 1) * 32, (r >> 1) * 64, scr, lane); continue; } r -= I_W1;
        if (r < I_W2) { transpose_item(a.w2_k, 64, 64, r * 32, (bf16_t*)(a.cmpw + CW_W2TK), r * 32, 0, scr, lane); continue; } r -= I_W2;
        if (r < I_W2) { transpose_item(a.w2_v, 64, 64, r * 32, (bf16_t*)(a.cmpw + CW_W2TV), r * 32, 0, scr, lane); continue; } r -= I_W2;
        {
            const float* pe = r ? a.pe_v : a.pe_k; const float* w1 = r ? a.w1_v : a.w1_k; float* c1 = (float*)(a.cmpw + (r ? CW_C1V : CW_C1K));
            float acc = 0.f; for (int idx = 0; idx < 2048; ++idx) acc += pe[idx] * w1[idx * 64 + lane];
            c1[lane] = acc; }
    }
    __syncthreads();
    LAS float* wng = (LAS float*)lds;
    for (int i = tid; i < 24 * 1024; i += NTHREADS) { const int g = i >> 10, k = i & 1023; wng[i] = a.w_in[(size_t)k * IN_W + C_NG + g]; }
    __syncthreads();
    for (int tok = gw; tok < NTOK; tok += NGW) {
        const float* xr = a.x + (size_t)tok * DM; f32x4 v[2][2];
#pragma unroll
        for (int j = 0; j < 2; ++j) { v[j][0] = *(const f32x4*)(xr + lane * 8 + 512 * j); v[j][1] = *(const f32x4*)(xr + lane * 8 + 512 * j + 4);
            u32x4 o; o.x = pk2(v[j][0][0], v[j][0][1]); o.y = pk2(v[j][0][2], v[j][0][3]); o.z = pk2(v[j][1][0], v[j][1][1]); o.w = pk2(v[j][1][2], v[j][1][3]);
            *(u32x4*)(a.xb + (size_t)tok * DM + lane * 8 + 512 * j) = o; }
        const int gi = (lane & 1) * 4 + ((lane >> 1) & 1) * 2 + ((lane >> 2) & 1);
#pragma unroll 1
        for (int grp = 0; grp < 3; ++grp) {
            float p[8];
#pragma unroll
            for (int g = 0; g < 8; ++g) { float s = 0.f; const LAS float* wp = wng + (grp * 8 + g) * 1024 + lane * 8;
#pragma unroll
                for (int j = 0; j < 2; ++j) { const f32x4 w0 = *(const LAS f32x4*)(wp + 512 * j), w1 = *(const LAS f32x4*)(wp + 512 * j + 4);
                    s += v[j][0][0] * w0[0] + v[j][0][1] * w0[1] + v[j][0][2] * w0[2] + v[j][0][3] * w0[3] + v[j][1][0] * w1[0] + v[j][1][1] * w1[1] + v[j][1][2] * w1[2] + v[j][1][3] * w1[3]; }
                p[g] = s; }
#define BFLY(W, B) { const bool up = (lane & (B)) != 0; _Pragma("unroll") for (int i = 0; i < (W); ++i) { const float lo = p[i], hi = p[i + (W)]; const float keep = up ? hi : lo, send = up ? lo : hi; p[i] = keep + __shfl_xor(send, (B)); } }
            BFLY(4, 1) BFLY(2, 2) BFLY(1, 4)
#undef BFLY
            float tot = p[0]; tot += __shfl_xor(tot, 8); tot += __shfl_xor(tot, 16); tot += __shfl_xor(tot, 32);
            if (lane < 8) a.ng[(size_t)tok * 24 + grp * 8 + gi] = 1.f / (1.f + expf(-tot));
            asm volatile("" ::: "memory");
        }
    }
}
typedef short bf16x8 __attribute__((ext_vector_type(8)));
typedef short s16x4 __attribute__((ext_vector_type(4)));
constexpr int AT_SLOT = 8192, AT_K = 0, AT_V = 3 * AT_SLOT, AT_PSLC = 6 * AT_SLOT  , AT_MASK = AT_PSLC + 32768  , AT_FLAG = AT_MASK + 1024  ;
#define AT_WAIT_BAR(N) asm volatile("s_waitcnt vmcnt(" #N ") lgkmcnt(0)\n\ts_barrier" ::: "memory")
__device__ __forceinline__ int crow(int r, int hi) { return (r & 3) + 8 * (r >> 2) + 4 * hi; }
__device__ __forceinline__ float fexp2(float x) { return __builtin_amdgcn_exp2f(x); }
__device__ __forceinline__ float flog2(float x) { return __builtin_amdgcn_logf(x); }
__device__ __forceinline__ unsigned cvtpk(float lo, float hi) { f32x2 v = {lo, hi}; typedef __bf16 bf2 __attribute__((ext_vector_type(2))); bf2 b = __builtin_convertvector(v, bf2); return __builtin_bit_cast(unsigned, b); }
__device__ __forceinline__ float swap_get(float x) { auto r = __builtin_amdgcn_permlane32_swap(__float_as_uint(x), __float_as_uint(x), false, false); return (threadIdx.x & 32) ? __uint_as_float(r[0]) : __uint_as_float(r[1]); }
struct KVTile { const bf16_t* k; const bf16_t* v; int pitch; };
__device__ __forceinline__ void dma_kv(LAS unsigned char* lds, const KVTile& s, int key0, int slot, int wid, int lane) {
    const bf16_t* ks = s.k + (size_t)(key0 + lane) * s.pitch + wid * 8;
    const bf16_t* vs = s.v + (size_t)(key0 + 16 * (wid & 3) + (lane >> 2)) * s.pitch + (wid >> 2) * 32 + (lane & 3) * 8;
    __builtin_amdgcn_global_load_lds((const unsigned*)ks, (LAS unsigned*)(lds + AT_K + slot * AT_SLOT + wid * 1024), 16, 0, 0);
    __builtin_amdgcn_global_load_lds((const unsigned*)vs, (LAS unsigned*)(lds + AT_V + slot * AT_SLOT + wid * 1024), 16, 0, 0);
}
__device__ __forceinline__ void qkt(f32x16& p0, f32x16& p1, const LAS unsigned char* kslot, const bf16x8 (&qf)[4], int lane) {
    const LAS unsigned char* kb = kslot + (lane >> 5) * 1024 + (lane & 31) * 16;
    p0 = (f32x16){0.f,0.f,0.f,0.f,0.f,0.f,0.f,0.f,0.f,0.f,0.f,0.f,0.f,0.f,0.f,0.f}; p1 = p0;
#pragma unroll
    for (int d0 = 0; d0 < 4; ++d0) {
        const bf16x8 k0 = *(const LAS bf16x8*)(kb + d0 * 2048), k1 = *(const LAS bf16x8*)(kb + d0 * 2048 + 512);
        p0 = __builtin_amdgcn_mfma_f32_32x32x16_bf16(k0, qf[d0], p0, 0, 0, 0);
        p1 = __builtin_amdgcn_mfma_f32_32x32x16_bf16(k1, qf[d0], p1, 0, 0, 0);
    }
}
__device__ __forceinline__ void pv(f32x16 (&oT)[2], const LAS unsigned char* vslot, const f32x16& p0, const f32x16& p1, int lane) {
    bf16x8 pb[4];
#pragma unroll
    for (int ks = 0; ks < 4; ++ks) { const f32x16& p = (ks < 2) ? p0 : p1; const int b = (ks & 1) * 8;
        u32x4 w; w.x = cvtpk(p[b], p[b + 1]); w.y = cvtpk(p[b + 2], p[b + 3]); w.z = cvtpk(p[b + 4], p[b + 5]); w.w = cvtpk(p[b + 6], p[b + 7]); pb[ks] = __builtin_bit_cast(bf16x8, w); }
    const int hi = lane >> 5;
    const LAS unsigned char* vb = vslot + ((lane >> 4) & 1) * 32 + (lane & 3) * 8 + (4 * hi + ((lane & 15) >> 2)) * 64;
    typedef short v4i16_t __attribute__((ext_vector_type(4)));
#pragma unroll
    for (int d0 = 0; d0 < 2; ++d0)
#pragma unroll
        for (int ks = 0; ks < 4; ++ks) {
            const s16x4 lo = __builtin_bit_cast(s16x4, __builtin_amdgcn_ds_read_tr16_b64_v4i16((LAS v4i16_t*)(vb + d0 * 4096 + ks * 1024)));
            const s16x4 hh = __builtin_bit_cast(s16x4, __builtin_amdgcn_ds_read_tr16_b64_v4i16((LAS v4i16_t*)(vb + d0 * 4096 + ks * 1024 + 512)));
            const bf16x8 vf = (bf16x8){lo[0], lo[1], lo[2], lo[3], hh[0], hh[1], hh[2], hh[3]};
            oT[d0] = __builtin_amdgcn_mfma_f32_32x32x16_bf16(vf, pb[ks], oT[d0], 0, 0, 0);
        }
}
__device__ __forceinline__ float rowmax32(const f32x16& p0, const f32x16& p1) {
    float a = fmaxf(p0[0], p1[0]);
#pragma unroll
    for (int r = 1; r < 16; ++r) a = fmaxf(a, fmaxf(p0[r], p1[r]));
    return fmaxf(a, swap_get(a));
}
constexpr float NEG = -1.0e30f;
__device__ __forceinline__ void softmax_tile(f32x16& p0, f32x16& p1, float& m, float& l, f32x16 (&oT)[2]) {
    const float rm = rowmax32(p0, p1);
    if (rm > m) { const float f = fexp2(m - rm); l *= f;
#pragma unroll
        for (int r = 0; r < 16; ++r) { oT[0][r] *= f; oT[1][r] *= f; }
        m = rm; }
    float s = 0.f;
#pragma unroll
    for (int r = 0; r < 16; ++r) { p0[r] = fexp2(p0[r] - m); p1[r] = fexp2(p1[r] - m); s += p0[r] + p1[r]; }
    l += s;
}
__device__ __forceinline__ void load_q(bf16x8 (&qf)[4], const bf16_t* qrow, int lane) {
#pragma unroll
    for (int d0 = 0; d0 < 4; ++d0) qf[d0] = *(const bf16x8*)(qrow + d0 * 16 + (lane >> 5) * 8);
}
__device__ __forceinline__ int next_item(int* head, LAS unsigned char* lds) {
    LAS int* slot = (LAS int*)(lds + AT_FLAG + 128);
    __syncthreads();
    if (threadIdx.x == 0) slot[0] = atomicAdd(head, 1);
    __syncthreads();
    return slot[0];
}

__device__ __forceinline__ void win_item(int item, const bf16_t* NQ, const bf16_t* KW, const bf16_t* VW, const float* NG, float* YPART, LAS unsigned char* lds) {
    const int tid = threadIdx.x, lane = tid & 63, wid = __builtin_amdgcn_readfirstlane(tid >> 6), hi = lane >> 5, q = lane & 31;
    const int qb = item & 127, bg = item >> 7, b = bg >> 1, g = bg & 1;
    const size_t rowbase = (size_t)b * SEQ; const int t0 = qb * 64, tl = wid * 8 + (q >> 2), t = t0 + tl, hq = g * 4 + (q & 3);
    const KVTile kv{KW + rowbase * 128 + g * 64, VW + rowbase * 128 + g * 64, 128};
    bf16x8 qf[4]; load_q(qf, NQ + (rowbase + t) * 512 + hq * 64, lane);
    const int T1 = qb, T0 = (qb >= 8) ? qb - 8 : 0, NT = T1 - T0 + 1;
    f32x16 oT[2]; float m = NEG, l = 0.f;
#pragma unroll
    for (int r = 0; r < 16; ++r) { oT[0][r] = 0.f; oT[1][r] = 0.f; }
    dma_kv(lds, kv, T0 * 64, 0, wid, lane);
    if (NT > 1) dma_kv(lds, kv, (T0 + 1) * 64, 1, wid, lane);
    for (int i = 0; i < NT; ++i) {
        if (i + 1 < NT) { AT_WAIT_BAR(2); } else { AT_WAIT_BAR(0); }
        if (i + 2 < NT) dma_kv(lds, kv, (T0 + i + 2) * 64, (i + 2) % 3, wid, lane);
        const int T = T0 + i, slot = i % 3;
        f32x16 p0, p1; qkt(p0, p1, lds + AT_K + slot * AT_SLOT, qf, lane);
        if (T == T1 || T == qb - 8) {
            const int lo_ = t - 511 - T * 64, hi_ = t - T * 64;
#pragma unroll
            for (int r = 0; r < 16; ++r) { const int k0 = crow(r, hi), k1 = 32 + k0; if (k0 < lo_ || k0 > hi_) p0[r] = NEG; if (k1 < lo_ || k1 > hi_) p1[r] = NEG; }
        }
        softmax_tile(p0, p1, m, l, oT);
        pv(oT, lds + AT_V + slot * AT_SLOT, p0, p1, lane);
    }
    l += swap_get(l);
    const float sc = NG[(rowbase + t) * 24 + hq * 3 + 2] / l;
    float* yp = YPART + (rowbase + t) * 512 + hq * 64;
#pragma unroll
    for (int d0 = 0; d0 < 2; ++d0)
#pragma unroll
        for (int c = 0; c < 4; ++c) *(f32x4*)(yp + d0 * 32 + 8 * c + 4 * hi) = (f32x4){oT[d0][4 * c] * sc, oT[d0][4 * c + 1] * sc, oT[d0][4 * c + 2] * sc, oT[d0][4 * c + 3] * sc};
    asm volatile("s_waitcnt lgkmcnt(0)\n\ts_barrier" ::: "memory");
}

__device__ __forceinline__ void cmpsel_item(int item, const bf16_t* NQ, const bf16_t* KCMP, const bf16_t* VCMP, const bf16_t* KS, const bf16_t* VS, const float* NG,
                                            const float* YPART, bf16_t* YNSA, LAS unsigned char* lds) {
    const int tid = threadIdx.x, lane = tid & 63, wid = __builtin_amdgcn_readfirstlane(tid >> 6), hi = lane >> 5, q = lane & 31;
    const int qb = 127 - (item & 127), bg = item >> 7, b = bg >> 1, g = bg & 1;
    const size_t rowbase = (size_t)b * SEQ; const int t0 = qb * 64, tl = wid * 8 + (q >> 2), t = t0 + tl, hq = g * 4 + (q & 3);
    LAS float* pslc = (LAS float*)(lds + AT_PSLC); LAS unsigned* msk = (LAS unsigned*)(lds + AT_MASK); LAS unsigned* flg = (LAS unsigned*)(lds + AT_FLAG);
    bf16x8 qf[4]; load_q(qf, NQ + (rowbase + t) * 512 + hq * 64, lane);
    const KVTile kvc{KCMP + (size_t)bg * 512 * 64, VCMP + (size_t)bg * 512 * 64, 64};
    const int nv = (t >= 31) ? ((t - 31) >> 4) + 1 : 0;
    const int nvmax = (t0 + 63 >= 31) ? ((t0 + 63 - 31) >> 4) + 1 : 0, NTc = (nvmax + 63) >> 6;
    for (int i = lane; i < 8 * 128; i += 64) pslc[wid * 8 * 128 + i] = 0.f;
    if (tid < 8) flg[tid] = 0u;
    float m = NEG, l = 0.f;
    if (NTc > 0) {
        dma_kv(lds, kvc, 0, 0, wid, lane); if (NTc > 1) dma_kv(lds, kvc, 64, 1, wid, lane);
        for (int i = 0; i < NTc; ++i) {
            if (i + 1 < NTc) { AT_WAIT_BAR(2); } else { AT_WAIT_BAR(0); }
            if (i + 2 < NTc) dma_kv(lds, kvc, (i + 2) * 64, (i + 2) % 3, wid, lane);
            f32x16 p0, p1; qkt(p0, p1, lds + AT_K + (i % 3) * AT_SLOT, qf, lane);
            const int lim = nv - i * 64;
#pragma unroll
            for (int r = 0; r < 16; ++r) { const int k0 = crow(r, hi); if (k0 >= lim) p0[r] = NEG; if (k0 + 32 >= lim) p1[r] = NEG; }
            const float rm = rowmax32(p0, p1);
            if (rm > m) { l *= fexp2(m - rm); m = rm; }
            float s = 0.f;
#pragma unroll
            for (int r = 0; r < 16; ++r) s += fexp2(p0[r] - m) + fexp2(p1[r] - m);
            l += s;
        }
        asm volatile("s_waitcnt lgkmcnt(0)\n\ts_barrier" ::: "memory");
    }
    l += swap_get(l);
    const float inv = (nv > 0) ? 1.f / l : 0.f;
    f32x16 oT[2];
#pragma unroll
    for (int r = 0; r < 16; ++r) { oT[0][r] = 0.f; oT[1][r] = 0.f; }
    if (NTc > 0) {
        dma_kv(lds, kvc, 0, 0, wid, lane); if (NTc > 1) dma_kv(lds, kvc, 64, 1, wid, lane);
        for (int i = 0; i < NTc; ++i) {
            if (i + 1 < NTc) { AT_WAIT_BAR(2); } else { AT_WAIT_BAR(0); }
            if (i + 2 < NTc) dma_kv(lds, kvc, (i + 2) * 64, (i + 2) % 3, wid, lane);
            f32x16 p0, p1; qkt(p0, p1, lds + AT_K + (i % 3) * AT_SLOT, qf, lane);
            const int lim = nv - i * 64;
#pragma unroll
            for (int r = 0; r < 16; ++r) { const int k0 = crow(r, hi); p0[r] = (k0 < lim) ? fexp2(p0[r] - m) * inv : 0.f; p1[r] = (k0 + 32 < lim) ? fexp2(p1[r] - m) * inv : 0.f; }
            pv(oT, lds + AT_V + (i % 3) * AT_SLOT, p0, p1, lane);
#pragma unroll
            for (int kh = 0; kh < 2; ++kh)
#pragma unroll
                for (int c = 0; c < 4; ++c) { const f32x16& p = kh ? p1 : p0;
                    float A = (p[4 * c] + p[4 * c + 1]) + (p[4 * c + 2] + p[4 * c + 3]), Bv = p[4 * c + 3];
                    A += __shfl_xor(A, 1); A += __shfl_xor(A, 2); Bv += __shfl_xor(Bv, 1); Bv += __shfl_xor(Bv, 2);
                    const int j = 16 * i + 8 * kh + 2 * c + hi;
                    if ((q & 3) == 0 && j < 128) { (void)__hip_atomic_fetch_add(&pslc[tl * 128 + j], A, __ATOMIC_RELAXED, __HIP_MEMORY_SCOPE_WORKGROUP); if (j + 1 < 128) (void)__hip_atomic_fetch_add(&pslc[tl * 128 + j + 1], Bv, __ATOMIC_RELAXED, __HIP_MEMORY_SCOPE_WORKGROUP); } }
        }
        asm volatile("s_waitcnt lgkmcnt(0)\n\ts_barrier" ::: "memory");
    }
    const float g_cmp = NG[(rowbase + t) * 24 + hq * 3 + 0];
    f32x16 yc[2];
#pragma unroll
    for (int r = 0; r < 16; ++r) { yc[0][r] = oT[0][r] * g_cmp; yc[1][r] = oT[1][r] * g_cmp; oT[0][r] = 0.f; oT[1][r] = 0.f; }
    asm volatile("s_waitcnt lgkmcnt(0)" ::: "memory");
    unsigned long long ulo = 0ull, uhi = 0ull;
    for (int tk = 0; tk < 8; ++tk) {
        const int row = wid * 8 + tk; const int j0 = lane, j1 = lane + 64;
        const bool f0 = (j0 == 0) || (j0 == qb) || (j0 == qb - 1), f1 = (j1 == qb) || (j1 == qb - 1);
        unsigned long long mlo, mhi;
        if (qb < 16) { mlo = __ballot(j0 <= qb); mhi = 0ull; }
        else {
            const unsigned k0 = (!f0 && j0 <= qb) ? __float_as_uint(pslc[row * 128 + j0]) + 1u : 0u, k1 = (!f1 && j1 <= qb) ? __float_as_uint(pslc[row * 128 + j1]) + 1u : 0u;
            unsigned T = 0u;
            for (int bit = 31; bit >= 0; --bit) { const unsigned cand = T | (1u << bit);
                const int cnt = __popcll(__ballot(k0 >= cand)) + __popcll(__ballot(k1 >= cand)); if (cnt >= 13) T = cand; }
            const bool gt0 = k0 > T, gt1 = k1 > T, eq0 = (k0 == T), eq1 = (k1 == T);
            const unsigned long long be0 = __ballot(eq0), be1 = __ballot(eq1);
            const int rem = 13 - (__popcll(__ballot(gt0)) + __popcll(__ballot(gt1)));
            const unsigned long long below = (lane == 0) ? 0ull : (~0ull >> (64 - lane));
            const int pre0 = __popcll(be0 & below), pre1 = __popcll(be0) + __popcll(be1 & below);
            mlo = __ballot(f0 || gt0 || (eq0 && pre0 < rem)); mhi = __ballot(f1 || gt1 || (eq1 && pre1 < rem));
        }
        ulo |= mlo; uhi |= mhi;
        if (lane == 0) { msk[row * 4 + 0] = (unsigned)mlo; msk[row * 4 + 1] = (unsigned)(mlo >> 32); msk[row * 4 + 2] = (unsigned)mhi; msk[row * 4 + 3] = (unsigned)(mhi >> 32); }
    }
    if (lane == 0) { (void)__hip_atomic_fetch_or(&flg[0], (unsigned)ulo, __ATOMIC_RELAXED, __HIP_MEMORY_SCOPE_WORKGROUP); (void)__hip_atomic_fetch_or(&flg[1], (unsigned)(ulo >> 32), __ATOMIC_RELAXED, __HIP_MEMORY_SCOPE_WORKGROUP);
                     (void)__hip_atomic_fetch_or(&flg[2], (unsigned)uhi, __ATOMIC_RELAXED, __HIP_MEMORY_SCOPE_WORKGROUP); (void)__hip_atomic_fetch_or(&flg[3], (unsigned)(uhi >> 32), __ATOMIC_RELAXED, __HIP_MEMORY_SCOPE_WORKGROUP); }
    asm volatile("s_waitcnt lgkmcnt(0)\n\ts_barrier" ::: "memory");
    const unsigned mk0 = msk[tl * 4 + 0], mk1 = msk[tl * 4 + 1], mk2 = msk[tl * 4 + 2], mk3 = msk[tl * 4 + 3];
    unsigned long long blo = ((unsigned long long)flg[1] << 32) | flg[0], bhi = ((unsigned long long)flg[3] << 32) | flg[2];
    blo = __builtin_amdgcn_readfirstlane((unsigned)blo) | ((unsigned long long)__builtin_amdgcn_readfirstlane((unsigned)(blo >> 32)) << 32);
    bhi = __builtin_amdgcn_readfirstlane((unsigned)bhi) | ((unsigned long long)__builtin_amdgcn_readfirstlane((unsigned)(bhi >> 32)) << 32);
    const KVTile kvs{KS + rowbase * 128 + g * 64, VS + rowbase * 128 + g * 64, 128};
    auto nextbit = [&](int from) -> int {
        if (from < 64) { const unsigned long long x = blo & (~0ull << from); if (x) return __builtin_ctzll(x); from = 64; }
        if (from < 128) { const unsigned long long x = bhi & (~0ull << (from - 64)); if (x) return 64 + __builtin_ctzll(x); }
        return 128; };
    m = NEG; l = 0.f;
    int jc = nextbit(0), jn = nextbit(jc + 1), jnn = (jn < 128) ? nextbit(jn + 1) : 128, i = 0;
    dma_kv(lds, kvs, jc * 64, 0, wid, lane); if (jn < 128) dma_kv(lds, kvs, jn * 64, 1, wid, lane);
    while (jc < 128) {
        if (jn < 128) { AT_WAIT_BAR(2); } else { AT_WAIT_BAR(0); }
        if (jnn < 128) dma_kv(lds, kvs, jnn * 64, (i + 2) % 3, wid, lane);
        const bool wave_needs = (jc < 64) ? ((ulo >> jc) & 1ull) : ((uhi >> (jc - 64)) & 1ull);
        if (wave_needs) {
            const unsigned w = (jc < 32) ? mk0 : (jc < 64) ? mk1 : (jc < 96) ? mk2 : mk3;
            const bool mine = (w >> (jc & 31)) & 1u;
            f32x16 p0, p1; qkt(p0, p1, lds + AT_K + (i % 3) * AT_SLOT, qf, lane);
            const int lim = !mine ? -1 : (jc == qb ? tl : 64);
#pragma unroll
            for (int r = 0; r < 16; ++r) { const int k0 = crow(r, hi); if (k0 > lim) p0[r] = NEG; if (k0 + 32 > lim) p1[r] = NEG; }
            softmax_tile(p0, p1, m, l, oT);
            pv(oT, lds + AT_V + (i % 3) * AT_SLOT, p0, p1, lane);
        }
        jc = jn; jn = jnn; jnn = (jnn < 128) ? nextbit(jnn + 1) : 128; ++i;
    }
    l += swap_get(l);
    const float sc = NG[(rowbase + t) * 24 + hq * 3 + 1] / l;
    const float* yp = YPART + (rowbase + t) * 512 + hq * 64; bf16_t* yo = YNSA + (rowbase + t) * 512 + hq * 64;
#pragma unroll
    for (int d0 = 0; d0 < 2; ++d0)
#pragma unroll
        for (int c = 0; c < 4; ++c) { const f32x4 w = *(const f32x4*)(yp + d0 * 32 + 8 * c + 4 * hi);
            u32x2 o; o.x = cvtpk(w[0] + yc[d0][4 * c] + oT[d0][4 * c] * sc, w[1] + yc[d0][4 * c + 1] + oT[d0][4 * c + 1] * sc);
            o.y = cvtpk(w[2] + yc[d0][4 * c + 2] + oT[d0][4 * c + 2] * sc, w[3] + yc[d0][4 * c + 3] + oT[d0][4 * c + 3] * sc);
            *(u32x2*)(yo + d0 * 32 + 8 * c + 4 * hi) = o; }
    asm volatile("s_waitcnt lgkmcnt(0)\n\ts_barrier" ::: "memory");
}

constexpr float SB_THR = 80.f;
__device__ __forceinline__ void sb_item(int item, const bf16_t* SBQ, const bf16_t* SBK, const bf16_t* SBV, bf16_t* YSB, LAS unsigned char* lds) {
    const int tid = threadIdx.x, lane = tid & 63, wid = __builtin_amdgcn_readfirstlane(tid >> 6), hi = lane >> 5, q = lane & 31;
    const int qblk = 31 - (item & 31), bh = item >> 5, b = bh >> 3, h = bh & 7;
    const size_t rowbase = (size_t)b * SEQ; const int q0 = qblk * 256, tw0 = q0 + 32 * wid, t = tw0 + q;
    LAS unsigned* flg = (LAS unsigned*)(lds + AT_FLAG);
    const KVTile kv{SBK + rowbase * 512 + h * 64, SBV + rowbase * 512 + h * 64, 512};
    bf16x8 qf[4]; load_q(qf, SBQ + (rowbase + t) * 512 + h * 64, lane);
    f32x16 oT[2];
#pragma unroll
    for (int r = 0; r < 16; ++r) { oT[0][r] = 0.f; oT[1][r] = 0.f; }
    float carry = 0.f; bool wdone = false;
    const int Tmax = (q0 + 254) >> 6, NT = Tmax + 1;
    if (tid < 8) flg[tid] = 0u;
    dma_kv(lds, kv, Tmax * 64, 0, wid, lane); if (NT > 1) dma_kv(lds, kv, (Tmax - 1) * 64, 1, wid, lane);
    for (int i = 0; i < NT; ++i) {
        if (i + 1 < NT) { AT_WAIT_BAR(2); } else { AT_WAIT_BAR(0); }
        if ((flg[0] & flg[1] & flg[2] & flg[3] & flg[4] & flg[5] & flg[6] & flg[7]) != 0u) break;
        if (i + 2 < NT) dma_kv(lds, kv, (Tmax - i - 2) * 64, (i + 2) % 3, wid, lane);
        const int T = Tmax - i, slot = i % 3;
        if (!wdone && 64 * T <= tw0 + 30) {
            f32x16 p0, p1; qkt(p0, p1, lds + AT_K + slot * AT_SLOT, qf, lane);
            const int lim = t - 64 * T;
            f32x16 k0v, k1v;
#pragma unroll
            for (int r = 0; r < 16; ++r) {
                const int kl = crow(r, hi);
                { const float z = p0[r]; const float sp = fmaxf(z, 0.f) + flog2(1.f + fexp2(-fabsf(z))); const bool v = kl < lim; k0v[r] = v ? -sp : 0.f; p0[r] = v ? z - sp : NEG; }
                { const float z = p1[r]; const float sp = fmaxf(z, 0.f) + flog2(1.f + fexp2(-fabsf(z))); const bool v = kl + 32 < lim; k1v[r] = v ? -sp : 0.f; p1[r] = v ? z - sp : NEG; }
            }
            float R = carry;
#pragma unroll
            for (int kh = 1; kh >= 0; --kh)
#pragma unroll
                for (int c = 3; c >= 0; --c) { const f32x16& kk = kh ? k1v : k0v; f32x16& pp = kh ? p1 : p0;
                    const float G = (kk[4 * c] + kk[4 * c + 1]) + (kk[4 * c + 2] + kk[4 * c + 3]); const float PG = swap_get(G);
                    const float S = R + (hi ? 0.f : PG);
                    const float w2 = kk[4 * c + 3], w1 = w2 + kk[4 * c + 2], w0 = w1 + kk[4 * c + 1];
                    pp[4 * c + 3] = fexp2(pp[4 * c + 3] + S); pp[4 * c + 2] = fexp2(pp[4 * c + 2] + S + w2); pp[4 * c + 1] = fexp2(pp[4 * c + 1] + S + w1); pp[4 * c] = fexp2(pp[4 * c] + S + w0);
                    R += G + PG; }
            carry = R;
            pv(oT, lds + AT_V + slot * AT_SLOT, p0, p1, lane);
            wdone = __all(carry < -SB_THR) || (T == 0);
            if (wdone && lane == 0) flg[wid] = 1u;
        }
    }
    asm volatile("s_waitcnt vmcnt(0) lgkmcnt(0)\n\ts_barrier" ::: "memory");
    bf16_t* yo = YSB + (rowbase + t) * 512 + h * 64;
#pragma unroll
    for (int d0 = 0; d0 < 2; ++d0)
#pragma unroll
        for (int c = 0; c < 4; ++c) { u32x2 o; o.x = cvtpk(oT[d0][4 * c], oT[d0][4 * c + 1]); o.y = cvtpk(oT[d0][4 * c + 2], oT[d0][4 * c + 3]); *(u32x2*)(yo + d0 * 32 + 8 * c + 4 * hi) = o; }
    asm volatile("s_waitcnt lgkmcnt(0)\n\ts_barrier" ::: "memory");
}

__device__ __forceinline__ void compress_wave(int witem, const bf16_t* src, const bf16_t* wt1, const bf16_t* w2t, const float* c1, bf16_t* out, int lane) {
    const int rb = witem & 15, bg = witem >> 4, b = bg >> 1, g = bg & 1, hi = lane >> 5, li = lane & 31;
    const int i = rb * 32 + li;
    const bool valid = i < NCMP;
    const bf16_t* xrow = src + ((size_t)b * SEQ + 16 * (valid ? i : 0)) * 128 + g * 64;
    f32x16 hT[2];
#pragma unroll
    for (int r = 0; r < 16; ++r) { hT[0][r] = 0.f; hT[1][r] = 0.f; }
#pragma unroll 4
    for (int s = 0; s < 128; ++s) {
        const int k = 16 * s + 8 * hi;
        const bf16x8 xb = *(const bf16x8*)(xrow + (size_t)(k >> 6) * 128 + (k & 63));
        const bf16x8 a0 = *(const bf16x8*)(wt1 + (size_t)li * 2048 + k), a1 = *(const bf16x8*)(wt1 + (size_t)(32 + li) * 2048 + k);
        hT[0] = __builtin_amdgcn_mfma_f32_32x32x16_bf16(a0, xb, hT[0], 0, 0, 0);
        hT[1] = __builtin_amdgcn_mfma_f32_32x32x16_bf16(a1, xb, hT[1], 0, 0, 0);
    }
    bf16x8 hb[4];
#pragma unroll
    for (int nb = 0; nb < 2; ++nb)
#pragma unroll
        for (int sh = 0; sh < 2; ++sh) { float v[8];
#pragma unroll
            for (int j = 0; j < 8; ++j) { const int r = 8 * sh + j; const float a = hT[nb][r] + c1[32 * nb + crow(r, hi)];
                const float c = 0.7978845608028654f * (a + 0.044715f * a * a * a); const float e = __expf(2.f * c); const float th = 1.f - 2.f / (e + 1.f); v[j] = 0.5f * a * (1.f + th); }
            u32x4 w; w.x = cvtpk(v[0], v[1]); w.y = cvtpk(v[2], v[3]); w.z = cvtpk(v[4], v[5]); w.w = cvtpk(v[6], v[7]); hb[nb * 2 + sh] = __builtin_bit_cast(bf16x8, w); }
    f32x16 oT[2];
#pragma unroll
    for (int r = 0; r < 16; ++r) { oT[0][r] = 0.f; oT[1][r] = 0.f; }
#pragma unroll
    for (int mb = 0; mb < 2; ++mb)
#pragma unroll
        for (int ks = 0; ks < 4; ++ks) {
            const bf16_t* wp = w2t + (size_t)(32 * mb + li) * 64 + 16 * ks + 4 * hi;
            const u32x2 lo = *(const u32x2*)wp, hh = *(const u32x2*)(wp + 8);
            const u32x4 w = {lo.x, lo.y, hh.x, hh.y};
            oT[mb] = __builtin_amdgcn_mfma_f32_32x32x16_bf16(__builtin_bit_cast(bf16x8, w), hb[ks], oT[mb], 0, 0, 0);
        }
    bf16_t* op = out + ((size_t)bg * 512 + i) * 64;
#pragma unroll
    for (int mb = 0; mb < 2; ++mb)
#pragma unroll
        for (int c = 0; c < 4; ++c) { u32x2 o; o.x = valid ? cvtpk(oT[mb][4 * c], oT[mb][4 * c + 1]) : 0u; o.y = valid ? cvtpk(oT[mb][4 * c + 2], oT[mb][4 * c + 3]) : 0u;
            *(u32x2*)(op + 32 * mb + 8 * c + 4 * hi) = o; }
}

struct AttnArgs { const bf16_t* sbq; const bf16_t* sbk; const bf16_t* sbv; const bf16_t* nq; const bf16_t* kv6; const float* ng; bf16_t* kcmp; bf16_t* vcmp;
                  bf16_t* ysb; bf16_t* ynsa; float* ypart; const bf16_t* wt1k; const bf16_t* wt1v; const bf16_t* w2tk; const bf16_t* w2tv; const float* c1k; const float* c1v; int* qhead; };
__device__ __forceinline__ void attn_phase1(const AttnArgs& a, LAS unsigned char* lds) {
    const size_t S128 = (size_t)NTOK * 128; const int lane = threadIdx.x & 63, wid = __builtin_amdgcn_readfirstlane(threadIdx.x >> 6);
    for (;;) {
        const int it = next_item(a.qhead, lds);
        if (it >= 64 + 2048 + 2048) break;
        if (it < 64) { const int w = it * 8 + wid;
            if (w < 256) compress_wave(w, a.kv6 + 0 * S128, a.wt1k, a.w2tk, a.c1k, a.kcmp, lane); else compress_wave(w - 256, a.kv6 + 1 * S128, a.wt1v, a.w2tv, a.c1v, a.vcmp, lane); }
        else if (it < 64 + 2048) sb_item(it - 64, a.sbq, a.sbk, a.sbv, a.ysb, lds);
        else win_item(it - 64 - 2048, a.nq, a.kv6 + 4 * S128, a.kv6 + 5 * S128, a.ng, a.ypart, lds);
    }
}
__device__ __forceinline__ void attn_phase2(const AttnArgs& a, LAS unsigned char* lds) {
    const size_t S128 = (size_t)NTOK * 128;
    for (;;) {
        const int it = next_item(a.qhead + 64, lds);
        if (it >= 2048) break;
        const int qbi = it >> 4, bg = it & 15;
        cmpsel_item((bg << 7) | qbi, a.nq, a.kcmp, a.vcmp, a.kv6 + 2 * S128, a.kv6 + 3 * S128, a.ng, a.ypart, a.ynsa, lds);
    }
}
typedef float f32x4v __attribute__((ext_vector_type(4)));
__device__ __forceinline__ void router_phase(const float* U, const float* g1, const float* b1, const float* wr, const float* br, float* H1S, bf16_t* H1B,
                                             int* cnt, int* list, float* topw, int* tope, int* spos, LAS unsigned char* lds, int vcu, int G) {
    const int tid = threadIdx.x, lane = tid & 63, wave = __builtin_amdgcn_readfirstlane(tid >> 6), r = lane & 15, kq = lane >> 4;
    LAS float* W = (LAS float*)lds;
    LAS float* stg = (LAS float*)(lds + 131072 + wave * 2048);
    for (int i = tid; i < 1024 * 8; i += NTHREADS) { const int k = i >> 3, c4 = (i & 7) * 4; const f32x4 v = *(const f32x4*)(wr + k * 32 + c4);
        *(LAS f32x4*)(W + k * 32 + (c4 ^ (((k >> 3) & 1) << 4))) = v; }
    __syncthreads();
    const int sw = (kq & 1) << 4;
    for (int grp = vcu * NWAVES + wave; grp < NTOK / 16; grp += G * NWAVES) {
        const int tok = grp * 16 + r; const float* up = U + (size_t)tok * DM + 8 * kq;
        float s = 0.f, s2 = 0.f;
#pragma unroll 8
        for (int st = 0; st < 32; ++st) { const f32x4 a = *(const f32x4*)(up + 32 * st), b = *(const f32x4*)(up + 32 * st + 4);
            s += (a[0] + a[1]) + (a[2] + a[3]) + (b[0] + b[1]) + (b[2] + b[3]);
            s2 += (a[0] * a[0] + a[1] * a[1]) + (a[2] * a[2] + a[3] * a[3]) + (b[0] * b[0] + b[1] * b[1]) + (b[2] * b[2] + b[3] * b[3]); }
        s += __shfl_xor(s, 16); s += __shfl_xor(s, 32); s2 += __shfl_xor(s2, 16); s2 += __shfl_xor(s2, 32);
        const float mean = s * (1.f / DM); const float var = fmaxf(s2 * (1.f / DM) - mean * mean, 0.f); const float rstd = 1.f / sqrtf(var + LN_EPS);
        f32x4v acc0 = {0.f, 0.f, 0.f, 0.f}, acc1 = {0.f, 0.f, 0.f, 0.f};
#pragma unroll 2
        for (int st = 0; st < 32; ++st) {
            const int k0 = 32 * st + 8 * kq;
            const f32x4 a = *(const f32x4*)(up + 32 * st), b = *(const f32x4*)(up + 32 * st + 4);
            const f32x4 ga = *(const f32x4*)(g1 + k0), gb = *(const f32x4*)(g1 + k0 + 4), ba = *(const f32x4*)(b1 + k0), bb = *(const f32x4*)(b1 + k0 + 4);
            const f32x4 ha = (a - mean) * rstd * ga + ba, hb = (b - mean) * rstd * gb + bb;
            *(f32x4*)(H1S + (size_t)tok * DM + k0) = ha * ALPHA; *(f32x4*)(H1S + (size_t)tok * DM + k0 + 4) = hb * ALPHA;
            u32x4 w; w.x = pk2(ha[0], ha[1]); w.y = pk2(ha[2], ha[3]); w.z = pk2(hb[0], hb[1]); w.w = pk2(hb[2], hb[3]);
            *(u32x4*)(H1B + (size_t)tok * DM + k0) = w;
            const LAS float* wp = W + k0 * 32;
#pragma unroll
            for (int j = 0; j < 8; ++j) { const float hv = (j < 4) ? ha[j & 3] : hb[j & 3];
                const float w0 = wp[j * 32 + (r ^ sw)], w1 = wp[j * 32 + ((r + 16) ^ sw)];
                acc0 = __builtin_amdgcn_mfma_f32_16x16x4f32(hv, w0, acc0, 0, 0, 0); acc1 = __builtin_amdgcn_mfma_f32_16x16x4f32(hv, w1, acc1, 0, 0, 0); }
        }
        const float bi0 = br[r], bi1 = br[16 + r];
#pragma unroll
        for (int q = 0; q < 4; ++q) { stg[(4 * kq + q) * 32 + r] = acc0[q] + bi0; stg[(4 * kq + q) * 32 + 16 + r] = acc1[q] + bi1; }
        asm volatile("s_waitcnt lgkmcnt(0)" ::: "memory");
        if (lane < 16) {
            float v[32];
#pragma unroll
            for (int e = 0; e < 32; e += 4) { const f32x4 x = *(const LAS f32x4*)(stg + lane * 32 + e); v[e] = x[0]; v[e + 1] = x[1]; v[e + 2] = x[2]; v[e + 3] = x[3]; }
            float tv[4]; int ti[4];
#pragma unroll
            for (int k = 0; k < 4; ++k) { float bv = -INFINITY; int bi = 0;
#pragma unroll
                for (int e = 0; e < 32; ++e) { if (v[e] > bv) { bv = v[e]; bi = e; } }
                tv[k] = bv; ti[k] = bi;
#pragma unroll
                for (int e = 0; e < 32; ++e) if (e == bi) v[e] = -INFINITY; }
            const float e1 = expf(tv[1] - tv[0]), e2 = expf(tv[2] - tv[0]), e3 = expf(tv[3] - tv[0]); const float inv = 1.f / (1.f + e1 + e2 + e3);
            const float wv[4] = {inv, e1 * inv, e2 * inv, e3 * inv};
            const int tk = grp * 16 + lane;
#pragma unroll
            for (int k = 0; k < 4; ++k) { const int slot = tk * 4 + k; topw[slot] = wv[k]; tope[slot] = ti[k];
                const int pos = atomicAdd(&cnt[ti[k]], 1); list[(size_t)ti[k] * NTOK + pos] = slot; spos[slot] = pos; }
        }
        asm volatile("s_waitcnt lgkmcnt(0)" ::: "memory");
    }
}
#include <hip/hip_cooperative_groups.h>
namespace cg = cooperative_groups;
struct MegaArgs {
    const float* pe_k; const float* w1_k; const float* w2_k; const float* pe_v; const float* w1_v; const float* w2_v;
    const float* x; const float* w_in; const float* w_sb; const float* w_nsa; const float* w_out; const float* w_gu; const float* w_dn;
    const float* b_gu; const float* b_dn; const float* ln1g; const float* ln1b; const float* w_r; const float* b_r; const float* ln2g; const float* ln2b;
    float* out; unsigned char* ws; int ph_lo, ph_hi;
};
__device__ __forceinline__ void combine_phase(const MegaArgs& A, LAS unsigned char* lds, int round, bool last, int vcu, int G) {
    unsigned char* ws = A.ws; float* Y = A.out; const bf16_t* outr = (const bf16_t*)(ws + WS_OUTR);
    const int* tope = (const int*)(ws + WS_TOPE); const int* spos = (const int*)(ws + WS_SPOS); const float* topw = (const float*)(ws + WS_TOPW);
    const LAS int* tstart = (const LAS int*)(lds + LDS_MISC);
    const int tid = threadIdx.x, lane = tid & 63, wave = tid >> 6;
    for (int tok = vcu * NWAVES + wave; tok < NTOK; tok += G * NWAVES) {
        float* yr = Y + (size_t)tok * DM + lane * 8;
        f32x4 v[2][2];
#pragma unroll
        for (int j = 0; j < 2; ++j) { v[j][0] = *(const f32x4*)(yr + 512 * j); v[j][1] = *(const f32x4*)(yr + 512 * j + 4); }
        bool any = false;
#pragma unroll
        for (int k = 0; k < 4; ++k) {
            const int slot = tok * 4 + k; const int e = tope[slot], pos = spos[slot]; const int tile = tstart[e] + (pos >> 8);
            if (tile / TR == round) { any = true; const float w = topw[slot]; const bf16_t* rp = outr + ((size_t)(tile - round * TR) * 256 + (pos & 255)) * DM + lane * 8;
#pragma unroll
                for (int j = 0; j < 2; ++j) { const u32x4 q = *(const u32x4*)(rp + 512 * j);
                    v[j][0][0] += w * bflo(q.x); v[j][0][1] += w * bfhi(q.x); v[j][0][2] += w * bflo(q.y); v[j][0][3] += w * bfhi(q.y);
                    v[j][1][0] += w * bflo(q.z); v[j][1][1] += w * bfhi(q.z); v[j][1][2] += w * bflo(q.w); v[j][1][3] += w * bfhi(q.w); } }
        }
        if (last) {
            float s = 0.f;
#pragma unroll
            for (int j = 0; j < 2; ++j) s += (v[j][0][0] + v[j][0][1]) + (v[j][0][2] + v[j][0][3]) + (v[j][1][0] + v[j][1][1]) + (v[j][1][2] + v[j][1][3]);
            const float mean = wave_sum(s) * (1.f / DM); float s2 = 0.f;
#pragma unroll
            for (int j = 0; j < 2; ++j) { v[j][0] = v[j][0] - mean; v[j][1] = v[j][1] - mean;
                s2 += (v[j][0][0] * v[j][0][0] + v[j][0][1] * v[j][0][1]) + (v[j][0][2] * v[j][0][2] + v[j][0][3] * v[j][0][3]) + (v[j][1][0] * v[j][1][0] + v[j][1][1] * v[j][1][1]) + (v[j][1][2] * v[j][1][2] + v[j][1][3] * v[j][1][3]); }
            const float rstd = 1.f / sqrtf(wave_sum(s2) * (1.f / DM) + LN_EPS);
#pragma unroll
            for (int j = 0; j < 2; ++j) { const int c = lane * 8 + 512 * j;
                *(f32x4*)(yr + 512 * j) = v[j][0] * rstd * *(const f32x4*)(A.ln2g + c) + *(const f32x4*)(A.ln2b + c);
                *(f32x4*)(yr + 512 * j + 4) = v[j][1] * rstd * *(const f32x4*)(A.ln2g + c + 4) + *(const f32x4*)(A.ln2b + c + 4); }
        } else if (any) {
#pragma unroll
            for (int j = 0; j < 2; ++j) { *(f32x4*)(yr + 512 * j) = v[j][0]; *(f32x4*)(yr + 512 * j + 4) = v[j][1]; }
        }
    }
}
enum { PH_PREP = 0, PH_INPROJ, PH_ATT1, PH_ATT2, PH_MERGE, PH_OUT, PH_ROUTER, PH_GU0, PH_DN0, PH_GU1, PH_DN1, PH_FIN, PH_N };
__global__ void __launch_bounds__(NTHREADS, 2) k_mega(MegaArgs A) {
    extern __shared__ __attribute__((aligned(16))) unsigned char lds_[];
    LAS unsigned char* lds = (LAS unsigned char*)lds_;
    cg::grid_group grid = cg::this_grid();
    const int G = gridDim.x, bx = blockIdx.x; const int vcu = (G % 8 == 0) ? (bx % 8) * (G / 8) + bx / 8 : bx;
    unsigned char* ws = A.ws;
    int* ctl = (int*)(ws + WS_CTL); float* ropeT = (float*)(ws + WS_ROPE);
    bf16_t* wt_gu = (bf16_t*)(ws + WS_WGU); bf16_t* wt_dn = (bf16_t*)(ws + WS_WDN); bf16_t* wt_in = (bf16_t*)(ws + WS_WIN);
    bf16_t* wt_sb = (bf16_t*)(ws + WS_WSB); bf16_t* wt_nsa = (bf16_t*)(ws + WS_WNSA); bf16_t* wt_out = (bf16_t*)(ws + WS_WOUT);
    bf16_t* xb = (bf16_t*)(ws + WS_XB); bf16_t* sbq = (bf16_t*)(ws + WS_SBQ); bf16_t* sbk = (bf16_t*)(ws + WS_SBK); bf16_t* sbv = (bf16_t*)(ws + WS_SBV);
    bf16_t* nq = (bf16_t*)(ws + WS_NQ); bf16_t* kv6 = (bf16_t*)(ws + WS_KV6); float* ng = (float*)(ws + WS_NG);
    bf16_t* ysb = (bf16_t*)(ws + WS_YSB); bf16_t* ynsa = (bf16_t*)(ws + WS_YNSA);
    bf16_t* mg = (bf16_t*)A.out; bf16_t* merged = (bf16_t*)(ws + WS_MERGED); float* u = (float*)(ws + WS_U); bf16_t* h1b = (bf16_t*)(ws + WS_H1B);
    int* list = (int*)(ws + WS_LIST); bf16_t* hid = (bf16_t*)(ws + WS_HID); bf16_t* outr = (bf16_t*)(ws + WS_OUTR);
    const int lo = A.ph_lo, hi = A.ph_hi;
#define IN(k) (lo <= (k) && (k) < hi)
#define SEAM(k) do { if (IN(k) && IN((k) + 1)) grid.sync(); } while (0)
    if (IN(PH_PREP)) {
        PrepArgs a{A.x, A.w_in, A.w_sb, A.w_nsa, A.w_out, A.w_gu, A.w_dn, wt_in, wt_sb, wt_nsa, wt_out, wt_gu, wt_dn, xb, ng, ropeT, A.pe_k, A.w1_k, A.w2_k, A.pe_v, A.w1_v, A.w2_v, ws + WS_CMPW};
        prep_phase(a, lds, vcu, G);
    }
    SEAM(PH_PREP);
    if (IN(PH_INPROJ)) {
        EpiInProj E{sbq, sbk, sbv, nq, kv6, mg, ropeT, ropeT + SEQ * 32};
        pg8::Gemm g{xb, wt_in, DM, 0}; pg8::StaticOrder S; S.init(NTOK, 4864, G, bx);
        pg8::gemm_phase<EpiInProj, pg8::StaticOrder, true, false>(lds, g, S, E);
    }
    SEAM(PH_INPROJ);
    const AttnArgs AA{sbq, sbk, sbv, nq, kv6, ng, (bf16_t*)(ws + WS_KCMP), (bf16_t*)(ws + WS_VCMP), ysb, ynsa, (float*)(ws + WS_YPART),
                      (const bf16_t*)(ws + WS_CMPW + CW_WT1K), (const bf16_t*)(ws + WS_CMPW + CW_WT1V), (const bf16_t*)(ws + WS_CMPW + CW_W2TK), (const bf16_t*)(ws + WS_CMPW + CW_W2TV),
                      (const float*)(ws + WS_CMPW + CW_C1K), (const float*)(ws + WS_CMPW + CW_C1V), ctl + CT_Q};
    if (IN(PH_ATT1)) attn_phase1(AA, lds);
    SEAM(PH_ATT1);
    if (IN(PH_ATT2)) attn_phase2(AA, lds);
    SEAM(PH_ATT2);
    if (IN(PH_MERGE)) {
        pg8::StaticOrder S; S.init(NTOK, DM, G, bx);
        { pg8::Gemm g{ysb, wt_sb, 512, 0}; EpiMerge E0{mg, merged, 0, 0}; pg8::gemm_phase<EpiMerge, pg8::StaticOrder, true, false>(lds, g, S, E0); }
        asm volatile("s_waitcnt vmcnt(0)" ::: "memory"); __syncthreads();
        { pg8::Gemm g{ynsa, wt_nsa, 512, 0}; EpiMerge E1{mg, merged, 1, 0}; pg8::gemm_phase<EpiMerge, pg8::StaticOrder, true, false>(lds, g, S, E1); }
    }
    SEAM(PH_MERGE);
    if (IN(PH_OUT)) {
        EpiOut E{A.x, u}; pg8::Gemm g{merged, wt_out, DM, 0}; pg8::StaticOrder S; S.init(NTOK, DM, G, bx);
        pg8::gemm_phase<EpiOut, pg8::StaticOrder, true, false>(lds, g, S, E);
    }
    SEAM(PH_OUT);
    if (IN(PH_ROUTER)) router_phase(u, A.ln1g, A.ln1b, A.w_r, A.b_r, A.out, h1b, ctl + CT_CNT, list, (float*)(ws + WS_TOPW), (int*)(ws + WS_TOPE), (int*)(ws + WS_SPOS), lds, vcu, G);
    SEAM(PH_ROUTER);
    if (hi > PH_GU0) { __syncthreads(); moe_build_table(lds, ctl + CT_CNT); }
    if (IN(PH_GU0)) { EpiGateUp E{A.b_gu, hid}; pg8::Gemm g{h1b, wt_gu, DM, 0}; MoeOrder<8> S; S.init(lds, list, 0, G, bx); pg8::gemm_phase<EpiGateUp, MoeOrder<8>, true, true>(lds, g, S, E); }
    SEAM(PH_GU0);
    if (IN(PH_DN0)) { EpiDown E{A.b_dn, outr}; pg8::Gemm g{hid, wt_dn, DFF, 0}; MoeOrder<4> S; S.init(lds, list, 0, G, bx); pg8::gemm_phase<EpiDown, MoeOrder<4>, true, false>(lds, g, S, E); }
    SEAM(PH_DN0);
    if (IN(PH_GU1)) {
        { EpiGateUp E{A.b_gu, hid}; pg8::Gemm g{h1b, wt_gu, DM, 0}; MoeOrder<8> S; S.init(lds, list, 1, G, bx); pg8::gemm_phase<EpiGateUp, MoeOrder<8>, true, true>(lds, g, S, E); }
        combine_phase(A, lds, 0, false, vcu, G);
    }
    SEAM(PH_GU1);
    if (IN(PH_DN1)) { EpiDown E{A.b_dn, outr}; pg8::Gemm g{hid, wt_dn, DFF, 0}; MoeOrder<4> S; S.init(lds, list, 1, G, bx); pg8::gemm_phase<EpiDown, MoeOrder<4>, true, false>(lds, g, S, E); }
    SEAM(PH_DN1);
    if (IN(PH_FIN)) combine_phase(A, lds, 1, true, vcu, G);
#undef IN
#undef SEAM
}

extern "C" void kernel_launch(void* const* d_in, const int* in_sizes, int n_in, void* d_out, int out_size, void* d_ws, size_t ws_size, hipStream_t stream) {
    const float* x = (const float*)d_in[0]; const float* w_in = (const float*)d_in[1];
    const float* pe_k = (const float*)d_in[2]; const float* w1_k = (const float*)d_in[3]; const float* w2_k = (const float*)d_in[4];
    const float* pe_v = (const float*)d_in[5]; const float* w1_v = (const float*)d_in[6]; const float* w2_v = (const float*)d_in[7];
    char* ws = (char*)d_ws; float* out = (float*)d_out;
    static int grid = 0;
    if (grid == 0) {
        int dev = 0, cus = 0, per_cu = 0; (void)hipGetDevice(&dev); (void)hipDeviceGetAttribute(&cus, hipDeviceAttributeMultiprocessorCount, dev);
        (void)hipFuncSetAttribute((const void*)k_mega, hipFuncAttributeMaxDynamicSharedMemorySize, LDS_BYTES);
        (void)hipOccupancyMaxActiveBlocksPerMultiprocessor(&per_cu, (const void*)k_mega, NTHREADS, LDS_BYTES);
        if (per_cu < 1) per_cu = 1;
        grid = (cus > 0 ? cus : 256) * 1;
        (void)hipGetLastError();
    }
    MegaArgs A{};
    A.pe_k = pe_k; A.w1_k = w1_k; A.w2_k = w2_k; A.pe_v = pe_v; A.w1_v = w1_v; A.w2_v = w2_v;
    A.x = x; A.w_in = w_in; A.w_sb = (const float*)d_in[8]; A.w_nsa = (const float*)d_in[9]; A.w_out = (const float*)d_in[10];
    A.ln1g = (const float*)d_in[11]; A.ln1b = (const float*)d_in[12]; A.w_r = (const float*)d_in[13]; A.b_r = (const float*)d_in[14];
    A.w_gu = (const float*)d_in[15]; A.b_gu = (const float*)d_in[16]; A.w_dn = (const float*)d_in[17]; A.b_dn = (const float*)d_in[18];
    A.ln2g = (const float*)d_in[19]; A.ln2b = (const float*)d_in[20]; A.out = out; A.ws = (unsigned char*)d_ws;
    int* ctl = (int*)(ws + WS_CTL);
    bf16_t* sbq = (bf16_t*)(ws + WS_SBQ); bf16_t* sbk = (bf16_t*)(ws + WS_SBK); bf16_t* sbv = (bf16_t*)(ws + WS_SBV);
    bf16_t* nq = (bf16_t*)(ws + WS_NQ); bf16_t* kv6 = (bf16_t*)(ws + WS_KV6); float* ng = (float*)(ws + WS_NG);
    bf16_t* kcmp = (bf16_t*)(ws + WS_KCMP); bf16_t* vcmp = (bf16_t*)(ws + WS_VCMP);
    bf16_t* ysb = (bf16_t*)(ws + WS_YSB); bf16_t* ynsa = (bf16_t*)(ws + WS_YNSA);
    float* u = (float*)(ws + WS_U); bf16_t* h1b = (bf16_t*)(ws + WS_H1B);
    int* tope = (int*)(ws + WS_TOPE); float* topw = (float*)(ws + WS_TOPW); int* spos = (int*)(ws + WS_SPOS); int* list = (int*)(ws + WS_LIST);
    const size_t S128 = (size_t)NTOK * 128;
    auto launch = [&](int lo, int hi) { A.ph_lo = lo; A.ph_hi = hi; void* args[] = {&A};
        (void)hipLaunchCooperativeKernel((const void*)k_mega, dim3(grid), dim3(NTHREADS), args, LDS_BYTES, stream); };
    (void)hipMemsetAsync(ctl, 0, 1 * MiB, stream);
    launch(PH_PREP, PH_N);
}
```

```cpp
#include <hip/hip_runtime.h>
#include <stdint.h>
#include <math.h>
constexpr int NB = 8, SEQ = 8192, DM = 1024, NTOK = NB * SEQ;
constexpr int IN_W = 4888;
constexpr int C_NG = 2816, C_MG = 2840;
constexpr int NEXP = 32, TOPK = 4, DFF = 1024;
constexpr int NCMP = 511;
constexpr float ALPHA = 1.189207115002721f;
constexpr float LN_EPS = 1e-5f;
constexpr float LOG2E = 1.4426950408889634f;
constexpr float C2 = 0.125f * LOG2E;
constexpr int NTILE_MAX = NTOK * TOPK / 256 + NEXP;
constexpr int NROUND = 2, TR = 512, TR1MAX = NTILE_MAX - TR;
constexpr int NWAVES = 8, NTHREADS = 512;

typedef float f32x16 __attribute__((ext_vector_type(16)));
typedef float f32x4 __attribute__((ext_vector_type(4)));
typedef float f32x2 __attribute__((ext_vector_type(2)));
typedef unsigned u32x4 __attribute__((ext_vector_type(4)));
typedef unsigned u32x2 __attribute__((ext_vector_type(2)));
typedef unsigned short bf16_t;
#define LAS __attribute__((address_space(3)))

__device__ __forceinline__ unsigned f2bf(float f) { unsigned u = __builtin_bit_cast(unsigned, f); return (u + 0x7fffu + ((u >> 16) & 1u)) >> 16; }
__device__ __forceinline__ unsigned pk2(float lo, float hi) { return f2bf(lo) | (f2bf(hi) << 16); }
__device__ __forceinline__ float bf2f(unsigned h) { return __builtin_bit_cast(float, h << 16); }
__device__ __forceinline__ float bflo(unsigned w) { return __builtin_bit_cast(float, w << 16); }
__device__ __forceinline__ float bfhi(unsigned w) { return __builtin_bit_cast(float, w & 0xffff0000u); }
__device__ __forceinline__ float sigmoidf_(float x) { return __builtin_amdgcn_rcpf(1.f + __expf(-x)); }
__device__ __forceinline__ float wave_sum(float v) {
#pragma unroll
    for (int o = 1; o < 64; o <<= 1) v += __shfl_xor(v, o);
    return v;
}

constexpr size_t MiB = 1u << 20;
constexpr size_t WS_CTL = 0;
constexpr size_t WS_ROPE = 1 * MiB;
constexpr size_t WS_WGU = 3 * MiB;
constexpr size_t WS_WDN = 131 * MiB;
constexpr size_t WS_WIN = 195 * MiB;
constexpr size_t WS_WSB = 205 * MiB;
constexpr size_t WS_WNSA = 206 * MiB;
constexpr size_t WS_WOUT = 207 * MiB;
constexpr size_t WS_CMPW = 209 * MiB;
constexpr size_t WS_XB = 210 * MiB;
constexpr size_t WS_SBQ = 338 * MiB, WS_SBK = 402 * MiB, WS_SBV = 466 * MiB, WS_NQ = 530 * MiB;
constexpr size_t WS_KV6 = 594 * MiB;
constexpr size_t WS_NG = 690 * MiB;
constexpr size_t WS_KCMP = 696 * MiB, WS_VCMP = 697 * MiB;
constexpr size_t WS_MASK = 698 * MiB;
constexpr size_t WS_YSB = 700 * MiB, WS_YNSA = 764 * MiB;
constexpr size_t WS_YPART = 828 * MiB;
constexpr size_t WS_MERGED = 210 * MiB;
constexpr size_t WS_U = 338 * MiB;
constexpr size_t WS_STATS = 1014 * MiB;
constexpr size_t WS_H1B = 594 * MiB;
constexpr size_t WS_TOPE = 1010 * MiB, WS_TOPW = 1011 * MiB, WS_SPOS = 1012 * MiB;
constexpr size_t WS_MR = 1013 * MiB;
constexpr size_t WS_LIST = 722 * MiB;
constexpr size_t WS_HID = 210 * MiB;
constexpr size_t WS_OUTR0 = 754 * MiB;
constexpr size_t WS_OUTR1 = 482 * MiB;
constexpr int CT_CNT = 0;
constexpr int CT_Q = 64;
constexpr int CT_C1 = 3072;
constexpr int CT_BAR = 4096;
namespace pg8 {
#define PG8_LAS __attribute__((address_space(3)))
typedef unsigned short bf16_t;
typedef short bf16x8 __attribute__((ext_vector_type(8)));
typedef float f32x4 __attribute__((ext_vector_type(4)));
typedef unsigned u32x4 __attribute__((ext_vector_type(4)));
constexpr int BM = 256, BK = 64, HALF = 128, HTB = HALF * BK * 2, STAGE_BYTES = 8 * HTB, NXCD = 8, WGM = 8;
__host__ __device__ __forceinline__ int lds_byte(int r, int c) { const int st = (r >> 4) * 2 + (c >> 5), rr = r & 15, cc = c & 31, ob = rr * 64 + cc * 2; return st * 1024 + (ob ^ (((ob >> 9) & 1) << 5)); }
__host__ __device__ __forceinline__ void stage_rc(int b, int& R, int& C) { const int st = b / 1024, sb = b % 1024, swz = sb ^ (((sb >> 9) & 1) << 5); R = (st >> 1) * 16 + swz / 64; C = (st & 1) * 32 + (swz % 64) / 2; }
__host__ __device__ __forceinline__ int perm32(int rho) { const int n = rho >> 4, i = rho & 15; return 8 * (i >> 2) + 4 * n + (i & 3); }
struct Unit { int pm, pn, e, r0; };
struct Gemm { const bf16_t* A; const bf16_t* Bt; int K; int pad; };
struct StaticOrder {
    int nM, nN, nwg, G, c;
    __host__ __device__ void init(int M, int N, int G_, int c_) { nM = M / BM; nN = N / BM; nwg = nM * nN; G = G_; c = c_; }
    __host__ __device__ bool next(int i, Unit& u) const {
        const long L = (long)i * G + c; if (L >= nwg) return false;
        int wgid = (int)L; { const int q = nwg / NXCD, r = nwg % NXCD, xcd = wgid % NXCD, off = wgid / NXCD; wgid = (xcd < r ? xcd * (q + 1) : r * (q + 1) + (xcd - r) * q) + off; }
        const int nig = WGM * nN, gid = wgid / nig, fm = gid * WGM, gsz = (nM - fm) < WGM ? (nM - fm) : WGM;
        u.pm = fm + ((wgid % nig) % gsz); u.pn = (wgid % nig) / gsz; u.e = 0; u.r0 = 0; return true;
    }
    __device__ __forceinline__ unsigned row_off(const Unit&, int) const { return 0u; }
    __device__ __forceinline__ void row_off4(const Unit&, int, int, unsigned (&ro)[2][2]) const { ro[0][0] = ro[0][1] = ro[1][0] = ro[1][1] = 0u; }
};
__device__ __forceinline__ unsigned cvt_pk_bf16(float lo, float hi) { typedef float f2_ __attribute__((ext_vector_type(2))); typedef __bf16 bf2_ __attribute__((ext_vector_type(2)));
    return __builtin_bit_cast(unsigned, __builtin_convertvector((f2_){lo, hi}, bf2_)); }

template <class Epi, class Sched, bool ALIGN_EPI, bool GATHER>
__device__ __forceinline__ void gemm_phase(PG8_LAS unsigned char* lds, const Gemm g, const Sched& S, const Epi& E) {
    const int tid = threadIdx.x, wid = __builtin_amdgcn_readfirstlane(tid >> 6), lane = tid & 63, wr = wid >> 2, wc = wid & 3, fr = lane & 15, fq = lane >> 4;
    const int K = g.K, nt = K / BK;
    unsigned voffA[2], voffB[2]; int Rrow[2];
#pragma unroll
    for (int i = 0; i < 2; ++i) { int R, C; stage_rc(tid * 16 + i * 8192, R, C); const int Rb = Epi::PERM ? ((R & ~31) + perm32(R & 31)) : R;
        voffA[i] = GATHER ? (unsigned)(C * 2) : (unsigned)(R * K + C) * 2u; voffB[i] = (unsigned)(Rb * K + C) * 2u; Rrow[i] = R; }
    const size_t kstep = (size_t)(BK * 2);
    const size_t hstep = (size_t)HALF * K * 2;
    const size_t hstepA = GATHER ? 0 : hstep;
    const size_t tstep = 2 * hstep;
    const unsigned ldsw = (unsigned)wid * 1024u;
    const int aoff = lds_byte(wr * 64 + fr, fq * 8), boff = lds_byte(wc * 32 + fr, fq * 8);
#define PG8_SA(b, h) (((b) * 2 + (h)) * HTB)
#define PG8_SB(b, h) ((4 + (b) * 2 + (h)) * HTB)
#define PG8_STAGE(bufoff, gbase, voff) do { _Pragma("unroll") for (int _i = 0; _i < 2; ++_i) \
        __builtin_amdgcn_global_load_lds((const unsigned*)((const char*)(gbase) + (voff)[_i]), (PG8_LAS unsigned*)(lds + (bufoff) + ldsw + _i * 8192), 16, 0, 0); } while (0)
#define PG8_STAGE_A(bufoff, gbase, h, nx) do { if constexpr (GATHER) { unsigned _o[2]; _o[0] = ((nx) ? gN[h][0] : gA[h][0]); _o[1] = ((nx) ? gN[h][1] : gA[h][1]); PG8_STAGE(bufoff, gbase, _o); } \
        else { PG8_STAGE(bufoff, (gbase) + (h) * hstepA, voffA); } } while (0)
#define PG8_LDA(dst, b, h) do { _Pragma("unroll") for (int m = 0; m < 4; ++m) _Pragma("unroll") for (int k = 0; k < 2; ++k) dst[m][k] = *(const PG8_LAS bf16x8*)(lds + PG8_SA(b, h) + aoff + m * 2048 + k * 1024); } while (0)
#define PG8_LDB(dst, b, h) do { _Pragma("unroll") for (int n = 0; n < 2; ++n) _Pragma("unroll") for (int k = 0; k < 2; ++k) dst[n][k] = *(const PG8_LAS bf16x8*)(lds + PG8_SB(b, h) + boff + n * 2048 + k * 1024); } while (0)
#define PG8_MMA(ai, bj, At, Bt) do { __builtin_amdgcn_s_setprio(1); _Pragma("unroll") for (int m = 0; m < 4; ++m) _Pragma("unroll") for (int n = 0; n < 2; ++n) _Pragma("unroll") for (int k = 0; k < 2; ++k) \
        acc[ai][bj][m][n] = __builtin_amdgcn_mfma_f32_16x16x32_bf16(Bt[n][k], At[m][k], acc[ai][bj][m][n], 0, 0, 0); __builtin_amdgcn_s_setprio(0); } while (0)
#define PG8_WAIT_V(n) asm volatile("s_waitcnt vmcnt(" #n ")" ::: "memory")
#define PG8_WAIT_L(n) asm volatile("s_waitcnt lgkmcnt(" #n ")" ::: "memory")
#define PG8_BAR __builtin_amdgcn_s_barrier()
#define PG8_SCHED __builtin_amdgcn_sched_barrier(0)
    Unit cur, nxt; int ui = 0;
    if (!S.next(0, cur)) return;
    f32x4 acc[2][2][4][2];
#pragma unroll
    for (int a = 0; a < 2; ++a)
#pragma unroll
        for (int b = 0; b < 2; ++b)
#pragma unroll
            for (int m = 0; m < 4; ++m)
#pragma unroll
                for (int n = 0; n < 2; ++n) acc[a][b][m][n] = (f32x4){0.f, 0.f, 0.f, 0.f};
    bf16x8 At[4][2], B0[2][2], B1[2][2];
    unsigned gA[2][2], gN[2][2];
#pragma unroll
    for (int h = 0; h < 2; ++h)
#pragma unroll
        for (int i = 0; i < 2; ++i) { gA[h][i] = GATHER ? S.row_off(cur, h * HALF + Rrow[i]) + voffA[i] : 0u; gN[h][i] = gA[h][i]; }
    const char* cA = (const char*)g.A + (GATHER ? (size_t)0 : (size_t)cur.pm * tstep); const char* cB = (const char*)g.Bt + (size_t)cur.pn * tstep;
    PG8_STAGE(PG8_SB(0, 0), cB, voffB); PG8_STAGE(PG8_SB(0, 1), cB + hstep, voffB); PG8_STAGE_A(PG8_SA(0, 0), cA, 0, false); PG8_STAGE_A(PG8_SA(0, 1), cA, 1, false);
    if (wr == 1) PG8_BAR;
    PG8_WAIT_V(2); PG8_BAR;
    PG8_STAGE(PG8_SB(1, 0), cB + kstep, voffB); PG8_STAGE_A(PG8_SA(1, 0), cA + kstep, 0, false); PG8_STAGE(PG8_SB(1, 1), cB + hstep + kstep, voffB);
    PG8_WAIT_V(6); PG8_BAR;
    for (;;) {
        const bool has_next = S.next(ui + 1, nxt);
        if constexpr (GATHER) {
            if (has_next) {
                unsigned ro[2][2]; S.row_off4(nxt, Rrow[0], Rrow[1], ro);
#pragma unroll
                for (int h = 0; h < 2; ++h)
#pragma unroll
                    for (int i = 0; i < 2; ++i) gN[h][i] = ro[h][i] + voffA[i];
            } else {
#pragma unroll
                for (int h = 0; h < 2; ++h)
#pragma unroll
                    for (int i = 0; i < 2; ++i) gN[h][i] = gA[h][i];
            }
        }
        const char* nA = (has_next && !GATHER) ? (const char*)g.A + (size_t)nxt.pm * tstep : cA; const char* nB = has_next ? (const char*)g.Bt + (size_t)nxt.pn * tstep : cB;
        for (int t = 0; t < nt; t += 2) {
            const bool last = (t == nt - 2);
            const char* a1 = cA + (size_t)(t + 1) * kstep;
            const char* a2 = last ? nA : cA + (size_t)(t + 2) * kstep; const char* b2 = last ? nB : cB + (size_t)(t + 2) * kstep;
            const char* a3 = a2 + kstep; const char* b3 = b2 + kstep;
            PG8_LDB(B0, 0, 0); PG8_LDB(B1, 0, 1); PG8_SCHED; PG8_LDA(At, 0, 0); PG8_STAGE_A(PG8_SA(1, 1), a1, 1, false);
            PG8_WAIT_V(8); PG8_WAIT_L(0); PG8_BAR; PG8_MMA(0, 0, At, B0); PG8_MMA(0, 1, At, B1); PG8_BAR; PG8_SCHED;
            PG8_LDA(At, 0, 1); PG8_STAGE(PG8_SB(0, 0), b2, voffB); PG8_STAGE(PG8_SB(0, 1), b2 + hstep, voffB); PG8_STAGE_A(PG8_SA(0, 0), a2, 0, last);
            PG8_WAIT_V(8); PG8_WAIT_L(0); PG8_BAR; PG8_MMA(1, 0, At, B0); PG8_MMA(1, 1, At, B1); PG8_BAR; PG8_SCHED;
            PG8_LDB(B0, 1, 0); PG8_LDB(B1, 1, 1); PG8_SCHED; PG8_LDA(At, 1, 0); PG8_STAGE_A(PG8_SA(0, 1), a2, 1, last);
            PG8_WAIT_V(8); PG8_WAIT_L(0); PG8_BAR; PG8_MMA(0, 0, At, B0); PG8_MMA(0, 1, At, B1); PG8_BAR; PG8_SCHED;
            PG8_LDA(At, 1, 1); PG8_STAGE(PG8_SB(1, 0), b3, voffB); PG8_STAGE(PG8_SB(1, 1), b3 + hstep, voffB); PG8_STAGE_A(PG8_SA(1, 0), a3, 0, last);
            PG8_WAIT_V(8); PG8_WAIT_L(0); PG8_BAR; PG8_MMA(1, 0, At, B0); PG8_MMA(1, 1, At, B1); PG8_BAR; PG8_SCHED;
        }
        if constexpr (ALIGN_EPI) { if (wr == 0) PG8_BAR; }
        E(acc, cur, wr, wc, fr, fq);
        if (!has_next) break;
        {
            typedef float f32x2z __attribute__((ext_vector_type(2)));
#pragma unroll
            for (int a = 0; a < 2; ++a)
#pragma unroll
                for (int b = 0; b < 2; ++b)
#pragma unroll
                    for (int m = 0; m < 4; ++m)
#pragma unroll
                        for (int n = 0; n < 2; ++n) { f32x2z lo_, hi_;
                            asm volatile("v_pk_mov_b32 %0, 0, 0 op_sel_hi:[0,0]" : "=v"(lo_));
                            asm volatile("v_pk_mov_b32 %0, 0, 0 op_sel_hi:[0,0]" : "=v"(hi_));
                            acc[a][b][m][n] = (f32x4){lo_.x, lo_.y, hi_.x, hi_.y}; }
        }
        cur = nxt; cA = nA; cB = nB; ++ui;
#pragma unroll
        for (int h = 0; h < 2; ++h)
#pragma unroll
            for (int i = 0; i < 2; ++i) gA[h][i] = gN[h][i];
        if constexpr (ALIGN_EPI) { if (wr == 1) PG8_BAR; }
    }
    PG8_WAIT_V(0);
    if constexpr (!ALIGN_EPI) { if (wr == 0) PG8_BAR; }
    PG8_BAR;
#undef PG8_SA
#undef PG8_SB
#undef PG8_STAGE
#undef PG8_STAGE_A
#undef PG8_LDA
#undef PG8_LDB
#undef PG8_MMA
#undef PG8_WAIT_V
#undef PG8_WAIT_L
#undef PG8_BAR
#undef PG8_SCHED
}
}
using pg8::Unit; using pg8::cvt_pk_bf16;
__device__ __forceinline__ f32x2 sigmoid2(f32x2 x) { const f32x2 tt = x * (-1.4426950408889634f); const f32x2 d = (f32x2){__builtin_amdgcn_exp2f(tt.x), __builtin_amdgcn_exp2f(tt.y)} + 1.f;
    return (f32x2){__builtin_amdgcn_rcpf(d.x), __builtin_amdgcn_rcpf(d.y)}; }
struct EpiInProj {
    static constexpr bool PERM = true;
    bf16_t* sbq; bf16_t* sbk; bf16_t* sbv; bf16_t* nq; bf16_t* kv6; bf16_t* mg; const float* cosT; const float* sinT;
    __device__ __forceinline__ void operator()(const f32x4 (&acc)[2][2][4][2], const Unit& u, int wr, int wc, int fr, int fq) const {
        const int pn = u.pn; const int row0 = u.pm * 256 + wr * 64 + fr; const int x0 = wc * 32 + 8 * fq;
        if (pn < 6 || pn >= 11) {
            bf16_t* base; int ld, col; float sc = 1.f; const bool sig = pn >= 11;
            if (pn < 2) { base = sbq; ld = 512; col = pn * 256; sc = C2; } else if (pn < 4) { base = sbk; ld = 512; col = (pn - 2) * 256; }
            else if (pn < 6) { base = sbv; ld = 512; col = (pn - 4) * 256; } else { base = mg; ld = 2048; col = (pn - 11) * 256; }
#pragma unroll
            for (int ai = 0; ai < 2; ++ai)
#pragma unroll
                for (int m = 0; m < 4; ++m) { bf16_t* rp = base + (size_t)(row0 + ai * 128 + m * 16) * ld + col + x0;
#pragma unroll
                    for (int bj = 0; bj < 2; ++bj) { f32x4 v0 = acc[ai][bj][m][0] * sc, v1 = acc[ai][bj][m][1] * sc;
                        if (sig) {
                            const f32x2 a = sigmoid2((f32x2){v0[0], v0[1]}), b = sigmoid2((f32x2){v0[2], v0[3]}), c = sigmoid2((f32x2){v1[0], v1[1]}), d = sigmoid2((f32x2){v1[2], v1[3]});
                            v0 = (f32x4){a.x, a.y, b.x, b.y}; v1 = (f32x4){c.x, c.y, d.x, d.y}; }
                        u32x4 w; w.x = cvt_pk_bf16(v0[0], v0[1]); w.y = cvt_pk_bf16(v0[2], v0[3]); w.z = cvt_pk_bf16(v1[0], v1[1]); w.w = cvt_pk_bf16(v1[2], v1[3]);
                        *(u32x4*)(rp + bj * 128) = w; } }
        } else {
            const bool rope = (pn < 8) || (wc < 2);
            bf16_t* base; int ld, c0, c1; float sc = 1.f;
            if (pn < 8) { base = nq; ld = 512; c0 = ((pn - 6) * 4 + wc) * 64 + 8 * fq; c1 = c0 + 32; sc = C2; }
            else { const int t = pn - 8; ld = 128;
                if (wc < 2) { base = kv6 + (size_t)(2 * t) * NTOK * 128; c0 = wc * 64 + 8 * fq; c1 = c0 + 32; }
                else { base = kv6 + (size_t)(2 * t + 1) * NTOK * 128; c0 = (wc - 2) * 32 + 8 * fq; c1 = 64 + c0; } }
#pragma unroll
            for (int am = 0; am < 4; ++am) { const int ai = am >> 1, mb = (am & 1) * 2;
                f32x4 cA[2], cB[2], sA[2], sB[2];
                if (rope) {
#pragma unroll
                    for (int mm = 0; mm < 2; ++mm) { const int pos = (row0 + ai * 128 + (mb + mm) * 16) & (SEQ - 1);
                        cA[mm] = *(const f32x4*)(cosT + pos * 32 + 8 * fq); cB[mm] = *(const f32x4*)(cosT + pos * 32 + 8 * fq + 4);
                        sA[mm] = *(const f32x4*)(sinT + pos * 32 + 8 * fq); sB[mm] = *(const f32x4*)(sinT + pos * 32 + 8 * fq + 4); }
                    asm volatile("" ::: "memory");
                }
#pragma unroll
                for (int mm = 0; mm < 2; ++mm) { const int m = mb + mm; const int row = row0 + ai * 128 + m * 16; bf16_t* rp = base + (size_t)row * ld;
                    f32x4 a0 = acc[ai][0][m][0], a1 = acc[ai][0][m][1], b0 = acc[ai][1][m][0], b1 = acc[ai][1][m][1];
                    if (rope) {
                        const f32x4 r0 = a0 * cA[mm] - b0 * sA[mm], r1 = a1 * cB[mm] - b1 * sB[mm], r2 = b0 * cA[mm] + a0 * sA[mm], r3 = b1 * cB[mm] + a1 * sB[mm];
                        a0 = r0 * sc; a1 = r1 * sc; b0 = r2 * sc; b1 = r3 * sc; }
                    u32x4 w; w.x = cvt_pk_bf16(a0[0], a0[1]); w.y = cvt_pk_bf16(a0[2], a0[3]); w.z = cvt_pk_bf16(a1[0], a1[1]); w.w = cvt_pk_bf16(a1[2], a1[3]);
                    *(u32x4*)(rp + c0) = w;
                    w.x = cvt_pk_bf16(b0[0], b0[1]); w.y = cvt_pk_bf16(b0[2], b0[3]); w.z = cvt_pk_bf16(b1[0], b1[1]); w.w = cvt_pk_bf16(b1[2], b1[3]);
                    *(u32x4*)(rp + c1) = w; }
            }
        }
    }
};
struct EpiMerge {
    static constexpr bool PERM = true;
    const bf16_t* mg; bf16_t* merged; int pass; int pad;
    __device__ __forceinline__ void operator()(const f32x4 (&acc)[2][2][4][2], const Unit& u, int wr, int wc, int fr, int fq) const {
        const int row0 = u.pm * 256 + wr * 64 + fr; const int col0 = u.pn * 256 + wc * 32 + 8 * fq;
#pragma unroll
        for (int ai = 0; ai < 2; ++ai) {
            u32x4 gv[4][2], pv_[4][2];
#pragma unroll
            for (int m = 0; m < 4; ++m) { const size_t row = (size_t)(row0 + ai * 128 + m * 16);
#pragma unroll
                for (int bj = 0; bj < 2; ++bj) { gv[m][bj] = *(const u32x4*)(mg + row * 2048 + pass * 1024 + col0 + bj * 128);
                    if (pass) pv_[m][bj] = *(const u32x4*)(merged + row * DM + col0 + bj * 128); } }
            asm volatile("" ::: "memory");
#pragma unroll
            for (int m = 0; m < 4; ++m) { const size_t row = (size_t)(row0 + ai * 128 + m * 16);
#pragma unroll
                for (int bj = 0; bj < 2; ++bj) { const u32x4 g = gv[m][bj];
                    f32x4 v0 = acc[ai][bj][m][0], v1 = acc[ai][bj][m][1];
                    v0[0] *= bflo(g.x); v0[1] *= bfhi(g.x); v0[2] *= bflo(g.y); v0[3] *= bfhi(g.y); v1[0] *= bflo(g.z); v1[1] *= bfhi(g.z); v1[2] *= bflo(g.w); v1[3] *= bfhi(g.w);
                    if (pass) { const u32x4 p = pv_[m][bj]; v0[0] += bflo(p.x); v0[1] += bfhi(p.x); v0[2] += bflo(p.y); v0[3] += bfhi(p.y); v1[0] += bflo(p.z); v1[1] += bfhi(p.z); v1[2] += bflo(p.w); v1[3] += bfhi(p.w); }
                    u32x4 w; w.x = cvt_pk_bf16(v0[0], v0[1]); w.y = cvt_pk_bf16(v0[2], v0[3]); w.z = cvt_pk_bf16(v1[0], v1[1]); w.w = cvt_pk_bf16(v1[2], v1[3]);
                    *(u32x4*)(merged + row * DM + col0 + bj * 128) = w; } }
        }
    }
};
struct EpiOut {
    static constexpr bool PERM = false;
    const float* x; float* u; f32x2* stats;
    __device__ __forceinline__ void operator()(const f32x4 (&acc)[2][2][4][2], const Unit& un, int wr, int wc, int fr, int fq) const {
        const int row0 = un.pm * 256 + wr * 64 + fr; const int col0 = un.pn * 256 + wc * 32 + 4 * fq;
#pragma unroll
        for (int ai = 0; ai < 2; ++ai) {
            f32x4 xv[4][2][2];
#pragma unroll
            for (int m = 0; m < 4; ++m) { const size_t off = (size_t)(row0 + ai * 128 + m * 16) * DM + col0;
#pragma unroll
                for (int bj = 0; bj < 2; ++bj)
#pragma unroll
                    for (int n = 0; n < 2; ++n) xv[m][bj][n] = *(const f32x4*)(x + off + bj * 128 + n * 16); }
            asm volatile("" ::: "memory");
#pragma unroll
            for (int m = 0; m < 4; ++m) { const int row = row0 + ai * 128 + m * 16; const size_t off = (size_t)row * DM + col0; float s = 0.f, s2 = 0.f;
#pragma unroll
                for (int bj = 0; bj < 2; ++bj)
#pragma unroll
                    for (int n = 0; n < 2; ++n) { const f32x4 v = xv[m][bj][n] * ALPHA + acc[ai][bj][m][n]; *(f32x4*)(u + off + bj * 128 + n * 16) = v;
                        s += (v[0] + v[1]) + (v[2] + v[3]); s2 += (v[0] * v[0] + v[1] * v[1]) + (v[2] * v[2] + v[3] * v[3]); }
                s += __shfl_xor(s, 16); s += __shfl_xor(s, 32); s2 += __shfl_xor(s2, 16); s2 += __shfl_xor(s2, 32);
                if (fq == 0) stats[(size_t)row * 16 + un.pn * 4 + wc] = (f32x2){s, s2}; }
        }
    }
};
__device__ __forceinline__ f32x2 swiglu2(f32x2 ga, f32x2 ua) {
    const f32x2 g = {fminf(ga.x, 7.f), fminf(ga.y, 7.f)};
    const f32x2 uu = {fminf(fmaxf(ua.x, -7.f), 7.f), fminf(fmaxf(ua.y, -7.f), 7.f)};
    const f32x2 tt = g * (-1.702f * 1.4426950408889634f);
    const f32x2 d = (f32x2){__builtin_amdgcn_exp2f(tt.x), __builtin_amdgcn_exp2f(tt.y)} + 1.f;
    const f32x2 h = g * (f32x2){__builtin_amdgcn_rcpf(d.x), __builtin_amdgcn_rcpf(d.y)};
    return h * uu + h;
}
struct EpiGateUp {
    static constexpr bool PERM = true;
    const float* bgu; bf16_t* hid;
    __device__ __forceinline__ void operator()(const f32x4 (&acc)[2][2][4][2], const Unit& u, int wr, int wc, int fr, int fq) const {
        const int e = u.e, pnl = u.pn - e * 8; const int f0 = pnl * 128 + wc * 32 + 8 * fq;
        const float* bp = bgu + e * 2048 + f0;
        const f32x4 bg0 = *(const f32x4*)bp, bg1 = *(const f32x4*)(bp + 4), bu0 = *(const f32x4*)(bp + 1024), bu1 = *(const f32x4*)(bp + 1028);
        const int row0 = u.pm * 256 + wr * 64 + fr;
#pragma unroll
        for (int ai = 0; ai < 2; ++ai)
#pragma unroll
            for (int m = 0; m < 4; ++m) {
                const f32x4 g0 = acc[ai][0][m][0] + bg0, g1 = acc[ai][0][m][1] + bg1, u0 = acc[ai][1][m][0] + bu0, u1 = acc[ai][1][m][1] + bu1;
                const f32x2 ha = swiglu2((f32x2){g0[0], g0[1]}, (f32x2){u0[0], u0[1]}), hb = swiglu2((f32x2){g0[2], g0[3]}, (f32x2){u0[2], u0[3]});
                const f32x2 hc = swiglu2((f32x2){g1[0], g1[1]}, (f32x2){u1[0], u1[1]}), hd = swiglu2((f32x2){g1[2], g1[3]}, (f32x2){u1[2], u1[3]});
                u32x4 w; w.x = cvt_pk_bf16(ha.x, ha.y); w.y = cvt_pk_bf16(hb.x, hb.y); w.z = cvt_pk_bf16(hc.x, hc.y); w.w = cvt_pk_bf16(hd.x, hd.y);
                *(u32x4*)(hid + (size_t)(row0 + ai * 128 + m * 16) * DFF + f0) = w; }
    }
};
struct EpiDown {
    static constexpr bool PERM = true;
    const float* bd; bf16_t* outr;
    __device__ __forceinline__ void operator()(const f32x4 (&acc)[2][2][4][2], const Unit& u, int wr, int wc, int fr, int fq) const {
        const int e = u.e, pnl = u.pn - e * 4; const int col0 = pnl * 256 + wc * 32 + 8 * fq; const int row0 = u.pm * 256 + wr * 64 + fr;
        f32x4 b[2][2];
#pragma unroll
        for (int bj = 0; bj < 2; ++bj) { b[bj][0] = *(const f32x4*)(bd + e * DM + col0 + bj * 128); b[bj][1] = *(const f32x4*)(bd + e * DM + col0 + bj * 128 + 4); }
#pragma unroll
        for (int ai = 0; ai < 2; ++ai)
#pragma unroll
            for (int m = 0; m < 4; ++m) { bf16_t* rp = outr + (size_t)(row0 + ai * 128 + m * 16) * DM + col0;
#pragma unroll
                for (int bj = 0; bj < 2; ++bj) { const f32x4 v0 = acc[ai][bj][m][0] + b[bj][0], v1 = acc[ai][bj][m][1] + b[bj][1];
                    u32x4 w; w.x = cvt_pk_bf16(v0[0], v0[1]); w.y = cvt_pk_bf16(v0[2], v0[3]); w.z = cvt_pk_bf16(v1[0], v1[1]); w.w = cvt_pk_bf16(v1[2], v1[3]);
                    *(u32x4*)(rp + bj * 128) = w; } }
    }
};
constexpr int LDS_RING = 131072, LDS_TAB = LDS_RING, LDS_CNT = LDS_TAB + NTILE_MAX * 4, LDS_NT = LDS_CNT + 128, LDS_MISC = LDS_NT + 64, LDS_BYTES = 160 * 1024;
__device__ __forceinline__ void moe_build_table(LAS unsigned char* lds, const int* gcnt) {
    LAS int* tab = (LAS int*)(lds + LDS_TAB); LAS int* cnts = (LAS int*)(lds + LDS_CNT); LAS int* nt = (LAS int*)(lds + LDS_NT);
    LAS int* tstart = (LAS int*)(lds + LDS_MISC);
    const int tid = threadIdx.x;
    if (tid < 32) cnts[tid] = gcnt[tid];
    __syncthreads();
    if (tid == 0) { int a = 0; for (int e = 0; e < 32; ++e) { tstart[e] = a; a += (cnts[e] + 255) >> 8; } tstart[32] = a; nt[0] = a; }
    __syncthreads();
    const int ntl = nt[0];
    for (int t = tid; t < ntl; t += NTHREADS) { int e = 0; for (int k = 1; k < 32; ++k) if (tstart[k] <= t) e = k; tab[t] = (e << 16) | (t - tstart[e]); }
    __syncthreads();
}
template <int NPN> struct MoeOrder {
    LAS unsigned char* lds; const int* list; int r, G, c, ntr;
    __device__ __forceinline__ void init(LAS unsigned char* lds_, const int* list_, int r_, int G_, int c_) {
        lds = lds_; list = list_; r = r_; G = G_; c = c_; const int ntl = ((LAS int*)(lds + LDS_NT))[0]; int n = ntl - r * TR; ntr = n < 0 ? 0 : ((r < NROUND - 1 && n > TR) ? TR : n); }
    __device__ __forceinline__ bool next(int i, Unit& u) const {
        const int nM = ntr, nN = NPN, nwg = nM * nN; const long L = (long)i * G + c; if (L >= nwg) return false;
        int wgid = (int)L; { const int q = nwg / 8, rr = nwg % 8, xcd = wgid % 8, off = wgid / 8; wgid = (xcd < rr ? xcd * (q + 1) : rr * (q + 1) + (xcd - rr) * q) + off; }
        const int nig = 8 * nN, gid = wgid / nig, fm = gid * 8, gsz = (nM - fm) < 8 ? (nM - fm) : 8;
        const int pm = fm + ((wgid % nig) % gsz), pnl = (wgid % nig) / gsz;
        const int pk = ((LAS int*)(lds + LDS_TAB))[r * TR + pm];
        u.pm = pm; u.e = pk >> 16; u.r0 = (pk & 0xffff) << 8; u.pn = u.e * NPN + pnl; return true;
    }
    __device__ __forceinline__ unsigned row_off(const Unit& u, int rr) const {
        const int pos = u.r0 + rr; const int cnt = ((LAS int*)(lds + LDS_CNT))[u.e];
        const bool ok = pos < cnt; const int v = list[(size_t)u.e * NTOK + (ok ? pos : 0)];
        const int tok = ok ? (v >> 2) : 0;
        return (unsigned)tok * (unsigned)(DM * 2);
    }
    __device__ __forceinline__ void row_off4(const Unit& u, int r0_, int r1_, unsigned (&ro)[2][2]) const {
        const int cnt = ((LAS int*)(lds + LDS_CNT))[u.e]; const int* lp = list + (size_t)u.e * NTOK;
        const int p00 = u.r0 + r0_, p01 = u.r0 + r1_, p10 = p00 + 128, p11 = p01 + 128;
        const int v00 = lp[p00 < cnt ? p00 : 0], v01 = lp[p01 < cnt ? p01 : 0], v10 = lp[p10 < cnt ? p10 : 0], v11 = lp[p11 < cnt ? p11 : 0];
        asm volatile("" ::: "memory");
        ro[0][0] = (p00 < cnt ? (unsigned)(v00 >> 2) : 0u) * (unsigned)(DM * 2); ro[0][1] = (p01 < cnt ? (unsigned)(v01 >> 2) : 0u) * (unsigned)(DM * 2);
        ro[1][0] = (p10 < cnt ? (unsigned)(v10 >> 2) : 0u) * (unsigned)(DM * 2); ro[1][1] = (p11 < cnt ? (unsigned)(v11 >> 2) : 0u) * (unsigned)(DM * 2);
    }
};
__device__ __forceinline__ int win_src_col(int n) {
    const int pn = n >> 8, c = n & 255, bj = c >> 7, x = c & 127;
    if (pn < 6) return n;
    if (pn < 8) return 1536 + ((pn - 6) * 4 + (x >> 5)) * 64 + (x & 31) + 32 * bj;
    if (pn < 11) { const int base = 2048 + (pn - 8) * 256; return x < 64 ? base + (x >> 5) * 64 + (x & 31) + 32 * bj : base + 128 + bj * 64 + (x - 64); }
    return C_MG + (n - 2816);
}
__device__ __forceinline__ int wgu_src_col(int n) { const int pnl = n >> 8, c = n & 255, bj = c >> 7, x = c & 127; return bj * 1024 + 128 * pnl + x; }
__device__ __forceinline__ void transpose_item64(const float* W, int ldw, int K, int srccol0a, int srccol0b, bf16_t* WT, int n0, int k0, LAS float* scr, int lane) {
    const int sc = (lane < 32) ? srccol0a + lane : srccol0b + (lane - 32);
    float tv[32];
#pragma unroll
    for (int h = 0; h < 2; ++h) {
#pragma unroll
        for (int i = 0; i < 32; ++i) tv[i] = W[(size_t)(k0 + 32 * h + i) * ldw + sc];
#pragma unroll
        for (int i = 0; i < 32; ++i) scr[(32 * h + i) * 65 + lane] = tv[i];
    }
    asm volatile("s_waitcnt lgkmcnt(0)" ::: "memory");
    const int c = lane & 7;
#pragma unroll
    for (int j = 0; j < 8; ++j) { const int n = (lane >> 3) + 8 * j; const LAS float* s = scr + (8 * c) * 65 + n;
        u32x4 o; o.x = pk2(s[0 * 65], s[1 * 65]); o.y = pk2(s[2 * 65], s[3 * 65]); o.z = pk2(s[4 * 65], s[5 * 65]); o.w = pk2(s[6 * 65], s[7 * 65]);
        *(u32x4*)(WT + (size_t)(n0 + n) * K + k0 + 8 * c) = o; }
    asm volatile("s_waitcnt lgkmcnt(0)" ::: "memory");
}
__device__ __forceinline__ void transpose_item(const float* W, int ldw, int K, int srccol0, bf16_t* WT, int n0, int k0, LAS float* scr, int lane) {
    float tv[32];
#pragma unroll
    for (int i = 0; i < 32; ++i) tv[i] = W[(size_t)(k0 + 2 * i + (lane >> 5)) * ldw + srccol0 + (lane & 31)];
#pragma unroll
    for (int i = 0; i < 32; ++i) scr[(2 * i + (lane >> 5)) * 33 + (lane & 31)] = tv[i];
    asm volatile("s_waitcnt lgkmcnt(0)" ::: "memory");
    const int c = lane & 7;
#pragma unroll
    for (int j = 0; j < 4; ++j) { const int n = (lane >> 3) + 8 * j; const LAS float* s = scr + (8 * c) * 33 + n;
        u32x4 o; o.x = pk2(s[0 * 33], s[1 * 33]); o.y = pk2(s[2 * 33], s[3 * 33]); o.z = pk2(s[4 * 33], s[5 * 33]); o.w = pk2(s[6 * 33], s[7 * 33]);
        *(u32x4*)(WT + (size_t)(n0 + n) * K + k0 + 8 * c) = o; }
    asm volatile("s_waitcnt lgkmcnt(0)" ::: "memory");
}
struct PrepArgs { const float* x; const float* w_in; const float* w_sb; const float* w_nsa; const float* w_out; const float* w_gu; const float* w_dn;
                  bf16_t* wt_in; bf16_t* wt_sb; bf16_t* wt_nsa; bf16_t* wt_out; bf16_t* wt_gu; bf16_t* wt_dn; bf16_t* xb; float* ng; float* ropeT;
                  const float* pe_k; const float* w1_k; const float* w2_k; const float* pe_v; const float* w1_v; const float* w2_v; unsigned char* cmpw; float* c1; };
constexpr int CW_WT1K = 0, CW_WT1V = 262144, CW_W2TK = 524288, CW_W2TV = 532480, CW_C1K = 540672, CW_C1V = 541696;
__device__ __forceinline__ void prep_phase(const PrepArgs& a, LAS unsigned char* lds, int vcu, int G) {
    const int tid = threadIdx.x, lane = tid & 63, wave = __builtin_amdgcn_readfirstlane(tid >> 6);
    const int gw = vcu * NWAVES + wave, NGW = G * NWAVES;
    for (int i = gw * 64 + lane; i < SEQ * 32; i += NGW * 64) { const int pos = i >> 5, d = i & 31;
        const float inv = (float)pow(10000.0, -(double)d / 32.0); const float ang = (float)pos * inv;
        a.ropeT[i] = (float)cos((double)ang); a.ropeT[SEQ * 32 + i] = (float)sin((double)ang); }
    LAS float* scr = (LAS float*)(lds + wave * 16640);
    constexpr int I_IN = 16 * (4864 / 64), I_SB = 8 * 32, I_OUT = 16 * 32, I_GU = 32 * 16 * 32, I_DN = 32 * 16 * 16;
    constexpr int I_W1 = 32 * 2, I_W2 = 2, I_C1 = 16;
    constexpr int NITEMS = I_IN + 2 * I_SB + I_OUT + 2 * I_W1 + 2 * I_W2 + 2 * I_C1;
    for (int it = gw; it < NITEMS; it += NGW) {
        int r = it;
        if (r < I_IN) { const int nb = r % 76, kb = r / 76; transpose_item64(a.w_in, IN_W, 1024, win_src_col(nb * 64), win_src_col(nb * 64 + 32), a.wt_in, nb * 64, kb * 64, scr, lane); continue; } r -= I_IN;
        if (r < I_SB) { const int nb = r % 32, kb = r / 32; transpose_item(a.w_sb, 1024, 512, nb * 32, a.wt_sb, nb * 32, kb * 64, scr, lane); continue; } r -= I_SB;
        if (r < I_SB) { const int nb = r % 32, kb = r / 32; transpose_item(a.w_nsa, 1024, 512, nb * 32, a.wt_nsa, nb * 32, kb * 64, scr, lane); continue; } r -= I_SB;
        if (r < I_OUT) { const int nb = r % 32, kb = r / 32; transpose_item(a.w_out, 1024, 1024, nb * 32, a.wt_out, nb * 32, kb * 64, scr, lane); continue; } r -= I_OUT;
        if (r < I_W1) { transpose_item(a.w1_k, 64, 2048, (r & 1) * 32, (bf16_t*)(a.cmpw + CW_WT1K), (r & 1) * 32, (r >> 1) * 64, scr, lane); continue; } r -= I_W1;
        if (r < I_W1) { transpose_item(a.w1_v, 64, 2048, (r & 1) * 32, (bf16_t*)(a.cmpw + CW_WT1V), (r & 1) * 32, (r >> 1) * 64, scr, lane); continue; } r -= I_W1;
        if (r < I_W2) { transpose_item(a.w2_k, 64, 64, r * 32, (bf16_t*)(a.cmpw + CW_W2TK), r * 32, 0, scr, lane); continue; } r -= I_W2;
        if (r < I_W2) { transpose_item(a.w2_v, 64, 64, r * 32, (bf16_t*)(a.cmpw + CW_W2TV), r * 32, 0, scr, lane); continue; } r -= I_W2;
        {
            const int kv = r >> 4, part = r & 15;
            const float* pe = kv ? a.pe_v : a.pe_k; const float* w1 = kv ? a.w1_v : a.w1_k; float* c1 = a.c1 + kv * 64;
            float acc = 0.f;
#pragma unroll 1
            for (int i0 = 0; i0 < 128; i0 += 32) {
                float wv[32], pv[32];
#pragma unroll
                for (int j = 0; j < 32; ++j) { const int idx = part * 128 + i0 + j; wv[j] = w1[idx * 64 + lane]; pv[j] = pe[idx]; }
                asm volatile("" ::: "memory");
#pragma unroll
                for (int j = 0; j < 32; ++j) acc += pv[j] * wv[j];
            }
            atomicAdd(&c1[lane], acc); }
    }
    {
        auto src_of = [&](int it, const float*& W, int& ldw, int& ca, int& cb, bf16_t*& WT, int& n0, int& k0) {
            if (it < I_GU) { const int e = it / (16 * 32), q = it % (16 * 32), nb = q % 32, kb = q / 32; W = a.w_gu + (size_t)e * 1024 * 2048; ldw = 2048; ca = wgu_src_col(nb * 64); cb = wgu_src_col(nb * 64 + 32);
                WT = a.wt_gu + (size_t)e * 2048 * 1024; n0 = nb * 64; k0 = kb * 64; }
            else { const int r2 = it - I_GU; const int e = r2 / (16 * 16), q = r2 % (16 * 16), nb = q % 16, kb = q / 16; W = a.w_dn + (size_t)e * 1024 * 1024; ldw = 1024; ca = nb * 64; cb = nb * 64 + 32;
                WT = a.wt_dn + (size_t)e * 1024 * 1024; n0 = nb * 64; k0 = kb * 64; } };
        float tA[32], tB[32];
        const float* W; int ldw, ca, cb, n0, k0; bf16_t* WT;
        int it = gw;
        if (it < I_GU + I_DN) { src_of(it, W, ldw, ca, cb, WT, n0, k0); const int sc = (lane < 32) ? ca + lane : cb + (lane - 32);
#pragma unroll
            for (int i = 0; i < 32; ++i) tA[i] = W[(size_t)(k0 + i) * ldw + sc]; }
        while (it < I_GU + I_DN) {
            const int sc = (lane < 32) ? ca + lane : cb + (lane - 32);
#pragma unroll
            for (int i = 0; i < 32; ++i) tB[i] = W[(size_t)(k0 + 32 + i) * ldw + sc];
#pragma unroll
            for (int i = 0; i < 32; ++i) scr[i * 65 + lane] = tA[i];
            bf16_t* WTc = WT; const int n0c = n0, k0c = k0; const int K = 1024;
            const int itn = it + NGW;
            if (itn < I_GU + I_DN) { src_of(itn, W, ldw, ca, cb, WT, n0, k0); const int sc2 = (lane < 32) ? ca + lane : cb + (lane - 32);
#pragma unroll
                for (int i = 0; i < 32; ++i) tA[i] = W[(size_t)(k0 + i) * ldw + sc2]; }
#pragma unroll
            for (int i = 0; i < 32; ++i) scr[(32 + i) * 65 + lane] = tB[i];
            asm volatile("s_waitcnt lgkmcnt(0)" ::: "memory");
            const int c = lane & 7;
#pragma unroll
            for (int j = 0; j < 8; ++j) { const int n = (lane >> 3) + 8 * j; const LAS float* sp = scr + (8 * c) * 65 + n;
                u32x4 o; o.x = pk2(sp[0 * 65], sp[1 * 65]); o.y = pk2(sp[2 * 65], sp[3 * 65]); o.z = pk2(sp[4 * 65], sp[5 * 65]); o.w = pk2(sp[6 * 65], sp[7 * 65]);
                *(u32x4*)(WTc + (size_t)(n0c + n) * K + k0c + 8 * c) = o; }
            asm volatile("s_waitcnt lgkmcnt(0)" ::: "memory");
            it = itn;
        }
    }
    __syncthreads();
    LAS unsigned char* wl = lds;
    for (int i = tid; i < 32 * 1024; i += NTHREADS) { const int k = i >> 5, n = i & 31; const float v = (n < 24) ? a.w_in[(size_t)k * IN_W + C_NG + n] : 0.f;
        *(LAS bf16_t*)(wl + n * 2048 + ((((k >> 3) ^ (n & 15)) << 4) | ((k & 7) << 1))) = (bf16_t)f2bf(v); }
    __syncthreads();
    {
        typedef short bf16x8_t __attribute__((ext_vector_type(8)));
        const int r = lane & 15, kq = lane >> 4;
        for (int grp = gw; grp < NTOK / 16; grp += NGW) {
            const int tok = grp * 16 + r; const float* xr = a.x + (size_t)tok * DM + 8 * kq; bf16_t* xo = a.xb + (size_t)tok * DM + 8 * kq;
            f32x4 acc0 = {0.f, 0.f, 0.f, 0.f}, acc1 = {0.f, 0.f, 0.f, 0.f};
            f32x4 ra[8], rb[8];
#pragma unroll
            for (int i = 0; i < 8; ++i) { ra[i] = *(const f32x4*)(xr + 32 * i); rb[i] = *(const f32x4*)(xr + 32 * i + 4); }
#pragma unroll 1
            for (int s8 = 0; s8 < 32; s8 += 8) {
#pragma unroll
            for (int u8 = 0; u8 < 8; ++u8) {
                const int st = s8 + u8;
                const f32x4 va = ra[u8], vb = rb[u8];
                { const int sn = (s8 < 24) ? st + 8 : st;
                  ra[u8] = *(const f32x4*)(xr + 32 * sn); rb[u8] = *(const f32x4*)(xr + 32 * sn + 4); }
                u32x4 w; w.x = pk2(va[0], va[1]); w.y = pk2(va[2], va[3]); w.z = pk2(vb[0], vb[1]); w.w = pk2(vb[2], vb[3]);
                *(u32x4*)(xo + 32 * st) = w;
                const int kc = 4 * st + kq;
                const bf16x8_t b0 = *(const LAS bf16x8_t*)(wl + r * 2048 + ((kc ^ r) << 4)), b1 = *(const LAS bf16x8_t*)(wl + (16 + r) * 2048 + ((kc ^ r) << 4));
                const bf16x8_t af = __builtin_bit_cast(bf16x8_t, w);
                acc0 = __builtin_amdgcn_mfma_f32_16x16x32_bf16(af, b0, acc0, 0, 0, 0); acc1 = __builtin_amdgcn_mfma_f32_16x16x32_bf16(af, b1, acc1, 0, 0, 0);
            }
            }
#pragma unroll
            for (int q = 0; q < 4; ++q) { float* o = a.ng + (size_t)(grp * 16 + 4 * kq + q) * 24; o[r] = 1.f / (1.f + expf(-acc0[q])); if (r < 8) o[16 + r] = 1.f / (1.f + expf(-acc1[q])); }
        }
    }
}
#define GAS __attribute__((address_space(1)))
typedef GAS unsigned gu32;
typedef GAS unsigned long long gu64;
#define RLX_AGENT __ATOMIC_RELAXED, __HIP_MEMORY_SCOPE_AGENT
#define LDS_WAIT() asm volatile("s_waitcnt lgkmcnt(0)" ::: "memory")
#define VM_WAIT() asm volatile("s_waitcnt vmcnt(0)" ::: "memory")
__device__ __forceinline__ unsigned long long rt() { return __builtin_amdgcn_s_memrealtime(); }

#define XB_TMO      128
#define XB_XCNT(j)  (256  + 64 * (j))
#define XB_XSUB(j)  (1280 + 64 * (j))
#define XB_XGEN(j)  (2304 + 64 * (j))
#define XB_TOP      3328
#define XB_TOPGEN   3392
#define XCD_BAR_WORDS 3456
#define XB_SPIN_CAP (1u << 18)

__device__ __forceinline__ unsigned xb_ld(unsigned* p)              { return __hip_atomic_load(p, __ATOMIC_RELAXED, __HIP_MEMORY_SCOPE_AGENT); }
__device__ __forceinline__ unsigned xb_add(unsigned* p, unsigned v) { return __hip_atomic_fetch_add(p, v, __ATOMIC_RELAXED, __HIP_MEMORY_SCOPE_AGENT); }
__device__ __forceinline__ unsigned xb_xcc_id() { return (unsigned)__builtin_amdgcn_s_getreg((3 << 11) | 20) & 0xFu; }
#define XB_SPIN(cond, bar) do { unsigned _sp = 0; while (cond) { __builtin_amdgcn_s_sleep(1); \
    if ((++_sp & 255u) == 0u) { if (xb_ld(&(bar)[XB_TMO])) break; if (_sp > XB_SPIN_CAP) { atomicAdd(&(bar)[XB_TMO], 1u); break; } } } } while (0)

struct XcdBarrier {
    unsigned* bar; unsigned x;
    volatile LAS unsigned* st;
};

__device__ __forceinline__ XcdBarrier xcd_barrier_post(unsigned* bar, volatile LAS unsigned* st) {
    XcdBarrier b; b.bar = bar; b.x = xb_xcc_id(); b.st = st;
    if (threadIdx.x == 0) (void)xb_add(&bar[XB_XCNT(b.x)], 1u);
    return b;
}
__device__ __forceinline__ void xcd_barrier_complete(unsigned* bar, unsigned x, unsigned& nloc, unsigned& nx) {
    const unsigned G = gridDim.x * gridDim.y * gridDim.z;
    unsigned sum, cnt, mine, sp = 0u;
    for (;;) {
        sum = 0u; cnt = 0u; mine = 0u;
#pragma unroll
        for (unsigned j = 0; j < 16; ++j) { const unsigned c = xb_ld(&bar[XB_XCNT(j)]); sum += c; cnt += (c > 0u) ? 1u : 0u; mine = (j == x) ? c : mine; }
        if (sum == G) break;
        __builtin_amdgcn_s_sleep(1);
        if ((++sp & 255u) == 0u) { if (xb_ld(&bar[XB_TMO])) break; if (sp > XB_SPIN_CAP) { atomicAdd(&bar[XB_TMO], 1u); break; } }
    }
    nloc = mine > 0u ? mine : 1u; nx = cnt > 0u ? cnt : 1u;
}

__device__ __forceinline__ void xcd_barrier(const XcdBarrier& b) {
    asm volatile("s_waitcnt vmcnt(0)" ::: "memory");
    __syncthreads();
    if (threadIdx.x == 0) {
        unsigned* bar = b.bar;
        __builtin_amdgcn_s_waitcnt(0);
        unsigned nloc = b.st[0], nx = b.st[1];
        if (nloc == 0u) { xcd_barrier_complete(bar, b.x, nloc, nx); b.st[0] = nloc; b.st[1] = nx; }
        const unsigned old = xb_add(&bar[XB_XSUB(b.x)], 1u);
        const unsigned gen = old / nloc;
        if (old + 1u == (gen + 1u) * nloc) {
            __builtin_amdgcn_fence(__ATOMIC_RELEASE, "agent");
            asm volatile("s_waitcnt vmcnt(0)" ::: "memory");
            const unsigned og = xb_add(&bar[XB_TOP], 1u);
            const unsigned tg = og / nx;
            if (og + 1u == (tg + 1u) * nx) xb_add(&bar[XB_TOPGEN], 1u);
            else XB_SPIN(xb_ld(&bar[XB_TOPGEN]) == tg, bar);
            __builtin_amdgcn_fence(__ATOMIC_ACQUIRE, "agent");
            xb_add(&bar[XB_XGEN(b.x)], 1u);
            asm volatile("s_waitcnt vmcnt(0)" ::: "memory");
        } else {
            XB_SPIN(xb_ld(&bar[XB_XGEN(b.x)]) == gen, bar);
            __builtin_amdgcn_fence(__ATOMIC_ACQUIRE, "agent");
            asm volatile("s_waitcnt vmcnt(0)" ::: "memory");
        }
    }
    __syncthreads();
}


typedef short bf16x8 __attribute__((ext_vector_type(8)));
typedef short s16x4 __attribute__((ext_vector_type(4)));
constexpr int AT_NS = 4, AT_SLOT = 8192, AT_K = 0, AT_V = AT_NS * AT_SLOT, AT_PSLC = 2 * AT_NS * AT_SLOT  , AT_MASK = AT_PSLC + 32768  , AT_FLAG = AT_MASK + 1024  ;
#define AT_WAIT_BAR(N) asm volatile("s_waitcnt vmcnt(" #N ") lgkmcnt(0)\n\ts_barrier" ::: "memory")
__device__ __forceinline__ int crow(int r, int hi) { return (r & 3) + 8 * (r >> 2) + 4 * hi; }
#define CROW0(r) (((r) & 3) + 8 * ((r) >> 2))
__device__ __forceinline__ float fexp2(float x) { return __builtin_amdgcn_exp2f(x); }
__device__ __forceinline__ float flog2(float x) { return __builtin_amdgcn_logf(x); }
__device__ __forceinline__ unsigned cvtpk(float lo, float hi) { f32x2 v = {lo, hi}; typedef __bf16 bf2 __attribute__((ext_vector_type(2))); bf2 b = __builtin_convertvector(v, bf2); return __builtin_bit_cast(unsigned, b); }
__device__ __forceinline__ float swap_get(float x) { auto r = __builtin_amdgcn_permlane32_swap(__float_as_uint(x), __float_as_uint(x), false, false); return (threadIdx.x & 32) ? __uint_as_float(r[0]) : __uint_as_float(r[1]); }
__device__ __forceinline__ float quad_sum(float x) {
    x += __builtin_bit_cast(float, __builtin_amdgcn_update_dpp(0, __builtin_bit_cast(int, x), 0xB1  , 0xF, 0xF, true));
    x += __builtin_bit_cast(float, __builtin_amdgcn_update_dpp(0, __builtin_bit_cast(int, x), 0x4E  , 0xF, 0xF, true));
    return x;
}
struct KVTile { const bf16_t* k; const bf16_t* v; int pitch; };
__device__ __forceinline__ void glds16(const void* gbase_uniform, unsigned voff, unsigned lds_dst) { unsigned keep;
    const unsigned long long a = (unsigned long long)gbase_uniform;
    const unsigned long long sb = (unsigned long long)(unsigned)__builtin_amdgcn_readfirstlane((unsigned)a) | ((unsigned long long)(unsigned)__builtin_amdgcn_readfirstlane((unsigned)(a >> 32)) << 32);
    asm volatile("s_nop 4\n\ts_mov_b32 %0, m0\n\ts_mov_b32 m0, %3\n\ts_nop 0\n\tglobal_load_lds_dwordx4 %1, %2\n\ts_mov_b32 m0, %0" : "=&s"(keep) : "v"(voff), "s"(sb), "s"(lds_dst) : "memory"); }
__device__ __forceinline__ void dma_kv(LAS unsigned char* lds, const KVTile& s, int key0, int slot, int wid, int lane) {
    const int kl_ = ((lane >> 5) & 1) * 4 + ((lane >> 2) & 3), c_ = 4 * ((lane >> 4) & 1) + (((lane & 3) - wid) & 3);
    const unsigned koff = (unsigned)(((8 * wid + kl_) * s.pitch + c_ * 8) * 2);
    const unsigned voff = (unsigned)(((16 * (wid & 3) + (lane >> 2)) * s.pitch + (wid >> 2) * 32 + (lane & 3) * 8) * 2);
    const unsigned base = (unsigned)(uintptr_t)lds;
    glds16(s.k + (size_t)key0 * s.pitch, koff, (unsigned)__builtin_amdgcn_readfirstlane(base + AT_K + slot * AT_SLOT + wid * 1024));
    glds16(s.v + (size_t)key0 * s.pitch, voff, (unsigned)__builtin_amdgcn_readfirstlane(base + AT_V + slot * AT_SLOT + wid * 1024));
}
__device__ __forceinline__ void qkt(f32x16& p0, f32x16& p1, const LAS unsigned char* kslot, const bf16x8 (&qf)[4], const f32x16& cv, int lane) {
    const int q_ = lane & 31, j_ = q_ >> 3, r0_ = (j_ + (lane >> 5)) & 3;
    const LAS unsigned char* kb = kslot + j_ * 1024 + ((q_ >> 2) & 1) * 512 + (q_ & 3) * 64;
    const LAS unsigned char* ka0 = kb + 16 * r0_; const LAS unsigned char* ka1 = kb + 16 * (r0_ ^ 2);
    bf16x8 kf[8];
#pragma unroll
    for (int d0 = 0; d0 < 4; ++d0) { const LAS unsigned char* kp = ((d0 & 1) ? ka1 : ka0) + (d0 >> 1) * 256; kf[2 * d0] = *(const LAS bf16x8*)kp; kf[2 * d0 + 1] = *(const LAS bf16x8*)(kp + 4096); }
    p0 = __builtin_amdgcn_mfma_f32_32x32x16_bf16(kf[0], qf[0], cv, 0, 0, 0);
    p1 = __builtin_amdgcn_mfma_f32_32x32x16_bf16(kf[1], qf[0], cv, 0, 0, 0);
#pragma unroll
    for (int d0 = 1; d0 < 4; ++d0) {
        p0 = __builtin_amdgcn_mfma_f32_32x32x16_bf16(kf[2 * d0], qf[d0], p0, 0, 0, 0);
        p1 = __builtin_amdgcn_mfma_f32_32x32x16_bf16(kf[2 * d0 + 1], qf[d0], p1, 0, 0, 0);
    }
}
struct VFrag { s16x4 lo[8], hh[8]; };
__device__ __forceinline__ void vload(VFrag& vf, const LAS unsigned char* vslot, int lane) {
    const int hi = lane >> 5;
    const unsigned vb = (unsigned)(uintptr_t)vslot + ((lane >> 4) & 1) * 32 + (lane & 3) * 8 + (4 * hi + ((lane & 15) >> 2)) * 64;
#pragma unroll
    for (int i = 0; i < 8; ++i) { const int d0 = i >> 2, ks = i & 3;
        asm volatile("ds_read_b64_tr_b16 %0, %1 offset:%c2" : "=&v"(vf.lo[i]) : "v"(vb), "i"(d0 * 4096 + ks * 1024) : "memory");
        asm volatile("ds_read_b64_tr_b16 %0, %1 offset:%c2" : "=&v"(vf.hh[i]) : "v"(vb), "i"(d0 * 4096 + ks * 1024 + 512) : "memory"); }
}
__device__ __forceinline__ void pvmm(f32x16 (&oT)[2], const VFrag& vf, const f32x16& p0, const f32x16& p1) {
    bf16x8 pb[4];
#pragma unroll
    for (int ks = 0; ks < 4; ++ks) { const f32x16& p = (ks < 2) ? p0 : p1; const int b = (ks & 1) * 8;
        u32x4 w; w.x = cvtpk(p[b], p[b + 1]); w.y = cvtpk(p[b + 2], p[b + 3]); w.z = cvtpk(p[b + 4], p[b + 5]); w.w = cvtpk(p[b + 6], p[b + 7]); pb[ks] = __builtin_bit_cast(bf16x8, w); }
#pragma unroll
    for (int i = 0; i < 8; ++i) { const int d0 = i >> 2, ks = i & 3;
        const bf16x8 v = (bf16x8){vf.lo[i][0], vf.lo[i][1], vf.lo[i][2], vf.lo[i][3], vf.hh[i][0], vf.hh[i][1], vf.hh[i][2], vf.hh[i][3]};
        oT[d0] = __builtin_amdgcn_mfma_f32_32x32x16_bf16(v, pb[ks], oT[d0], 0, 0, 0); }
}
#define AT_VWAIT() do { asm volatile("s_waitcnt lgkmcnt(0)" ::: "memory"); __builtin_amdgcn_sched_barrier(0); } while (0)
__device__ __forceinline__ float max3f(float a, float b, float c) { float r; asm("v_max3_f32 %0, %1, %2, %3" : "=v"(r) : "v"(a), "v"(b), "v"(c)); return r; }
__device__ __forceinline__ float rowmax32(const f32x16& p0, const f32x16& p1) {
    float a = max3f(p0[0], p0[1], p1[0]), b = max3f(p0[2], p0[3], p1[1]); a = max3f(a, p1[2], p1[3]);
#pragma unroll
    for (int r = 4; r < 16; r += 4) { a = max3f(a, p0[r], p0[r + 1]); b = max3f(b, p0[r + 2], p0[r + 3]); a = max3f(a, p1[r], p1[r + 1]); b = max3f(b, p1[r + 2], p1[r + 3]); }
    const float m = fmaxf(a, b);
    return fmaxf(m, swap_get(m));
}
constexpr float NEG = -1.0e30f, SM_THR = 8.f, SM_BIG = 16777216.f;
struct SmState { float negm, l; bool mset, allset; };
__device__ __forceinline__ void sm_init(SmState& st) { st.negm = 0.f; st.l = 0.f; st.mset = false; st.allset = false; }
__device__ __forceinline__ f32x16 splat16(float v) { f32x16 c;
#pragma unroll
    for (int r = 0; r < 16; ++r) c[r] = v;
    return c; }
template <bool HAS_O> __device__ __forceinline__ void softmax_tile(f32x16& p0, f32x16& p1, SmState& st, f32x16 (&oT)[2]) {
    asm volatile("s_nop 7\n\ts_nop 7\n\ts_nop 7" : "+v"(p0), "+v"(p1));
    const float rm = rowmax32(p0, p1);
    const bool need = (rm > SM_THR) || (!st.mset && rm > -1.0e29f);
    if (__any(need)) {
        const float delta = need ? rm : 0.f; const float f = need ? (st.mset ? fexp2(-delta) : 0.f) : 1.f;
        st.negm -= delta; st.l *= f; st.mset = st.mset || need;
#pragma unroll
        for (int r = 0; r < 16; ++r) { p0[r] -= delta; p1[r] -= delta; if (HAS_O) { oT[0][r] *= f; oT[1][r] *= f; } }
    }
    float s0 = 0.f, s1 = 0.f;
#pragma unroll
    for (int r = 0; r < 16; ++r) { p0[r] = fexp2(p0[r]); p1[r] = fexp2(p1[r]); s0 += p0[r]; s1 += p1[r]; }
    st.l += s0 + s1;
    st.allset = __all(st.mset);
}
__device__ __forceinline__ bool softmax_fast(f32x16& p0, f32x16& p1, SmState& st) {
    float s0 = 0.f, s1 = 0.f;
#pragma unroll
    for (int r = 0; r < 16; ++r) { p0[r] = fexp2(p0[r]); p1[r] = fexp2(p1[r]); s0 += p0[r]; asm("" : "+v"(s0)); s1 += p1[r]; asm("" : "+v"(s1)); }
    const float sum = s0 + s1;
    if (__any(!(sum < SM_BIG))) return false;
    st.l += sum; return true;
}
__device__ __forceinline__ void load_q(bf16x8 (&qf)[4], const bf16_t* qrow, int lane) {
#pragma unroll
    for (int d0 = 0; d0 < 4; ++d0) qf[d0] = *(const bf16x8*)(qrow + d0 * 16 + (lane >> 5) * 8);
    asm volatile("" : "+v"(qf[0]), "+v"(qf[1]), "+v"(qf[2]), "+v"(qf[3]));
}
__device__ __forceinline__ int next_item(int* head, LAS unsigned char* lds) {
    LAS int* slot = (LAS int*)(lds + AT_FLAG + 128);
    __syncthreads();
    if (threadIdx.x == 0) slot[0] = atomicAdd(head, 1);
    __syncthreads();
    return slot[0];
}

#define QPREFETCH(head) int q_nx_ = 0; if (threadIdx.x == 0) q_nx_ = atomicAdd((head), 1)
#define QADVANCE(cur, lds) do { LAS int* q_slot_ = (LAS int*)((lds) + AT_FLAG + 128); if (threadIdx.x == 0) q_slot_[0] = q_nx_; \
        asm volatile("s_waitcnt lgkmcnt(0)\n\ts_barrier" ::: "memory"); (cur) = q_slot_[0]; asm volatile("s_waitcnt lgkmcnt(0)\n\ts_barrier" ::: "memory"); } while (0)

__device__ __forceinline__ void win_item(int item, const bf16_t* NQ, const bf16_t* KW, const bf16_t* VW, const float* NG, float* YPART, LAS unsigned char* lds) {
    const int tid = threadIdx.x, lane = tid & 63, wid = __builtin_amdgcn_readfirstlane(tid >> 6), hi = lane >> 5, q = lane & 31;
    const int qb = item & 127, bg = item >> 7, b = bg >> 1, g = bg & 1;
    const size_t rowbase = (size_t)b * SEQ; const int t0 = qb * 64, tl = wid * 8 + (q >> 2), t = t0 + tl, hq = g * 4 + (q & 3);
    const KVTile kv{KW + rowbase * 128 + g * 64, VW + rowbase * 128 + g * 64, 128};
    bf16x8 qf[4]; load_q(qf, NQ + (rowbase + t) * 512 + hq * 64, lane);
    const int T1 = qb, T0 = (qb >= 8) ? qb - 8 : 0, NT = T1 - T0 + 1;
    f32x16 oT[2]; SmState st; sm_init(st);
#pragma unroll
    for (int r = 0; r < 16; ++r) { oT[0][r] = 0.f; oT[1][r] = 0.f; }
    dma_kv(lds, kv, T0 * 64, 0, wid, lane);
    if (NT > 1) dma_kv(lds, kv, (T0 + 1) * 64, 1, wid, lane);
    for (int i = 0; i < NT; ++i) {
        if (i + 1 < NT) { AT_WAIT_BAR(2); } else { AT_WAIT_BAR(0); }
        if (i + 2 < NT) dma_kv(lds, kv, (T0 + i + 2) * 64, (i + 2) % 3, wid, lane);
        const int T = T0 + i, slot = i % 3;
        f32x16 p0, p1; qkt(p0, p1, lds + AT_K + slot * AT_SLOT, qf, splat16(st.negm), lane);
        VFrag vf; vload(vf, lds + AT_V + slot * AT_SLOT, lane);
        if (T == T1 || T == qb - 8) {
            const int lo_ = t - 511 - T * 64 - 4 * hi, hi_ = t - T * 64 - 4 * hi;
#pragma unroll
            for (int r = 0; r < 16; ++r) { if (CROW0(r) < lo_ || CROW0(r) > hi_) p0[r] = NEG; if (CROW0(r) + 32 < lo_ || CROW0(r) + 32 > hi_) p1[r] = NEG; }
        }
        softmax_tile<true>(p0, p1, st, oT);
        AT_VWAIT(); pvmm(oT, vf, p0, p1);
    }
    const float l = st.l + swap_get(st.l);
    const float sc = NG[(rowbase + t) * 24 + hq * 3 + 2] / l;
    float* yp = YPART + (rowbase + t) * 512 + hq * 64;
#pragma unroll
    for (int d0 = 0; d0 < 2; ++d0)
#pragma unroll
        for (int c = 0; c < 4; ++c) *(f32x4*)(yp + d0 * 32 + 8 * c + 4 * hi) = (f32x4){oT[d0][4 * c] * sc, oT[d0][4 * c + 1] * sc, oT[d0][4 * c + 2] * sc, oT[d0][4 * c + 3] * sc};
    asm volatile("s_waitcnt lgkmcnt(0)\n\ts_barrier" ::: "memory");
}

__device__ __forceinline__ void cmpsel_item(int item, const bf16_t* NQ, const bf16_t* KCMP, const bf16_t* VCMP, const bf16_t* KS, const bf16_t* VS, const bf16_t* KW, const bf16_t* VW, const float* NG,
                                            const float* YPART, bf16_t* YNSA, LAS unsigned char* lds, unsigned long long* istamp = nullptr) {
    const int tid = threadIdx.x, lane = tid & 63, wid = __builtin_amdgcn_readfirstlane(tid >> 6), hi = lane >> 5, q = lane & 31;
    const int qb = 127 - (item & 127), bg = item >> 7, b = bg >> 1, g = bg & 1;
    const size_t rowbase = (size_t)b * SEQ; const int t0 = qb * 64, tl = wid * 8 + (q >> 2), t = t0 + tl, hq = g * 4 + (q & 3);
    LAS float* pslc = (LAS float*)(lds + AT_PSLC); LAS unsigned* msk = (LAS unsigned*)(lds + AT_MASK); LAS unsigned* flg = (LAS unsigned*)(lds + AT_FLAG);
#ifdef PROBE_ITEM
#define ISTAMP(i) do { if (istamp && threadIdx.x == 0) istamp[i] = __builtin_amdgcn_s_memrealtime(); } while (0)
#else
#define ISTAMP(i) do { } while (0)
#endif
    ISTAMP(0);
    float g_c = NG[(rowbase + t) * 24 + hq * 3 + 0], g_s = NG[(rowbase + t) * 24 + hq * 3 + 1], g_w = NG[(rowbase + t) * 24 + hq * 3 + 2];
    bf16x8 qf[4]; load_q(qf, NQ + (rowbase + t) * 512 + hq * 64, lane);
    asm volatile("" : "+v"(g_c), "+v"(g_s), "+v"(g_w));
    const KVTile kvc{KCMP + (size_t)bg * 512 * 64, VCMP + (size_t)bg * 512 * 64, 64};
    const KVTile kvs{KS + rowbase * 128 + g * 64, VS + rowbase * 128 + g * 64, 128};
    f32x16 oT[2]; SmState st;
    {
        const KVTile kvw{KW + rowbase * 128 + g * 64, VW + rowbase * 128 + g * 64, 128};
        const int T1 = qb, T0 = (qb >= 8) ? qb - 8 : 0, NT = T1 - T0 + 1;
        sm_init(st);
#pragma unroll
        for (int r = 0; r < 16; ++r) { oT[0][r] = 0.f; oT[1][r] = 0.f; }
        dma_kv(lds, kvw, T0 * 64, 0, wid, lane);
        if (NT > 1) dma_kv(lds, kvw, (T0 + 1) * 64, 1, wid, lane);
        if (NT > 2) dma_kv(lds, kvw, (T0 + 2) * 64, 2, wid, lane);
        for (int i = 0; i < NT; ++i) {
            if (i + 2 < NT) { AT_WAIT_BAR(4); } else if (i + 1 < NT) { AT_WAIT_BAR(2); } else { AT_WAIT_BAR(0); }
            if (i + 3 < NT) dma_kv(lds, kvw, (T0 + i + 3) * 64, (i + 3) % AT_NS, wid, lane);
            const int T = T0 + i, slot = i % AT_NS;
            f32x16 p0, p1; VFrag vf;
            for (bool exact = !st.allset;; exact = true) {
                qkt(p0, p1, lds + AT_K + slot * AT_SLOT, qf, splat16(st.negm), lane);
                vload(vf, lds + AT_V + slot * AT_SLOT, lane);
                if (T == T1 || T == qb - 8) {
                    const int lo_ = t - 511 - T * 64 - 4 * hi, hi_ = t - T * 64 - 4 * hi;
#pragma unroll
                    for (int r = 0; r < 16; ++r) { if (CROW0(r) < lo_ || CROW0(r) > hi_) p0[r] = NEG; if (CROW0(r) + 32 < lo_ || CROW0(r) + 32 > hi_) p1[r] = NEG; }
                }
                if (exact) { softmax_tile<true>(p0, p1, st, oT); break; }
                if (softmax_fast(p0, p1, st)) break;
            }
            AT_VWAIT(); pvmm(oT, vf, p0, p1);
        }
        const float lw = st.l + swap_get(st.l);
        const float scw = g_w / lw;
#pragma unroll
        for (int r = 0; r < 16; ++r) { oT[0][r] *= scw; oT[1][r] *= scw; }
        asm volatile("s_waitcnt lgkmcnt(0)\n\ts_barrier" ::: "memory");
        dma_kv(lds, kvs, 0, 3, wid, lane);
    }
    ISTAMP(1);
    const int nv = (t >= 31) ? ((t - 31) >> 4) + 1 : 0;
    const int tw = t0 + wid * 8; const int nvw = (tw >= 31) ? ((tw - 31) >> 4) + 1 : 0;
    const int nvmax = (t0 + 63 >= 31) ? ((t0 + 63 - 31) >> 4) + 1 : 0, NTc = (nvmax + 63) >> 6;
    if (tid < 8) flg[tid] = 0u;
    float lc = 0.f, inv = 0.f;
    sm_init(st);
    {
        dma_kv(lds, kvc, 0, 0, wid, lane); if (NTc > 1) dma_kv(lds, kvc, 64, 1, wid, lane);
        for (int i = 0; i < NTc; ++i) {
            if (i + 1 < NTc) { AT_WAIT_BAR(2); } else { AT_WAIT_BAR(0); }
            if (i + 2 < NTc) dma_kv(lds, kvc, (i + 2) * 64, (i + 2) % 3, wid, lane);
            f32x16 p0, p1;
            for (bool exact = !st.allset;; exact = true) {
                qkt(p0, p1, lds + AT_K + (i % 3) * AT_SLOT, qf, splat16(st.negm), lane);
                if (i * 64 + 64 > nvw) { const int lim = nv - i * 64 - 4 * hi;
#pragma unroll
                    for (int r = 0; r < 16; ++r) { if (CROW0(r) >= lim) p0[r] = NEG; if (CROW0(r) + 32 >= lim) p1[r] = NEG; } }
                if (exact) { softmax_tile<false>(p0, p1, st, oT); break; }
                if (softmax_fast(p0, p1, st)) break;
            }
        }
        asm volatile("s_waitcnt lgkmcnt(0)\n\ts_barrier" ::: "memory");
    }
    lc = st.l + swap_get(st.l);
    inv = (nv > 0) ? 1.f / lc : 0.f;
    const float ccmp = fmaxf(g_c * inv, 1e-20f);
    { const float rc = 1.f / ccmp;
#pragma unroll
      for (int r = 0; r < 16; ++r) { oT[0][r] *= rc; oT[1][r] *= rc; } }
    {
        float carryB = 0.f;
        dma_kv(lds, kvc, 0, 0, wid, lane); if (NTc > 1) dma_kv(lds, kvc, 64, 1, wid, lane);
        for (int i = 0; i < NTc; ++i) {
            if (i + 1 < NTc) { AT_WAIT_BAR(2); } else { AT_WAIT_BAR(0); }
            if (i + 2 < NTc) dma_kv(lds, kvc, (i + 2) * 64, (i + 2) % 3, wid, lane);
            f32x16 p0, p1; qkt(p0, p1, lds + AT_K + (i % 3) * AT_SLOT, qf, splat16(st.negm), lane);
            VFrag vf; vload(vf, lds + AT_V + (i % 3) * AT_SLOT, lane);
            if (i * 64 + 64 > nvw) { const int lim = nv - i * 64 - 4 * hi;
#pragma unroll
                for (int r = 0; r < 16; ++r) { if (CROW0(r) >= lim) p0[r] = NEG; if (CROW0(r) + 32 >= lim) p1[r] = NEG; } }
#pragma unroll
            for (int r = 0; r < 16; ++r) { p0[r] = fexp2(p0[r]); p1[r] = fexp2(p1[r]); }
            AT_VWAIT(); pvmm(oT, vf, p0, p1);
            { float Aq[2][4], PB[2][4];
#pragma unroll
              for (int kh = 0; kh < 2; ++kh)
#pragma unroll
                  for (int c = 0; c < 4; ++c) { const f32x16& p = kh ? p1 : p0;
                      Aq[kh][c] = quad_sum(((p[4 * c] + p[4 * c + 1]) + (p[4 * c + 2] + p[4 * c + 3])) * inv); PB[kh][c] = swap_get(quad_sum(p[4 * c + 3] * inv)); }
#pragma unroll
              for (int kh = 0; kh < 2; ++kh)
#pragma unroll
                  for (int c = 0; c < 4; ++c) { const float prevB = hi ? PB[kh][c] : (c ? PB[kh][c ? c - 1 : 0] : (kh ? PB[0][3] : carryB));
                      const int j = 16 * i + 8 * kh + 2 * c + hi;
                      if ((q & 3) == 0 && j < 128) pslc[tl * 128 + j] = Aq[kh][c] + prevB; }
              carryB = PB[1][3]; }
        }
        asm volatile("s_waitcnt lgkmcnt(0)\n\ts_barrier" ::: "memory");
    }
    f32x16 yp[2];
#pragma unroll
    for (int r = 0; r < 16; ++r) { yp[0][r] = oT[0][r] * ccmp; yp[1][r] = oT[1][r] * ccmp; oT[0][r] = 0.f; oT[1][r] = 0.f; }
    ISTAMP(2);
    asm volatile("s_waitcnt lgkmcnt(0)" ::: "memory");
    unsigned long long ulo = 0ull, uhi = 0ull;
    for (int tk = 0; tk < 8; ++tk) {
        const int row = wid * 8 + tk; const int j0 = lane, j1 = lane + 64;
        const bool f0 = (j0 == 0) || (j0 == qb) || (j0 == qb - 1), f1 = (j1 == qb) || (j1 == qb - 1);
        unsigned long long mlo, mhi;
        if (qb < 16) { mlo = __ballot(j0 <= qb); mhi = 0ull; }
        else {
            const unsigned k0 = (!f0 && j0 <= qb) ? __float_as_uint(pslc[row * 128 + j0]) + 1u : 0u, k1 = (!f1 && j1 <= qb) ? __float_as_uint(pslc[row * 128 + j1]) + 1u : 0u;
            unsigned T = 0u;
            for (int bit = 31; bit >= 0; --bit) { const unsigned cand = T | (1u << bit);
                const int cnt = __popcll(__ballot(k0 >= cand)) + __popcll(__ballot(k1 >= cand)); if (cnt >= 13) T = cand;
                if (cnt == 13) break; }
            const bool gt0 = k0 > T, gt1 = k1 > T, eq0 = (k0 == T), eq1 = (k1 == T);
            const unsigned long long be0 = __ballot(eq0), be1 = __ballot(eq1);
            const int rem = 13 - (__popcll(__ballot(gt0)) + __popcll(__ballot(gt1)));
            const unsigned long long below = (lane == 0) ? 0ull : (~0ull >> (64 - lane));
            const int pre0 = __popcll(be0 & below), pre1 = __popcll(be0) + __popcll(be1 & below);
            mlo = __ballot(f0 || gt0 || (eq0 && pre0 < rem)); mhi = __ballot(f1 || gt1 || (eq1 && pre1 < rem));
        }
        ulo |= mlo; uhi |= mhi;
        if (lane == 0) { msk[row * 4 + 0] = (unsigned)mlo; msk[row * 4 + 1] = (unsigned)(mlo >> 32); msk[row * 4 + 2] = (unsigned)mhi; msk[row * 4 + 3] = (unsigned)(mhi >> 32); }
    }
    if (lane == 0) { (void)__hip_atomic_fetch_or(&flg[0], (unsigned)ulo, __ATOMIC_RELAXED, __HIP_MEMORY_SCOPE_WORKGROUP); (void)__hip_atomic_fetch_or(&flg[1], (unsigned)(ulo >> 32), __ATOMIC_RELAXED, __HIP_MEMORY_SCOPE_WORKGROUP);
                     (void)__hip_atomic_fetch_or(&flg[2], (unsigned)uhi, __ATOMIC_RELAXED, __HIP_MEMORY_SCOPE_WORKGROUP); (void)__hip_atomic_fetch_or(&flg[3], (unsigned)(uhi >> 32), __ATOMIC_RELAXED, __HIP_MEMORY_SCOPE_WORKGROUP); }
    asm volatile("s_waitcnt lgkmcnt(0)\n\ts_barrier" ::: "memory");
    const unsigned mk0 = msk[tl * 4 + 0], mk1 = msk[tl * 4 + 1], mk2 = msk[tl * 4 + 2], mk3 = msk[tl * 4 + 3];
    unsigned long long blo = ((unsigned long long)flg[1] << 32) | flg[0], bhi = ((unsigned long long)flg[3] << 32) | flg[2];
    blo = (unsigned long long)(unsigned)__builtin_amdgcn_readfirstlane((unsigned)blo) | ((unsigned long long)(unsigned)__builtin_amdgcn_readfirstlane((unsigned)(blo >> 32)) << 32);
    bhi = (unsigned long long)(unsigned)__builtin_amdgcn_readfirstlane((unsigned)bhi) | ((unsigned long long)(unsigned)__builtin_amdgcn_readfirstlane((unsigned)(bhi >> 32)) << 32);
    ISTAMP(3);
    auto nextbit = [&](int from) -> int {
        if (from < 64) { const unsigned long long x = blo & (~0ull << from); if (x) return __builtin_ctzll(x); from = 64; }
        if (from < 128) { const unsigned long long x = bhi & (~0ull << (from - 64)); if (x) return 64 + __builtin_ctzll(x); }
        return 128; };
    sm_init(st);
    const int tlh = tl - 4 * hi;
    int jc = nextbit(0), jn = nextbit(jc + 1), jnn = (jn < 128) ? nextbit(jn + 1) : 128, jn3 = (jnn < 128) ? nextbit(jnn + 1) : 128, i = 0;
    if (jn < 128) dma_kv(lds, kvs, jn * 64, 0, wid, lane); if (jnn < 128) dma_kv(lds, kvs, jnn * 64, 1, wid, lane);
    while (jc < 128) {
        if (jnn < 128) { AT_WAIT_BAR(4); } else if (jn < 128) { AT_WAIT_BAR(2); } else { AT_WAIT_BAR(0); }
        if (jn3 < 128) dma_kv(lds, kvs, jn3 * 64, (i + 2) % AT_NS, wid, lane);
        const bool wave_needs = (jc < 64) ? ((ulo >> jc) & 1ull) : ((uhi >> (jc - 64)) & 1ull);
        if (wave_needs) {
            const unsigned w = (jc < 32) ? mk0 : (jc < 64) ? mk1 : (jc < 96) ? mk2 : mk3;
            const bool mine = (w >> (jc & 31)) & 1u;
            f32x16 p0, p1; VFrag vf;
            for (bool exact = !st.allset;; exact = true) {
                qkt(p0, p1, lds + AT_K + ((i + 3) % AT_NS) * AT_SLOT, qf, splat16(mine ? st.negm : NEG), lane);
                vload(vf, lds + AT_V + ((i + 3) % AT_NS) * AT_SLOT, lane);
                if (jc == qb) {
#pragma unroll
                    for (int r = 0; r < 16; ++r) { if (CROW0(r) > tlh) p0[r] = NEG; if (CROW0(r) + 32 > tlh) p1[r] = NEG; } }
                if (exact) { softmax_tile<true>(p0, p1, st, oT); break; }
                if (softmax_fast(p0, p1, st)) break;
            }
            AT_VWAIT(); pvmm(oT, vf, p0, p1);
        }
        jc = jn; jn = jnn; jnn = jn3; jn3 = (jn3 < 128) ? nextbit(jn3 + 1) : 128; ++i;
    }
    ISTAMP(4);
    const float l = st.l + swap_get(st.l);
    const float sc = g_s / l;
    bf16_t* yo = YNSA + (rowbase + t) * 512 + hq * 64;
#pragma unroll
    for (int d0 = 0; d0 < 2; ++d0)
#pragma unroll
        for (int c = 0; c < 4; ++c) {
            u32x2 o; o.x = cvtpk(yp[d0][4 * c] + oT[d0][4 * c] * sc, yp[d0][4 * c + 1] + oT[d0][4 * c + 1] * sc);
            o.y = cvtpk(yp[d0][4 * c + 2] + oT[d0][4 * c + 2] * sc, yp[d0][4 * c + 3] + oT[d0][4 * c + 3] * sc);
            *(u32x2*)(yo + d0 * 32 + 8 * c + 4 * hi) = o; }
    asm volatile("s_waitcnt lgkmcnt(0)\n\ts_barrier" ::: "memory");
}

constexpr float SB_THR = 48.f;
__device__ __forceinline__ void sb_item(int item, const bf16_t* SBQ, const bf16_t* SBK, const bf16_t* SBV, bf16_t* YSB, LAS unsigned char* lds) {
    const int tid = threadIdx.x, lane = tid & 63, wid = __builtin_amdgcn_readfirstlane(tid >> 6), hi = lane >> 5, q = lane & 31;
    const int qblk = 31 - (item & 31), bh = item >> 5, b = bh >> 3, h = bh & 7;
    const size_t rowbase = (size_t)b * SEQ; const int q0 = qblk * 256, tw0 = q0 + 32 * wid, t = tw0 + q;
    LAS unsigned* flg = (LAS unsigned*)(lds + AT_FLAG);
    const KVTile kv{SBK + rowbase * 512 + h * 64, SBV + rowbase * 512 + h * 64, 512};
    bf16x8 qf[4]; load_q(qf, SBQ + (rowbase + t) * 512 + h * 64, lane);
    f32x16 oT[2];
#pragma unroll
    for (int r = 0; r < 16; ++r) { oT[0][r] = 0.f; oT[1][r] = 0.f; }
    float carry = 0.f; bool wdone = false; f32x16 zv;
#pragma unroll
    for (int r = 0; r < 16; ++r) zv[r] = 0.f;
    const int Tmax = (q0 + 254) >> 6, NT = Tmax + 1;
    if (tid < 8) flg[tid] = 0u;
    dma_kv(lds, kv, Tmax * 64, 0, wid, lane); if (NT > 1) dma_kv(lds, kv, (Tmax - 1) * 64, 1, wid, lane);
    for (int i = 0; i < NT; ++i) {
        if (i + 1 < NT) { AT_WAIT_BAR(2); } else { AT_WAIT_BAR(0); }
        if ((flg[0] & flg[1] & flg[2] & flg[3] & flg[4] & flg[5] & flg[6] & flg[7]) != 0u) break;
        if (i + 2 < NT) dma_kv(lds, kv, (Tmax - i - 2) * 64, (i + 2) % 3, wid, lane);
        const int T = Tmax - i, slot = i % 3;
        if (!wdone && 64 * T <= tw0 + 30) {
            f32x16 p0, p1; qkt(p0, p1, lds + AT_K + slot * AT_SLOT, qf, zv, lane);
            const int lim = t - 64 * T - 4 * hi;
            f32x16 k0v, k1v;
#pragma unroll
            for (int r = 0; r < 16; ++r) {
                const int kl = CROW0(r);
                { const float z = fminf(p0[r], 64.f); const float sp = flog2(1.f + fexp2(z)); const bool v = kl < lim; k0v[r] = v ? -sp : 0.f; p0[r] = v ? z - sp : NEG; }
                { const float z = fminf(p1[r], 64.f); const float sp = flog2(1.f + fexp2(z)); const bool v = kl + 32 < lim; k1v[r] = v ? -sp : 0.f; p1[r] = v ? z - sp : NEG; }
            }
            float R = carry;
#pragma unroll
            for (int kh = 1; kh >= 0; --kh)
#pragma unroll
                for (int c = 3; c >= 0; --c) { const f32x16& kk = kh ? k1v : k0v; f32x16& pp = kh ? p1 : p0;
                    const float G = (kk[4 * c] + kk[4 * c + 1]) + (kk[4 * c + 2] + kk[4 * c + 3]); const float PG = swap_get(G);
                    const float S = R + (hi ? 0.f : PG);
                    const float w2 = kk[4 * c + 3], w1 = w2 + kk[4 * c + 2], w0 = w1 + kk[4 * c + 1];
                    pp[4 * c + 3] = fexp2(pp[4 * c + 3] + S); pp[4 * c + 2] = fexp2(pp[4 * c + 2] + S + w2); pp[4 * c + 1] = fexp2(pp[4 * c + 1] + S + w1); pp[4 * c] = fexp2(pp[4 * c] + S + w0);
                    R += G + PG; }
            carry = R;
            { VFrag vf; vload(vf, lds + AT_V + slot * AT_SLOT, lane); AT_VWAIT(); pvmm(oT, vf, p0, p1); }
            wdone = __all(carry < -SB_THR) || (T == 0);
            if (wdone && lane == 0) flg[wid] = 1u;
        }
    }
    asm volatile("s_waitcnt vmcnt(0) lgkmcnt(0)\n\ts_barrier" ::: "memory");
    bf16_t* yo = YSB + (rowbase + t) * 512 + h * 64;
#pragma unroll
    for (int d0 = 0; d0 < 2; ++d0)
#pragma unroll
        for (int c = 0; c < 4; ++c) { u32x2 o; o.x = cvtpk(oT[d0][4 * c], oT[d0][4 * c + 1]); o.y = cvtpk(oT[d0][4 * c + 2], oT[d0][4 * c + 3]); *(u32x2*)(yo + d0 * 32 + 8 * c + 4 * hi) = o; }
    asm volatile("s_waitcnt lgkmcnt(0)\n\ts_barrier" ::: "memory");
}

__device__ __forceinline__ void compress_wave(int witem, const bf16_t* src, const bf16_t* wt1, const bf16_t* w2t, const float* c1, bf16_t* out, int lane) {
    const int rb = witem & 15, bg = witem >> 4, b = bg >> 1, g = bg & 1, hi = lane >> 5, li = lane & 31;
    const int i = rb * 32 + li;
    const bool valid = i < NCMP;
    const bf16_t* xrow = src + ((size_t)b * SEQ + 16 * (valid ? i : 0)) * 128 + g * 64;
    f32x16 hT[2];
#pragma unroll
    for (int r = 0; r < 16; ++r) { hT[0][r] = 0.f; hT[1][r] = 0.f; }
#pragma unroll 4
    for (int s = 0; s < 128; ++s) {
        const int k = 16 * s + 8 * hi;
        const bf16x8 xb = *(const bf16x8*)(xrow + (size_t)(k >> 6) * 128 + (k & 63));
        const bf16x8 a0 = *(const bf16x8*)(wt1 + (size_t)li * 2048 + k), a1 = *(const bf16x8*)(wt1 + (size_t)(32 + li) * 2048 + k);
        hT[0] = __builtin_amdgcn_mfma_f32_32x32x16_bf16(a0, xb, hT[0], 0, 0, 0);
        hT[1] = __builtin_amdgcn_mfma_f32_32x32x16_bf16(a1, xb, hT[1], 0, 0, 0);
    }
    bf16x8 hb[4];
#pragma unroll
    for (int nb = 0; nb < 2; ++nb)
#pragma unroll
        for (int sh = 0; sh < 2; ++sh) { float v[8];
#pragma unroll
            for (int j = 0; j < 8; ++j) { const int r = 8 * sh + j; const float a = hT[nb][r] + c1[32 * nb + crow(r, hi)];
                const float c = 0.7978845608028654f * (a + 0.044715f * a * a * a); const float e = __expf(2.f * c); const float th = 1.f - 2.f / (e + 1.f); v[j] = 0.5f * a * (1.f + th); }
            u32x4 w; w.x = cvtpk(v[0], v[1]); w.y = cvtpk(v[2], v[3]); w.z = cvtpk(v[4], v[5]); w.w = cvtpk(v[6], v[7]); hb[nb * 2 + sh] = __builtin_bit_cast(bf16x8, w); }
    f32x16 oT[2];
#pragma unroll
    for (int r = 0; r < 16; ++r) { oT[0][r] = 0.f; oT[1][r] = 0.f; }
#pragma unroll
    for (int mb = 0; mb < 2; ++mb)
#pragma unroll
        for (int ks = 0; ks < 4; ++ks) {
            const bf16_t* wp = w2t + (size_t)(32 * mb + li) * 64 + 16 * ks + 4 * hi;
            const u32x2 lo = *(const u32x2*)wp, hh = *(const u32x2*)(wp + 8);
            const u32x4 w = {lo.x, lo.y, hh.x, hh.y};
            oT[mb] = __builtin_amdgcn_mfma_f32_32x32x16_bf16(__builtin_bit_cast(bf16x8, w), hb[ks], oT[mb], 0, 0, 0);
        }
    bf16_t* op = out + ((size_t)bg * 512 + i) * 64;
#pragma unroll
    for (int mb = 0; mb < 2; ++mb)
#pragma unroll
        for (int c = 0; c < 4; ++c) { u32x2 o; o.x = valid ? cvtpk(oT[mb][4 * c], oT[mb][4 * c + 1]) : 0u; o.y = valid ? cvtpk(oT[mb][4 * c + 2], oT[mb][4 * c + 3]) : 0u;
            *(u32x2*)(op + 32 * mb + 8 * c + 4 * hi) = o; }
}

struct AttnArgs { const bf16_t* sbq; const bf16_t* sbk; const bf16_t* sbv; const bf16_t* nq; const bf16_t* kv6; const float* ng; bf16_t* kcmp; bf16_t* vcmp;
                  bf16_t* ysb; bf16_t* ynsa; float* ypart; const bf16_t* wt1k; const bf16_t* wt1v; const bf16_t* w2tk; const bf16_t* w2tv; const float* c1k; const float* c1v; int* qhead; };
__device__ __forceinline__ void attn_phase1(const AttnArgs& a, LAS unsigned char* lds) {
    const size_t S128 = (size_t)NTOK * 128; const int lane = threadIdx.x & 63, wid = __builtin_amdgcn_readfirstlane(threadIdx.x >> 6);
    for (;;) { const int it = next_item(a.qhead, lds); if (it >= 64) break;
        const int w = it * 8 + wid;
        if (w < 256) compress_wave(w, a.kv6 + 0 * S128, a.wt1k, a.w2tk, a.c1k, a.kcmp, lane); else compress_wave(w - 256, a.kv6 + 1 * S128, a.wt1v, a.w2tv, a.c1v, a.vcmp, lane);
        asm volatile("s_waitcnt vmcnt(0)" ::: "memory"); __syncthreads();
        if (threadIdx.x == 0) { __builtin_amdgcn_fence(__ATOMIC_RELEASE, "agent"); asm volatile("s_waitcnt vmcnt(0)" ::: "memory");
            (void)__hip_atomic_fetch_add((gu32*)(a.qhead + 48), 1u, __ATOMIC_RELAXED, __HIP_MEMORY_SCOPE_AGENT); } }
#ifndef REP_SB
#define REP_SB 1
#endif
#ifndef REP_WIN
#define REP_WIN 1
#endif
    for (int rs = 0; rs < REP_SB; ++rs) { int* h = a.qhead + 16 + 8 * rs; int cur = next_item(h, lds); while (cur < 2048) { QPREFETCH(h); sb_item(cur, a.sbq, a.sbk, a.sbv, a.ysb, lds); QADVANCE(cur, lds); } }
}
__device__ __forceinline__ void attn_phase2(const AttnArgs& a, LAS unsigned char* lds, int xcc) {
    const size_t S128 = (size_t)NTOK * 128;
    if (threadIdx.x == 0) { gu32* cd = (gu32*)(a.qhead + 48);
        for (unsigned sp = 0; __hip_atomic_load(cd, __ATOMIC_RELAXED, __HIP_MEMORY_SCOPE_AGENT) < 64u && sp < (1u << 24); ++sp) __builtin_amdgcn_s_sleep(2);
        __builtin_amdgcn_fence(__ATOMIC_ACQUIRE, "agent"); asm volatile("s_waitcnt vmcnt(0)" ::: "memory"); }
    __syncthreads();
#ifdef PROBE_ITEM
    int nitem_ = 0;
#endif
    for (int pass = 0; pass < 8; ++pass) {
        const int x = (xcc + pass) & 7;
        int* h = a.qhead + 64 + 16 * x; int it = next_item(h, lds);
        while (it < 256) {
            QPREFETCH(h);
            const int qbi = it >> 1, bg = 2 * x + (it & 1);
#ifdef PROBE_ITEM
            unsigned long long* ist = (blockIdx.x == PROBE_BLOCK && nitem_ == PROBE_ITEM) ? (unsigned long long*)(a.qhead - CT_Q + 2048) + 16 : nullptr; ++nitem_;
            cmpsel_item((bg << 7) | qbi, a.nq, a.kcmp, a.vcmp, a.kv6 + 2 * S128, a.kv6 + 3 * S128, a.kv6 + 4 * S128, a.kv6 + 5 * S128, a.ng, a.ypart, a.ynsa, lds, ist);
#else
            cmpsel_item((bg << 7) | qbi, a.nq, a.kcmp, a.vcmp, a.kv6 + 2 * S128, a.kv6 + 3 * S128, a.kv6 + 4 * S128, a.kv6 + 5 * S128, a.ng, a.ypart, a.ynsa, lds);
#endif
            QADVANCE(it, lds);
        }
    }
}
typedef float f32x4v __attribute__((ext_vector_type(4)));
__device__ __forceinline__ void router_phase(const float* U, const f32x2* stats, const float* g1, const float* b1, const float* wr, const float* br, f32x2* MR, bf16_t* H1B,
                                             int* cnt, int* list, float* topw, int* tope, int* spos, LAS unsigned char* lds, int vcu, int G) {
    const int tid = threadIdx.x, lane = tid & 63, wave = __builtin_amdgcn_readfirstlane(tid >> 6), r = lane & 15, kq = lane >> 4;
    LAS float* W = (LAS float*)lds;
    LAS float* stg = (LAS float*)(lds + 131072 + wave * 2048);
    LAS int* stB = (LAS int*)(lds + 147456);
    LAS float* G1L = (LAS float*)(lds + 151552); LAS float* B1L = (LAS float*)(lds + 155904);
    LAS int* hist = (LAS int*)(lds + 155648); LAS int* basee = hist + 32;
    if (tid < 32) hist[tid] = 0;
    if (tid < 256) { *(LAS f32x4*)(G1L + tid * 4) = *(const f32x4*)(g1 + tid * 4); *(LAS f32x4*)(B1L + tid * 4) = *(const f32x4*)(b1 + tid * 4); }
    for (int i = tid; i < 1024 * 8; i += NTHREADS) { const int k = i >> 3, c4 = (i & 7) * 4; const f32x4 v = *(const f32x4*)(wr + k * 32 + c4);
        *(LAS f32x4*)(W + k * 32 + (c4 ^ (((k >> 3) & 1) << 4))) = v; }
    __syncthreads();
    const int sw = (kq & 1) << 4;
    for (int gbase = 0; gbase < NTOK / 16; gbase += 2 * G * NWAVES) {
    if (tid < 32) hist[tid] = 0;
    __syncthreads();
    int gi = 0;
    for (int grp = gbase + vcu * NWAVES + wave; grp < NTOK / 16 && gi < 2; grp += G * NWAVES, ++gi) {
        const int tok = grp * 16 + r; const float* up = U + (size_t)tok * DM + 8 * kq;
        float s = 0.f, s2 = 0.f;
        { const f32x4 q0 = *(const f32x4*)(stats + (size_t)tok * 16 + 4 * kq), q1 = *(const f32x4*)(stats + (size_t)tok * 16 + 4 * kq + 2);
          s = (q0[0] + q0[2]) + (q1[0] + q1[2]); s2 = (q0[1] + q0[3]) + (q1[1] + q1[3]); }
        s += __shfl_xor(s, 16); s += __shfl_xor(s, 32); s2 += __shfl_xor(s2, 16); s2 += __shfl_xor(s2, 32);
        const float mean = s * (1.f / DM); const float var = fmaxf(s2 * (1.f / DM) - mean * mean, 0.f); const float rstd = 1.f / sqrtf(var + LN_EPS);
        f32x4v acc0 = {0.f, 0.f, 0.f, 0.f}, acc1 = {0.f, 0.f, 0.f, 0.f};
        if (kq == 0) MR[tok] = (f32x2){mean, rstd};
        f32x4 ra[4], rb[4];
#pragma unroll
        for (int i = 0; i < 4; ++i) { ra[i] = *(const f32x4*)(up + 32 * i); rb[i] = *(const f32x4*)(up + 32 * i + 4); }
#pragma unroll 1
        for (int s4 = 0; s4 < 32; s4 += 4) {
#pragma unroll
        for (int u4 = 0; u4 < 4; ++u4) {
            const int st = s4 + u4, k0 = 32 * st + 8 * kq;
            const f32x4 a = ra[u4], b = rb[u4];
            { const int sn = (s4 < 28) ? st + 4 : st;
              ra[u4] = *(const f32x4*)(up + 32 * sn); rb[u4] = *(const f32x4*)(up + 32 * sn + 4); }
            const f32x4 ga = *(const LAS f32x4*)(G1L + k0), gb = *(const LAS f32x4*)(G1L + k0 + 4), ba = *(const LAS f32x4*)(B1L + k0), bb = *(const LAS f32x4*)(B1L + k0 + 4);
            const f32x4 ha = (a - mean) * rstd * ga + ba, hb = (b - mean) * rstd * gb + bb;
            u32x4 w; w.x = pk2(ha[0], ha[1]); w.y = pk2(ha[2], ha[3]); w.z = pk2(hb[0], hb[1]); w.w = pk2(hb[2], hb[3]);
            *(u32x4*)(H1B + (size_t)tok * DM + k0) = w;
            const LAS float* wp = W + k0 * 32;
#pragma unroll
            for (int j = 0; j < 8; ++j) { const float hv = (j < 4) ? ha[j & 3] : hb[j & 3];
                const float w0 = wp[j * 32 + (r ^ sw)], w1 = wp[j * 32 + ((r + 16) ^ sw)];
                acc0 = __builtin_amdgcn_mfma_f32_16x16x4f32(hv, w0, acc0, 0, 0, 0); acc1 = __builtin_amdgcn_mfma_f32_16x16x4f32(hv, w1, acc1, 0, 0, 0); }
        }
        }
        const float bi0 = br[r], bi1 = br[16 + r];
#pragma unroll
        for (int q = 0; q < 4; ++q) { stg[(4 * kq + q) * 32 + r] = acc0[q] + bi0; stg[(4 * kq + q) * 32 + 16 + r] = acc1[q] + bi1; }
        asm volatile("s_waitcnt lgkmcnt(0)" ::: "memory");
        if (lane < 16) {
            float v[32];
#pragma unroll
            for (int e = 0; e < 32; e += 4) { const f32x4 x = *(const LAS f32x4*)(stg + lane * 32 + e); v[e] = x[0]; v[e + 1] = x[1]; v[e + 2] = x[2]; v[e + 3] = x[3]; }
            float tv[4]; int ti[4];
#pragma unroll
            for (int k = 0; k < 4; ++k) { float bv = -INFINITY; int bi = 0;
#pragma unroll
                for (int e = 0; e < 32; ++e) { if (v[e] > bv) { bv = v[e]; bi = e; } }
                tv[k] = bv; ti[k] = bi;
#pragma unroll
                for (int e = 0; e < 32; ++e) if (e == bi) v[e] = -INFINITY; }
            const float e1 = expf(tv[1] - tv[0]), e2 = expf(tv[2] - tv[0]), e3 = expf(tv[3] - tv[0]); const float inv = 1.f / (1.f + e1 + e2 + e3);
            const float wv[4] = {inv, e1 * inv, e2 * inv, e3 * inv};
            const int tk = grp * 16 + lane;
#pragma unroll
            for (int k = 0; k < 4; ++k) { const int slot = tk * 4 + k; topw[slot] = wv[k]; tope[slot] = ti[k];
                const int lp = __hip_atomic_fetch_add(&hist[ti[k]], 1, __ATOMIC_RELAXED, __HIP_MEMORY_SCOPE_WORKGROUP);
                const int si = (gi * NWAVES + wave) * 64 + lane * 4 + k; stB[si] = (ti[k] << 20) | lp; }
        }
        asm volatile("s_waitcnt lgkmcnt(0)" ::: "memory");
    }
    __syncthreads();
    if (tid < 32) basee[tid] = atomicAdd(&cnt[tid], hist[tid]);
    __syncthreads();
    for (int si = tid; si < 1024; si += NTHREADS) { const int g2 = si >> 9, w2 = (si >> 6) & 7; const int grp = gbase + vcu * NWAVES + w2 + g2 * G * NWAVES;
        if (grp < NTOK / 16) { const int slot = (grp * 16 + ((si >> 2) & 15)) * 4 + (si & 3), pk = stB[si], e = pk >> 20, pos = basee[e] + (pk & 0xfffff); list[(size_t)e * NTOK + pos] = slot; spos[slot] = pos; } }
    __syncthreads();
    }
}
#include <hip/hip_cooperative_groups.h>
namespace cg = cooperative_groups;
struct MegaArgs {
    const float* pe_k; const float* w1_k; const float* w2_k; const float* pe_v; const float* w1_v; const float* w2_v;
    const float* x; const float* w_in; const float* w_sb; const float* w_nsa; const float* w_out; const float* w_gu; const float* w_dn;
    const float* b_gu; const float* b_dn; const float* ln1g; const float* ln1b; const float* w_r; const float* b_r; const float* ln2g; const float* ln2b;
    float* out; unsigned char* ws; int ph_lo, ph_hi;
};
__device__ __forceinline__ void combine_phase(const MegaArgs& A, LAS unsigned char* lds, int round, bool last, int vcu, int G, float oscale) {
    unsigned char* ws = A.ws; float* Y = A.out; const bf16_t* outr0 = (const bf16_t*)(ws + WS_OUTR0); const bf16_t* outr1 = (const bf16_t*)(ws + WS_OUTR1);
    const int* tope = (const int*)(ws + WS_TOPE); const int* spos = (const int*)(ws + WS_SPOS); const float* topw = (const float*)(ws + WS_TOPW);
    const LAS int* tstart = (const LAS int*)(lds + LDS_MISC);
    const int tid = threadIdx.x, lane = tid & 63, wave = tid >> 6;
    constexpr int TU = 4;
    const f32x2* mrp = (const f32x2*)(ws + WS_MR);
    LAS float* G1A = (LAS float*)lds; LAS float* B1A = G1A + DM; LAS float* G2A = B1A + DM; LAS float* B2A = G2A + DM;
    __syncthreads();
    { int tl = threadIdx.x; asm volatile("" : "+v"(tl));
      for (int i = tl; i < DM; i += NTHREADS) { G1A[i] = A.ln1g[i] * ALPHA; B1A[i] = A.ln1b[i] * ALPHA; G2A[i] = A.ln2g[i]; B2A[i] = A.ln2b[i]; } }
    __syncthreads();
    for (int tok0 = (vcu * NWAVES + wave) * TU; tok0 < NTOK; tok0 += G * NWAVES * TU) {
        int4 ev[TU], pv_[TU]; f32x4 wv[TU];
#pragma unroll
        for (int u = 0; u < TU; ++u) { const int tok = tok0 + u; ev[u] = *(const int4*)(tope + tok * 4); pv_[u] = *(const int4*)(spos + tok * 4); wv[u] = *(const f32x4*)(topw + tok * 4); }
        f32x4 v[TU][2][2]; f32x2 mr[TU];
#pragma unroll
        for (int u = 0; u < TU; ++u) { const float* yr = Y + (size_t)(tok0 + u) * DM + lane * 8; mr[u] = mrp[tok0 + u];
#pragma unroll
            for (int j = 0; j < 2; ++j) { v[u][j][0] = *(const f32x4*)(yr + 512 * j); v[u][j][1] = *(const f32x4*)(yr + 512 * j + 4); } }
#pragma unroll
        for (int u = 0; u < TU; ++u)
#pragma unroll
            for (int j = 0; j < 2; ++j)
#pragma unroll
                for (int h = 0; h < 2; ++h) { const int c = lane * 8 + 512 * j + 4 * h; v[u][j][h] = (v[u][j][h] - mr[u].x) * mr[u].y * *(const LAS f32x4*)(G1A + c) + *(const LAS f32x4*)(B1A + c); }
        bool any[TU];
#pragma unroll
        for (int u = 0; u < TU; ++u) { any[u] = false;
            const int es[4] = {ev[u].x, ev[u].y, ev[u].z, ev[u].w}; const int ps[4] = {pv_[u].x, pv_[u].y, pv_[u].z, pv_[u].w};
#pragma unroll
            for (int k = 0; k < 4; ++k) {
                const int tile = tstart[es[k]] + (ps[k] >> 8);
                { any[u] = true; const float w = wv[u][k]; const int rnd = tile >= TR ? 1 : 0; const bf16_t* rp = (rnd ? outr1 : outr0) + ((size_t)(tile - rnd * TR) * 256 + (ps[k] & 255)) * DM + lane * 8;
#pragma unroll
                    for (int j = 0; j < 2; ++j) { const u32x4 q = *(const u32x4*)(rp + 512 * j);
                        v[u][j][0][0] += w * bflo(q.x); v[u][j][0][1] += w * bfhi(q.x); v[u][j][0][2] += w * bflo(q.y); v[u][j][0][3] += w * bfhi(q.y);
                        v[u][j][1][0] += w * bflo(q.z); v[u][j][1][1] += w * bfhi(q.z); v[u][j][1][2] += w * bflo(q.w); v[u][j][1][3] += w * bfhi(q.w); } }
            }
            if (u == 1) asm volatile("" ::: "memory");
        }
#pragma unroll
        for (int u = 0; u < TU; ++u) { float* yr = Y + (size_t)(tok0 + u) * DM + lane * 8;
            if (last) {
                float s = 0.f;
#pragma unroll
                for (int j = 0; j < 2; ++j) s += (v[u][j][0][0] + v[u][j][0][1]) + (v[u][j][0][2] + v[u][j][0][3]) + (v[u][j][1][0] + v[u][j][1][1]) + (v[u][j][1][2] + v[u][j][1][3]);
                const float mean = wave_sum(s) * (1.f / DM); float s2 = 0.f;
#pragma unroll
                for (int j = 0; j < 2; ++j) { v[u][j][0] = v[u][j][0] - mean; v[u][j][1] = v[u][j][1] - mean;
                    s2 += (v[u][j][0][0] * v[u][j][0][0] + v[u][j][0][1] * v[u][j][0][1]) + (v[u][j][0][2] * v[u][j][0][2] + v[u][j][0][3] * v[u][j][0][3]) + (v[u][j][1][0] * v[u][j][1][0] + v[u][j][1][1] * v[u][j][1][1]) + (v[u][j][1][2] * v[u][j][1][2] + v[u][j][1][3] * v[u][j][1][3]); }
                const float rstd = 1.f / sqrtf(wave_sum(s2) * (1.f / DM) + LN_EPS);
#pragma unroll
                for (int j = 0; j < 2; ++j) { const int c = lane * 8 + 512 * j;
                    *(f32x4*)(yr + 512 * j) = (v[u][j][0] * rstd * *(const LAS f32x4*)(G2A + c) + *(const LAS f32x4*)(B2A + c)) * oscale;
                    *(f32x4*)(yr + 512 * j + 4) = (v[u][j][1] * rstd * *(const LAS f32x4*)(G2A + c + 4) + *(const LAS f32x4*)(B2A + c + 4)) * oscale; }
            } else if (any[u]) {
#pragma unroll
                for (int j = 0; j < 2; ++j) { *(f32x4*)(yr + 512 * j) = v[u][j][0]; *(f32x4*)(yr + 512 * j + 4) = v[u][j][1]; }
            }
        }
    }
}
#ifndef REP_ROUTER
#define REP_ROUTER 1
#endif
#ifndef REP_PREP
#define REP_PREP 1
#endif
#ifndef REP_INPROJ
#define REP_INPROJ 1
#endif
#ifndef REP_MERGE
#define REP_MERGE 1
#endif
#ifndef REP_OUT
#define REP_OUT 1
#endif
#ifndef REP_GU
#define REP_GU 1
#endif
#ifndef REP_DN
#define REP_DN 1
#endif
#ifndef REP_ATT1
#define REP_ATT1 1
#endif
#ifndef REP_ATT2
#define REP_ATT2 1
#endif
enum { PH_PREP = 0, PH_INPROJ, PH_ATT1, PH_ATT2, PH_MERGE, PH_OUT, PH_ROUTER, PH_GU0, PH_DN0, PH_GU1, PH_DN1, PH_FIN, PH_N };
__global__ void __launch_bounds__(NTHREADS, 2) k_mega(MegaArgs A) {
    extern __shared__ __attribute__((aligned(16))) unsigned char lds_[];
    LAS unsigned char* lds = (LAS unsigned char*)lds_;
    cg::grid_group grid = cg::this_grid();
    if (threadIdx.x < 8) ((LAS unsigned*)(lds + LDS_BYTES - 64))[threadIdx.x] = 0u;
    __syncthreads();
    XcdBarrier bar = xcd_barrier_post((unsigned*)(A.ws + WS_CTL) + CT_BAR, (volatile LAS unsigned*)(lds + LDS_BYTES - 64));
    const int G = gridDim.x, bx = blockIdx.x; const int vcu = (G % 8 == 0) ? (bx % 8) * (G / 8) + bx / 8 : bx;
    unsigned char* ws = A.ws;
    int* ctl = (int*)(ws + WS_CTL); float* ropeT = (float*)(ws + WS_ROPE);
    bf16_t* wt_gu = (bf16_t*)(ws + WS_WGU); bf16_t* wt_dn = (bf16_t*)(ws + WS_WDN); bf16_t* wt_in = (bf16_t*)(ws + WS_WIN);
    bf16_t* wt_sb = (bf16_t*)(ws + WS_WSB); bf16_t* wt_nsa = (bf16_t*)(ws + WS_WNSA); bf16_t* wt_out = (bf16_t*)(ws + WS_WOUT);
    bf16_t* xb = (bf16_t*)(ws + WS_XB); bf16_t* sbq = (bf16_t*)(ws + WS_SBQ); bf16_t* sbk = (bf16_t*)(ws + WS_SBK); bf16_t* sbv = (bf16_t*)(ws + WS_SBV);
    bf16_t* nq = (bf16_t*)(ws + WS_NQ); bf16_t* kv6 = (bf16_t*)(ws + WS_KV6); float* ng = (float*)(ws + WS_NG);
    bf16_t* ysb = (bf16_t*)(ws + WS_YSB); bf16_t* ynsa = (bf16_t*)(ws + WS_YNSA);
    bf16_t* mg = (bf16_t*)A.out; bf16_t* merged = (bf16_t*)(ws + WS_MERGED); float* u = A.out; bf16_t* h1b = (bf16_t*)(ws + WS_H1B);
    int* list = (int*)(ws + WS_LIST); bf16_t* hid = (bf16_t*)(ws + WS_HID); bf16_t* outr0 = (bf16_t*)(ws + WS_OUTR0); bf16_t* outr1 = (bf16_t*)(ws + WS_OUTR1);
    const int lo = A.ph_lo, hi = A.ph_hi;
#define IN(k) (lo <= (k) && (k) < hi)
#ifdef PROBE_PHASE
#define STAMP(i) do { if (blockIdx.x == 0 && threadIdx.x == 0) ((unsigned long long*)(ctl + 2048))[i] = __builtin_amdgcn_s_memrealtime(); } while (0)
#else
#define STAMP(i) do { } while (0)
#endif
#define SEAM(k) do { if (IN(k) && IN((k) + 1)) { if ((k) == PH_PREP) grid.sync(); else xcd_barrier(bar); } STAMP((k) + 1); } while (0)
    STAMP(0);
    if (IN(PH_PREP)) {
        PrepArgs a{A.x, A.w_in, A.w_sb, A.w_nsa, A.w_out, A.w_gu, A.w_dn, wt_in, wt_sb, wt_nsa, wt_out, wt_gu, wt_dn, xb, ng, ropeT, A.pe_k, A.w1_k, A.w2_k, A.pe_v, A.w1_v, A.w2_v, ws + WS_CMPW, (float*)(ctl + CT_C1)};
        for (int rep = 0; rep < REP_PREP; ++rep) { if (rep) grid.sync(); prep_phase(a, lds, vcu, G); }
    }
    SEAM(PH_PREP);
    if (IN(PH_INPROJ)) {
        EpiInProj E{sbq, sbk, sbv, nq, kv6, mg, ropeT, ropeT + SEQ * 32};
        pg8::Gemm g{xb, wt_in, DM, 0}; pg8::StaticOrder S; S.init(NTOK, 4864, G, bx);
        for (int rep = 0; rep < REP_INPROJ; ++rep) { if (rep) grid.sync(); pg8::gemm_phase<EpiInProj, pg8::StaticOrder, true, false>(lds, g, S, E); }
    }
    SEAM(PH_INPROJ);
    const AttnArgs AA{sbq, sbk, sbv, nq, kv6, ng, (bf16_t*)(ws + WS_KCMP), (bf16_t*)(ws + WS_VCMP), ysb, ynsa, (float*)(ws + WS_YPART),
                      (const bf16_t*)(ws + WS_CMPW + CW_WT1K), (const bf16_t*)(ws + WS_CMPW + CW_WT1V), (const bf16_t*)(ws + WS_CMPW + CW_W2TK), (const bf16_t*)(ws + WS_CMPW + CW_W2TV),
                      (const float*)(ctl + CT_C1), (const float*)(ctl + CT_C1 + 64), ctl + CT_Q};
    if (IN(PH_ATT1)) for (int rep = 0; rep < REP_ATT1; ++rep) { if (rep) grid.sync(); AttnArgs A1 = AA; A1.qhead = ctl + CT_Q + 256 * rep; attn_phase1(A1, lds); }
    STAMP(PH_ATT1 + 1);
    if (IN(PH_ATT2)) for (int rep = 0; rep < REP_ATT2; ++rep) { if (rep) grid.sync(); AttnArgs A2 = AA; A2.qhead = ctl + CT_Q + 256 * rep; attn_phase2(A2, lds, (int)bar.x & 7); }
    SEAM(PH_ATT2);
    if (IN(PH_MERGE)) for (int rep = 0; rep < REP_MERGE; ++rep) {
        if (rep) grid.sync();
        pg8::StaticOrder S; S.init(NTOK, DM, G, bx);
        { pg8::Gemm g{ysb, wt_sb, 512, 0}; EpiMerge E0{mg, merged, 0, 0}; pg8::gemm_phase<EpiMerge, pg8::StaticOrder, true, false>(lds, g, S, E0); }
        asm volatile("s_waitcnt vmcnt(0)" ::: "memory"); __syncthreads();
        { pg8::Gemm g{ynsa, wt_nsa, 512, 0}; EpiMerge E1{mg, merged, 1, 0}; pg8::gemm_phase<EpiMerge, pg8::StaticOrder, true, false>(lds, g, S, E1); }
    }
    SEAM(PH_MERGE);
    if (IN(PH_OUT)) {
        EpiOut E{A.x, u, (f32x2*)(ws + WS_STATS)}; pg8::Gemm g{merged, wt_out, DM, 0}; pg8::StaticOrder S; S.init(NTOK, DM, G, bx);
        for (int rep = 0; rep < REP_OUT; ++rep) { if (rep) grid.sync(); pg8::gemm_phase<EpiOut, pg8::StaticOrder, true, false>(lds, g, S, E); }
    }
    SEAM(PH_OUT);
    if (IN(PH_ROUTER)) for (int rep = 0; rep < REP_ROUTER; ++rep) { if (rep) grid.sync(); router_phase(u, (const f32x2*)(ws + WS_STATS), A.ln1g, A.ln1b, A.w_r, A.b_r, (f32x2*)(ws + WS_MR), h1b, ctl + (rep == REP_ROUTER - 1 ? CT_CNT : 32), list, (float*)(ws + WS_TOPW), (int*)(ws + WS_TOPE), (int*)(ws + WS_SPOS), lds, vcu, G); }
    SEAM(PH_ROUTER);
    if (hi > PH_GU0) { __syncthreads(); moe_build_table(lds, ctl + CT_CNT); }
    if (IN(PH_GU0)) { EpiGateUp E{A.b_gu, hid}; pg8::Gemm g{h1b, wt_gu, DM, 0}; MoeOrder<8> S; S.init(lds, list, 0, G, bx); for (int rep = 0; rep < REP_GU; ++rep) { if (rep) grid.sync(); pg8::gemm_phase<EpiGateUp, MoeOrder<8>, true, true>(lds, g, S, E); } }
    SEAM(PH_GU0);
    if (IN(PH_DN0)) { EpiDown E{A.b_dn, outr0}; pg8::Gemm g{hid, wt_dn, DFF, 0}; MoeOrder<4> S; S.init(lds, list, 0, G, bx); for (int rep = 0; rep < REP_DN; ++rep) { if (rep) grid.sync(); pg8::gemm_phase<EpiDown, MoeOrder<4>, true, false>(lds, g, S, E); } }
    SEAM(PH_DN0);
    if (IN(PH_GU1)) {
        { EpiGateUp E{A.b_gu, hid}; pg8::Gemm g{h1b, wt_gu, DM, 0}; MoeOrder<8> S; S.init(lds, list, 1, G, bx); for (int rep = 0; rep < 1; ++rep) { if (rep) grid.sync(); pg8::gemm_phase<EpiGateUp, MoeOrder<8>, true, true>(lds, g, S, E); } }
    }
    SEAM(PH_GU1);
    if (IN(PH_DN1)) { EpiDown E{A.b_dn, outr1}; pg8::Gemm g{hid, wt_dn, DFF, 0}; MoeOrder<4> S; S.init(lds, list, 1, G, bx); for (int rep = 0; rep < 1; ++rep) { if (rep) grid.sync(); pg8::gemm_phase<EpiDown, MoeOrder<4>, true, false>(lds, g, S, E); } }
    SEAM(PH_DN1);
#ifdef PROBE_PHASE
    if (IN(PH_FIN)) combine_phase(A, lds, 1, true, vcu, G, 1.f);
    xcd_barrier(bar); STAMP(12);
    xcd_barrier(bar);
    { const unsigned long long* ts = (const unsigned long long*)(ctl + 2048); const float dt = (float)(__hip_atomic_load(ts + PROBE_END, __ATOMIC_RELAXED, __HIP_MEMORY_SCOPE_AGENT) - __hip_atomic_load(ts + PROBE_PHASE, __ATOMIC_RELAXED, __HIP_MEMORY_SCOPE_AGENT));
      const float dtq = floorf(dt / PROBE_QUANT + PROBE_QOFF) * PROBE_QUANT; const float sc = 1.f + sqrtf(dtq * PROBE_K);
      for (size_t i = (size_t)bx * NTHREADS + threadIdx.x; i < (size_t)NTOK * DM / 4; i += (size_t)G * NTHREADS) { f32x4 v = ((f32x4*)A.out)[i]; ((f32x4*)A.out)[i] = v * sc; } }
#else
    if (IN(PH_FIN)) combine_phase(A, lds, 1, true, vcu, G, 1.f);
#endif
#undef IN
#undef SEAM
}

extern "C" void kernel_launch(void* const* d_in, const int* in_sizes, int n_in, void* d_out, int out_size, void* d_ws, size_t ws_size, hipStream_t stream) {
    const float* x = (const float*)d_in[0]; const float* w_in = (const float*)d_in[1];
    const float* pe_k = (const float*)d_in[2]; const float* w1_k = (const float*)d_in[3]; const float* w2_k = (const float*)d_in[4];
    const float* pe_v = (const float*)d_in[5]; const float* w1_v = (const float*)d_in[6]; const float* w2_v = (const float*)d_in[7];
    char* ws = (char*)d_ws; float* out = (float*)d_out;
    static int grid = 0;
    if (grid == 0) {
        int dev = 0, cus = 0, per_cu = 0; (void)hipGetDevice(&dev); (void)hipDeviceGetAttribute(&cus, hipDeviceAttributeMultiprocessorCount, dev);
        (void)hipFuncSetAttribute((const void*)k_mega, hipFuncAttributeMaxDynamicSharedMemorySize, LDS_BYTES);
        (void)hipOccupancyMaxActiveBlocksPerMultiprocessor(&per_cu, (const void*)k_mega, NTHREADS, LDS_BYTES);
        if (per_cu < 1) per_cu = 1;
        grid = (cus > 0 ? cus : 256) * 1;
        (void)hipGetLastError();
    }
    MegaArgs A{};
    A.pe_k = pe_k; A.w1_k = w1_k; A.w2_k = w2_k; A.pe_v = pe_v; A.w1_v = w1_v; A.w2_v = w2_v;
    A.x = x; A.w_in = w_in; A.w_sb = (const float*)d_in[8]; A.w_nsa = (const float*)d_in[9]; A.w_out = (const float*)d_in[10];
    A.ln1g = (const float*)d_in[11]; A.ln1b = (const float*)d_in[12]; A.w_r = (const float*)d_in[13]; A.b_r = (const float*)d_in[14];
    A.w_gu = (const float*)d_in[15]; A.b_gu = (const float*)d_in[16]; A.w_dn = (const float*)d_in[17]; A.b_dn = (const float*)d_in[18];
    A.ln2g = (const float*)d_in[19]; A.ln2b = (const float*)d_in[20]; A.out = out; A.ws = (unsigned char*)d_ws;
    int* ctl = (int*)(ws + WS_CTL);
    bf16_t* sbq = (bf16_t*)(ws + WS_SBQ); bf16_t* sbk = (bf16_t*)(ws + WS_SBK); bf16_t* sbv = (bf16_t*)(ws + WS_SBV);
    bf16_t* nq = (bf16_t*)(ws + WS_NQ); bf16_t* kv6 = (bf16_t*)(ws + WS_KV6); float* ng = (float*)(ws + WS_NG);
    bf16_t* kcmp = (bf16_t*)(ws + WS_KCMP); bf16_t* vcmp = (bf16_t*)(ws + WS_VCMP);
    bf16_t* ysb = (bf16_t*)(ws + WS_YSB); bf16_t* ynsa = (bf16_t*)(ws + WS_YNSA);
    float* u = (float*)(ws + WS_U); bf16_t* h1b = (bf16_t*)(ws + WS_H1B);
    int* tope = (int*)(ws + WS_TOPE); float* topw = (float*)(ws + WS_TOPW); int* spos = (int*)(ws + WS_SPOS); int* list = (int*)(ws + WS_LIST);
    const size_t S128 = (size_t)NTOK * 128;
    auto launch = [&](int lo, int hi) { A.ph_lo = lo; A.ph_hi = hi; void* args[] = {&A};
        (void)hipLaunchCooperativeKernel((const void*)k_mega, dim3(grid), dim3(NTHREADS), args, LDS_BYTES, stream); };
    (void)hipMemsetAsync(ctl, 0, 1 * MiB, stream);
    launch(PH_PREP, PH_N);
}
```

```cpp
#include <hip/hip_runtime.h>
#include <stdint.h>
#include <math.h>
constexpr int NB = 8, SEQ = 8192, DM = 1024, NTOK = NB * SEQ;
constexpr int IN_W = 4888;
constexpr int C_NG = 2816, C_MG = 2840;
constexpr int NEXP = 32, TOPK = 4, DFF = 1024;
constexpr int NCMP = 511;
constexpr float ALPHA = 1.189207115002721f;
constexpr float LN_EPS = 1e-5f;
constexpr float LOG2E = 1.4426950408889634f;
constexpr float C2 = 0.125f * LOG2E;
constexpr int NTILE_MAX = NTOK * TOPK / 256 + NEXP;
constexpr int NROUND = 2, TR = 512, TR1MAX = NTILE_MAX - TR;
constexpr int NWAVES = 8, NTHREADS = 512;

typedef float f32x16 __attribute__((ext_vector_type(16)));
typedef float f32x4 __attribute__((ext_vector_type(4)));
typedef float f32x2 __attribute__((ext_vector_type(2)));
typedef unsigned u32x4 __attribute__((ext_vector_type(4)));
typedef unsigned u32x2 __attribute__((ext_vector_type(2)));
typedef unsigned short bf16_t;
#define LAS __attribute__((address_space(3)))

__device__ __forceinline__ unsigned f2bf(float f) { unsigned u = __builtin_bit_cast(unsigned, f); return (u + 0x7fffu + ((u >> 16) & 1u)) >> 16; }
__device__ __forceinline__ unsigned pk2(float lo, float hi) { return f2bf(lo) | (f2bf(hi) << 16); }
__device__ __forceinline__ float bf2f(unsigned h) { return __builtin_bit_cast(float, h << 16); }
__device__ __forceinline__ float bflo(unsigned w) { return __builtin_bit_cast(float, w << 16); }
__device__ __forceinline__ float bfhi(unsigned w) { return __builtin_bit_cast(float, w & 0xffff0000u); }
__device__ __forceinline__ float sigmoidf_(float x) { return __builtin_amdgcn_rcpf(1.f + __expf(-x)); }
__device__ __forceinline__ float wave_sum(float v) {
#pragma unroll
    for (int o = 1; o < 64; o <<= 1) v += __shfl_xor(v, o);
    return v;
}

constexpr size_t MiB = 1u << 20;
constexpr size_t WS_CTL = 0;
constexpr size_t WS_ROPE = 1 * MiB;
constexpr size_t WS_WGU = 3 * MiB;
constexpr size_t WS_WDN = 131 * MiB;
constexpr size_t WS_WIN = 195 * MiB;
constexpr size_t WS_WSB = 205 * MiB;
constexpr size_t WS_WNSA = 206 * MiB;
constexpr size_t WS_WOUT = 207 * MiB;
constexpr size_t WS_CMPW = 209 * MiB;
constexpr size_t WS_XB = 210 * MiB;
constexpr size_t WS_SBQ = 338 * MiB, WS_SBK = 402 * MiB, WS_SBV = 466 * MiB, WS_NQ = 530 * MiB;
constexpr size_t WS_KV6 = 594 * MiB;
constexpr size_t WS_NG = 690 * MiB;
constexpr size_t WS_KCMP = 696 * MiB, WS_VCMP = 697 * MiB;
constexpr size_t WS_MASK = 698 * MiB;
constexpr size_t WS_YSB = 700 * MiB, WS_YNSA = 764 * MiB;
constexpr size_t WS_YPART = 828 * MiB;
constexpr size_t WS_MERGED = 210 * MiB;
constexpr size_t WS_U = 338 * MiB;
constexpr size_t WS_STATS = 1014 * MiB;
constexpr size_t WS_H1B = 594 * MiB;
constexpr size_t WS_TOPE = 1010 * MiB, WS_TOPW = 1011 * MiB, WS_SPOS = 1012 * MiB;
constexpr size_t WS_MR = 1013 * MiB;
constexpr size_t WS_LIST = 722 * MiB;
constexpr size_t WS_HID = 210 * MiB;
constexpr size_t WS_OUTR0 = 754 * MiB;
constexpr size_t WS_OUTR1 = 482 * MiB;
constexpr int CT_CNT = 0;
constexpr int CT_Q = 64;
constexpr int CT_C1 = 3072;
constexpr int CT_BAR = 4096;
namespace pg8 {
#define PG8_LAS __attribute__((address_space(3)))
typedef unsigned short bf16_t;
typedef short bf16x8 __attribute__((ext_vector_type(8)));
typedef float f32x4 __attribute__((ext_vector_type(4)));
typedef unsigned u32x4 __attribute__((ext_vector_type(4)));
constexpr int BM = 256, BK = 64, HALF = 128, HTB = HALF * BK * 2, STAGE_BYTES = 8 * HTB, NXCD = 8, WGM = 8;
__host__ __device__ __forceinline__ int lds_byte(int r, int c) { const int st = (r >> 4) * 2 + (c >> 5), rr = r & 15, cc = c & 31, ob = rr * 64 + cc * 2; return st * 1024 + (ob ^ (((ob >> 9) & 1) << 5)); }
__host__ __device__ __forceinline__ void stage_rc(int b, int& R, int& C) { const int st = b / 1024, sb = b % 1024, swz = sb ^ (((sb >> 9) & 1) << 5); R = (st >> 1) * 16 + swz / 64; C = (st & 1) * 32 + (swz % 64) / 2; }
__host__ __device__ __forceinline__ int perm32(int rho) { const int n = rho >> 4, i = rho & 15; return 8 * (i >> 2) + 4 * n + (i & 3); }
struct Unit { int pm, pn, e, r0; };
struct Gemm { const bf16_t* A; const bf16_t* Bt; int K; int pad; };
struct StaticOrder {
    int nM, nN, nwg, G, c;
    __host__ __device__ void init(int M, int N, int G_, int c_) { nM = M / BM; nN = N / BM; nwg = nM * nN; G = G_; c = c_; }
    __host__ __device__ bool next(int i, Unit& u) const {
        const long L = (long)i * G + c; if (L >= nwg) return false;
        int wgid = (int)L; { const int q = nwg / NXCD, r = nwg % NXCD, xcd = wgid % NXCD, off = wgid / NXCD; wgid = (xcd < r ? xcd * (q + 1) : r * (q + 1) + (xcd - r) * q) + off; }
        const int nig = WGM * nN, gid = wgid / nig, fm = gid * WGM, gsz = (nM - fm) < WGM ? (nM - fm) : WGM;
        u.pm = fm + ((wgid % nig) % gsz); u.pn = (wgid % nig) / gsz; u.e = 0; u.r0 = 0; return true;
    }
    __device__ __forceinline__ unsigned row_off(const Unit&, int) const { return 0u; }
    __device__ __forceinline__ void row_off4(const Unit&, int, int, unsigned (&ro)[2][2]) const { ro[0][0] = ro[0][1] = ro[1][0] = ro[1][1] = 0u; }
};
__device__ __forceinline__ unsigned cvt_pk_bf16(float lo, float hi) { typedef float f2_ __attribute__((ext_vector_type(2))); typedef __bf16 bf2_ __attribute__((ext_vector_type(2)));
    return __builtin_bit_cast(unsigned, __builtin_convertvector((f2_){lo, hi}, bf2_)); }

template <class Epi, class Sched, bool ALIGN_EPI, bool GATHER>
__device__ __forceinline__ void gemm_phase(PG8_LAS unsigned char* lds, const Gemm g, const Sched& S, const Epi& E) {
    const int tid = threadIdx.x, wid = __builtin_amdgcn_readfirstlane(tid >> 6), lane = tid & 63, wr = wid >> 2, wc = wid & 3, fr = lane & 15, fq = lane >> 4;
    const int K = g.K, nt = K / BK;
    unsigned voffA[2], voffB[2]; int Rrow[2];
#pragma unroll
    for (int i = 0; i < 2; ++i) { int R, C; stage_rc(tid * 16 + i * 8192, R, C); const int Rb = Epi::PERM ? ((R & ~31) + perm32(R & 31)) : R;
        voffA[i] = GATHER ? (unsigned)(C * 2) : (unsigned)(R * K + C) * 2u; voffB[i] = (unsigned)(Rb * K + C) * 2u; Rrow[i] = R; }
    const size_t kstep = (size_t)(BK * 2);
    const size_t hstep = (size_t)HALF * K * 2;
    const size_t hstepA = GATHER ? 0 : hstep;
    const size_t tstep = 2 * hstep;
    const unsigned ldsw = (unsigned)wid * 1024u;
    const int aoff = lds_byte(wr * 64 + fr, fq * 8), boff = lds_byte(wc * 32 + fr, fq * 8);
#define PG8_SA(b, h) (((b) * 2 + (h)) * HTB)
#define PG8_SB(b, h) ((4 + (b) * 2 + (h)) * HTB)
#define PG8_STAGE(bufoff, gbase, voff) do { _Pragma("unroll") for (int _i = 0; _i < 2; ++_i) \
        __builtin_amdgcn_global_load_lds((const unsigned*)((const char*)(gbase) + (voff)[_i]), (PG8_LAS unsigned*)(lds + (bufoff) + ldsw + _i * 8192), 16, 0, 0); } while (0)
#define PG8_STAGE_A(bufoff, gbase, h, nx) do { if constexpr (GATHER) { unsigned _o[2]; _o[0] = ((nx) ? gN[h][0] : gA[h][0]); _o[1] = ((nx) ? gN[h][1] : gA[h][1]); PG8_STAGE(bufoff, gbase, _o); } \
        else { PG8_STAGE(bufoff, (gbase) + (h) * hstepA, voffA); } } while (0)
#define PG8_LDA(dst, b, h) do { _Pragma("unroll") for (int m = 0; m < 4; ++m) _Pragma("unroll") for (int k = 0; k < 2; ++k) dst[m][k] = *(const PG8_LAS bf16x8*)(lds + PG8_SA(b, h) + aoff + m * 2048 + k * 1024); } while (0)
#define PG8_LDB(dst, b, h) do { _Pragma("unroll") for (int n = 0; n < 2; ++n) _Pragma("unroll") for (int k = 0; k < 2; ++k) dst[n][k] = *(const PG8_LAS bf16x8*)(lds + PG8_SB(b, h) + boff + n * 2048 + k * 1024); } while (0)
#define PG8_MMA(ai, bj, At, Bt) do { __builtin_amdgcn_s_setprio(1); _Pragma("unroll") for (int m = 0; m < 4; ++m) _Pragma("unroll") for (int n = 0; n < 2; ++n) _Pragma("unroll") for (int k = 0; k < 2; ++k) \
        acc[ai][bj][m][n] = __builtin_amdgcn_mfma_f32_16x16x32_bf16(Bt[n][k], At[m][k], acc[ai][bj][m][n], 0, 0, 0); __builtin_amdgcn_s_setprio(0); } while (0)
#define PG8_WAIT_V(n) asm volatile("s_waitcnt vmcnt(" #n ")" ::: "memory")
#define PG8_WAIT_L(n) asm volatile("s_waitcnt lgkmcnt(" #n ")" ::: "memory")
#define PG8_BAR __builtin_amdgcn_s_barrier()
#define PG8_SCHED __builtin_amdgcn_sched_barrier(0)
    Unit cur, nxt; int ui = 0;
    if (!S.next(0, cur)) return;
    f32x4 acc[2][2][4][2];
#pragma unroll
    for (int a = 0; a < 2; ++a)
#pragma unroll
        for (int b = 0; b < 2; ++b)
#pragma unroll
            for (int m = 0; m < 4; ++m)
#pragma unroll
                for (int n = 0; n < 2; ++n) acc[a][b][m][n] = (f32x4){0.f, 0.f, 0.f, 0.f};
    bf16x8 At[4][2], B0[2][2], B1[2][2];
    unsigned gA[2][2], gN[2][2];
#pragma unroll
    for (int h = 0; h < 2; ++h)
#pragma unroll
        for (int i = 0; i < 2; ++i) { gA[h][i] = GATHER ? S.row_off(cur, h * HALF + Rrow[i]) + voffA[i] : 0u; gN[h][i] = gA[h][i]; }
    const char* cA = (const char*)g.A + (GATHER ? (size_t)0 : (size_t)cur.pm * tstep); const char* cB = (const char*)g.Bt + (size_t)cur.pn * tstep;
    PG8_STAGE(PG8_SB(0, 0), cB, voffB); PG8_STAGE(PG8_SB(0, 1), cB + hstep, voffB); PG8_STAGE_A(PG8_SA(0, 0), cA, 0, false); PG8_STAGE_A(PG8_SA(0, 1), cA, 1, false);
    if (wr == 1) PG8_BAR;
    PG8_WAIT_V(2); PG8_BAR;
    PG8_STAGE(PG8_SB(1, 0), cB + kstep, voffB); PG8_STAGE_A(PG8_SA(1, 0), cA + kstep, 0, false); PG8_STAGE(PG8_SB(1, 1), cB + hstep + kstep, voffB);
    PG8_WAIT_V(6); PG8_BAR;
    for (;;) {
        const bool has_next = S.next(ui + 1, nxt);
        if constexpr (GATHER) {
            if (has_next) {
                unsigned ro[2][2]; S.row_off4(nxt, Rrow[0], Rrow[1], ro);
#pragma unroll
                for (int h = 0; h < 2; ++h)
#pragma unroll
                    for (int i = 0; i < 2; ++i) gN[h][i] = ro[h][i] + voffA[i];
            } else {
#pragma unroll
                for (int h = 0; h < 2; ++h)
#pragma unroll
                    for (int i = 0; i < 2; ++i) gN[h][i] = gA[h][i];
            }
        }
        const char* nA = (has_next && !GATHER) ? (const char*)g.A + (size_t)nxt.pm * tstep : cA; const char* nB = has_next ? (const char*)g.Bt + (size_t)nxt.pn * tstep : cB;
        for (int t = 0; t < nt; t += 2) {
            const bool last = (t == nt - 2);
            const char* a1 = cA + (size_t)(t + 1) * kstep;
            const char* a2 = last ? nA : cA + (size_t)(t + 2) * kstep; const char* b2 = last ? nB : cB + (size_t)(t + 2) * kstep;
            const char* a3 = a2 + kstep; const char* b3 = b2 + kstep;
            PG8_LDB(B0, 0, 0); PG8_LDB(B1, 0, 1); PG8_SCHED; PG8_LDA(At, 0, 0); PG8_STAGE_A(PG8_SA(1, 1), a1, 1, false);
            PG8_WAIT_V(8); PG8_WAIT_L(0); PG8_BAR; PG8_MMA(0, 0, At, B0); PG8_MMA(0, 1, At, B1); PG8_BAR; PG8_SCHED;
            PG8_LDA(At, 0, 1); PG8_STAGE(PG8_SB(0, 0), b2, voffB); PG8_STAGE(PG8_SB(0, 1), b2 + hstep, voffB); PG8_STAGE_A(PG8_SA(0, 0), a2, 0, last);
            PG8_WAIT_V(8); PG8_WAIT_L(0); PG8_BAR; PG8_MMA(1, 0, At, B0); PG8_MMA(1, 1, At, B1); PG8_BAR; PG8_SCHED;
            PG8_LDB(B0, 1, 0); PG8_LDB(B1, 1, 1); PG8_SCHED; PG8_LDA(At, 1, 0); PG8_STAGE_A(PG8_SA(0, 1), a2, 1, last);
            PG8_WAIT_V(8); PG8_WAIT_L(0); PG8_BAR; PG8_MMA(0, 0, At, B0); PG8_MMA(0, 1, At, B1); PG8_BAR; PG8_SCHED;
            PG8_LDA(At, 1, 1); PG8_STAGE(PG8_SB(1, 0), b3, voffB); PG8_STAGE(PG8_SB(1, 1), b3 + hstep, voffB); PG8_STAGE_A(PG8_SA(1, 0), a3, 0, last);
            PG8_WAIT_V(8); PG8_WAIT_L(0); PG8_BAR; PG8_MMA(1, 0, At, B0); PG8_MMA(1, 1, At, B1); PG8_BAR; PG8_SCHED;
        }
        if constexpr (ALIGN_EPI) { if (wr == 0) PG8_BAR; }
        E(acc, cur, wr, wc, fr, fq);
        if (!has_next) break;
        {
            typedef float f32x2z __attribute__((ext_vector_type(2)));
#pragma unroll
            for (int a = 0; a < 2; ++a)
#pragma unroll
                for (int b = 0; b < 2; ++b)
#pragma unroll
                    for (int m = 0; m < 4; ++m)
#pragma unroll
                        for (int n = 0; n < 2; ++n) { f32x2z lo_, hi_;
                            asm volatile("v_pk_mov_b32 %0, 0, 0 op_sel_hi:[0,0]" : "=v"(lo_));
                            asm volatile("v_pk_mov_b32 %0, 0, 0 op_sel_hi:[0,0]" : "=v"(hi_));
                            acc[a][b][m][n] = (f32x4){lo_.x, lo_.y, hi_.x, hi_.y}; }
        }
        cur = nxt; cA = nA; cB = nB; ++ui;
#pragma unroll
        for (int h = 0; h < 2; ++h)
#pragma unroll
            for (int i = 0; i < 2; ++i) gA[h][i] = gN[h][i];
        if constexpr (ALIGN_EPI) { if (wr == 1) PG8_BAR; }
    }
    PG8_WAIT_V(0);
    if constexpr (!ALIGN_EPI) { if (wr == 0) PG8_BAR; }
    PG8_BAR;
#undef PG8_SA
#undef PG8_SB
#undef PG8_STAGE
#undef PG8_STAGE_A
#undef PG8_LDA
#undef PG8_LDB
#undef PG8_MMA
#undef PG8_WAIT_V
#undef PG8_WAIT_L
#undef PG8_BAR
#undef PG8_SCHED
}
}
using pg8::Unit; using pg8::cvt_pk_bf16;
__device__ __forceinline__ f32x2 sigmoid2(f32x2 x) { const f32x2 tt = x * (-1.4426950408889634f); const f32x2 d = (f32x2){__builtin_amdgcn_exp2f(tt.x), __builtin_amdgcn_exp2f(tt.y)} + 1.f;
    return (f32x2){__builtin_amdgcn_rcpf(d.x), __builtin_amdgcn_rcpf(d.y)}; }
struct EpiInProj {
    static constexpr bool PERM = true;
    bf16_t* sbq; bf16_t* sbk; bf16_t* sbv; bf16_t* nq; bf16_t* kv6; bf16_t* mg; const float* cosT; const float* sinT;
    __device__ __forceinline__ void operator()(const f32x4 (&acc)[2][2][4][2], const Unit& u, int wr, int wc, int fr, int fq) const {
        const int pn = u.pn; const int row0 = u.pm * 256 + wr * 64 + fr; const int x0 = wc * 32 + 8 * fq;
        if (pn < 6 || pn >= 11) {
            bf16_t* base; int ld, col; float sc = 1.f; const bool sig = pn >= 11;
            if (pn < 2) { base = sbq; ld = 512; col = pn * 256; sc = C2; } else if (pn < 4) { base = sbk; ld = 512; col = (pn - 2) * 256; }
            else if (pn < 6) { base = sbv; ld = 512; col = (pn - 4) * 256; } else { base = mg; ld = 2048; col = (pn - 11) * 256; }
#pragma unroll
            for (int ai = 0; ai < 2; ++ai)
#pragma unroll
                for (int m = 0; m < 4; ++m) { bf16_t* rp = base + (size_t)(row0 + ai * 128 + m * 16) * ld + col + x0;
#pragma unroll
                    for (int bj = 0; bj < 2; ++bj) { f32x4 v0 = acc[ai][bj][m][0] * sc, v1 = acc[ai][bj][m][1] * sc;
                        if (sig) {
                            const f32x2 a = sigmoid2((f32x2){v0[0], v0[1]}), b = sigmoid2((f32x2){v0[2], v0[3]}), c = sigmoid2((f32x2){v1[0], v1[1]}), d = sigmoid2((f32x2){v1[2], v1[3]});
                            v0 = (f32x4){a.x, a.y, b.x, b.y}; v1 = (f32x4){c.x, c.y, d.x, d.y}; }
                        u32x4 w; w.x = cvt_pk_bf16(v0[0], v0[1]); w.y = cvt_pk_bf16(v0[2], v0[3]); w.z = cvt_pk_bf16(v1[0], v1[1]); w.w = cvt_pk_bf16(v1[2], v1[3]);
                        *(u32x4*)(rp + bj * 128) = w; } }
        } else {
            const bool rope = (pn < 8) || (wc < 2);
            bf16_t* base; int ld, c0, c1; float sc = 1.f;
            if (pn < 8) { base = nq; ld = 512; c0 = ((pn - 6) * 4 + wc) * 64 + 8 * fq; c1 = c0 + 32; sc = C2; }
            else { const int t = pn - 8; ld = 128;
                if (wc < 2) { base = kv6 + (size_t)(2 * t) * NTOK * 128; c0 = wc * 64 + 8 * fq; c1 = c0 + 32; }
                else { base = kv6 + (size_t)(2 * t + 1) * NTOK * 128; c0 = (wc - 2) * 32 + 8 * fq; c1 = 64 + c0; } }
#pragma unroll
            for (int am = 0; am < 4; ++am) { const int ai = am >> 1, mb = (am & 1) * 2;
                f32x4 cA[2], cB[2], sA[2], sB[2];
                if (rope) {
#pragma unroll
                    for (int mm = 0; mm < 2; ++mm) { const int pos = (row0 + ai * 128 + (mb + mm) * 16) & (SEQ - 1);
                        cA[mm] = *(const f32x4*)(cosT + pos * 32 + 8 * fq); cB[mm] = *(const f32x4*)(cosT + pos * 32 + 8 * fq + 4);
                        sA[mm] = *(const f32x4*)(sinT + pos * 32 + 8 * fq); sB[mm] = *(const f32x4*)(sinT + pos * 32 + 8 * fq + 4); }
                    asm volatile("" ::: "memory");
                }
#pragma unroll
                for (int mm = 0; mm < 2; ++mm) { const int m = mb + mm; const int row = row0 + ai * 128 + m * 16; bf16_t* rp = base + (size_t)row * ld;
                    f32x4 a0 = acc[ai][0][m][0], a1 = acc[ai][0][m][1], b0 = acc[ai][1][m][0], b1 = acc[ai][1][m][1];
                    if (rope) {
                        const f32x4 r0 = a0 * cA[mm] - b0 * sA[mm], r1 = a1 * cB[mm] - b1 * sB[mm], r2 = b0 * cA[mm] + a0 * sA[mm], r3 = b1 * cB[mm] + a1 * sB[mm];
                        a0 = r0 * sc; a1 = r1 * sc; b0 = r2 * sc; b1 = r3 * sc; }
                    u32x4 w; w.x = cvt_pk_bf16(a0[0], a0[1]); w.y = cvt_pk_bf16(a0[2], a0[3]); w.z = cvt_pk_bf16(a1[0], a1[1]); w.w = cvt_pk_bf16(a1[2], a1[3]);
                    *(u32x4*)(rp + c0) = w;
                    w.x = cvt_pk_bf16(b0[0], b0[1]); w.y = cvt_pk_bf16(b0[2], b0[3]); w.z = cvt_pk_bf16(b1[0], b1[1]); w.w = cvt_pk_bf16(b1[2], b1[3]);
                    *(u32x4*)(rp + c1) = w; }
            }
        }
    }
};
struct EpiMerge {
    static constexpr bool PERM = true;
    const bf16_t* mg; bf16_t* merged; int pass; int pad;
    __device__ __forceinline__ void operator()(const f32x4 (&acc)[2][2][4][2], const Unit& u, int wr, int wc, int fr, int fq) const {
        const int row0 = u.pm * 256 + wr * 64 + fr; const int col0 = u.pn * 256 + wc * 32 + 8 * fq;
#pragma unroll
        for (int ai = 0; ai < 2; ++ai) {
            u32x4 gv[4][2], pv_[4][2];
#pragma unroll
            for (int m = 0; m < 4; ++m) { const size_t row = (size_t)(row0 + ai * 128 + m * 16);
#pragma unroll
                for (int bj = 0; bj < 2; ++bj) { gv[m][bj] = *(const u32x4*)(mg + row * 2048 + pass * 1024 + col0 + bj * 128);
                    if (pass) pv_[m][bj] = *(const u32x4*)(merged + row * DM + col0 + bj * 128); } }
            asm volatile("" ::: "memory");
#pragma unroll
            for (int m = 0; m < 4; ++m) { const size_t row = (size_t)(row0 + ai * 128 + m * 16);
#pragma unroll
                for (int bj = 0; bj < 2; ++bj) { const u32x4 g = gv[m][bj];
                    f32x4 v0 = acc[ai][bj][m][0], v1 = acc[ai][bj][m][1];
                    v0[0] *= bflo(g.x); v0[1] *= bfhi(g.x); v0[2] *= bflo(g.y); v0[3] *= bfhi(g.y); v1[0] *= bflo(g.z); v1[1] *= bfhi(g.z); v1[2] *= bflo(g.w); v1[3] *= bfhi(g.w);
                    if (pass) { const u32x4 p = pv_[m][bj]; v0[0] += bflo(p.x); v0[1] += bfhi(p.x); v0[2] += bflo(p.y); v0[3] += bfhi(p.y); v1[0] += bflo(p.z); v1[1] += bfhi(p.z); v1[2] += bflo(p.w); v1[3] += bfhi(p.w); }
                    u32x4 w; w.x = cvt_pk_bf16(v0[0], v0[1]); w.y = cvt_pk_bf16(v0[2], v0[3]); w.z = cvt_pk_bf16(v1[0], v1[1]); w.w = cvt_pk_bf16(v1[2], v1[3]);
                    *(u32x4*)(merged + row * DM + col0 + bj * 128) = w; } }
        }
    }
};
struct EpiOut {
    static constexpr bool PERM = false;
    const float* x; float* u; f32x2* stats;
    __device__ __forceinline__ void operator()(const f32x4 (&acc)[2][2][4][2], const Unit& un, int wr, int wc, int fr, int fq) const {
        const int row0 = un.pm * 256 + wr * 64 + fr; const int col0 = un.pn * 256 + wc * 32 + 4 * fq;
#pragma unroll
        for (int ai = 0; ai < 2; ++ai) {
            f32x4 xv[4][2][2];
#pragma unroll
            for (int m = 0; m < 4; ++m) { const size_t off = (size_t)(row0 + ai * 128 + m * 16) * DM + col0;
#pragma unroll
                for (int bj = 0; bj < 2; ++bj)
#pragma unroll
                    for (int n = 0; n < 2; ++n) xv[m][bj][n] = *(const f32x4*)(x + off + bj * 128 + n * 16); }
            asm volatile("" ::: "memory");
#pragma unroll
            for (int m = 0; m < 4; ++m) { const int row = row0 + ai * 128 + m * 16; const size_t off = (size_t)row * DM + col0; float s = 0.f, s2 = 0.f;
#pragma unroll
                for (int bj = 0; bj < 2; ++bj)
#pragma unroll
                    for (int n = 0; n < 2; ++n) { const f32x4 v = xv[m][bj][n] * ALPHA + acc[ai][bj][m][n]; *(f32x4*)(u + off + bj * 128 + n * 16) = v;
                        s += (v[0] + v[1]) + (v[2] + v[3]); s2 += (v[0] * v[0] + v[1] * v[1]) + (v[2] * v[2] + v[3] * v[3]); }
                s += __shfl_xor(s, 16); s += __shfl_xor(s, 32); s2 += __shfl_xor(s2, 16); s2 += __shfl_xor(s2, 32);
                if (fq == 0) stats[(size_t)row * 16 + un.pn * 4 + wc] = (f32x2){s, s2}; }
        }
    }
};
__device__ __forceinline__ f32x2 swiglu2(f32x2 ga, f32x2 ua) {
    const f32x2 g = {fminf(ga.x, 7.f), fminf(ga.y, 7.f)};
    const f32x2 uu = {fminf(fmaxf(ua.x, -7.f), 7.f), fminf(fmaxf(ua.y, -7.f), 7.f)};
    const f32x2 tt = g * (-1.702f * 1.4426950408889634f);
    const f32x2 d = (f32x2){__builtin_amdgcn_exp2f(tt.x), __builtin_amdgcn_exp2f(tt.y)} + 1.f;
    const f32x2 h = g * (f32x2){__builtin_amdgcn_rcpf(d.x), __builtin_amdgcn_rcpf(d.y)};
    return h * uu + h;
}
struct EpiGateUp {
    static constexpr bool PERM = true;
    const float* bgu; bf16_t* hid;
    __device__ __forceinline__ void operator()(const f32x4 (&acc)[2][2][4][2], const Unit& u, int wr, int wc, int fr, int fq) const {
        const int e = u.e, pnl = u.pn - e * 8; const int f0 = pnl * 128 + wc * 32 + 8 * fq;
        const float* bp = bgu + e * 2048 + f0;
        const f32x4 bg0 = *(const f32x4*)bp, bg1 = *(const f32x4*)(bp + 4), bu0 = *(const f32x4*)(bp + 1024), bu1 = *(const f32x4*)(bp + 1028);
        const int row0 = u.pm * 256 + wr * 64 + fr;
#pragma unroll
        for (int ai = 0; ai < 2; ++ai)
#pragma unroll
            for (int m = 0; m < 4; ++m) {
                const f32x4 g0 = acc[ai][0][m][0] + bg0, g1 = acc[ai][0][m][1] + bg1, u0 = acc[ai][1][m][0] + bu0, u1 = acc[ai][1][m][1] + bu1;
                const f32x2 ha = swiglu2((f32x2){g0[0], g0[1]}, (f32x2){u0[0], u0[1]}), hb = swiglu2((f32x2){g0[2], g0[3]}, (f32x2){u0[2], u0[3]});
                const f32x2 hc = swiglu2((f32x2){g1[0], g1[1]}, (f32x2){u1[0], u1[1]}), hd = swiglu2((f32x2){g1[2], g1[3]}, (f32x2){u1[2], u1[3]});
                u32x4 w; w.x = cvt_pk_bf16(ha.x, ha.y); w.y = cvt_pk_bf16(hb.x, hb.y); w.z = cvt_pk_bf16(hc.x, hc.y); w.w = cvt_pk_bf16(hd.x, hd.y);
                *(u32x4*)(hid + (size_t)(row0 + ai * 128 + m * 16) * DFF + f0) = w; }
    }
};
struct EpiDown {
    static constexpr bool PERM = true;
    const float* bd; bf16_t* outr;
    __device__ __forceinline__ void operator()(const f32x4 (&acc)[2][2][4][2], const Unit& u, int wr, int wc, int fr, int fq) const {
        const int e = u.e, pnl = u.pn - e * 4; const int col0 = pnl * 256 + wc * 32 + 8 * fq; const int row0 = u.pm * 256 + wr * 64 + fr;
        f32x4 b[2][2];
#pragma unroll
        for (int bj = 0; bj < 2; ++bj) { b[bj][0] = *(const f32x4*)(bd + e * DM + col0 + bj * 128); b[bj][1] = *(const f32x4*)(bd + e * DM + col0 + bj * 128 + 4); }
#pragma unroll
        for (int ai = 0; ai < 2; ++ai)
#pragma unroll
            for (int m = 0; m < 4; ++m) { bf16_t* rp = outr + (size_t)(row0 + ai * 128 + m * 16) * DM + col0;
#pragma unroll
                for (int bj = 0; bj < 2; ++bj) { const f32x4 v0 = acc[ai][bj][m][0] + b[bj][0], v1 = acc[ai][bj][m][1] + b[bj][1];
                    u32x4 w; w.x = cvt_pk_bf16(v0[0], v0[1]); w.y = cvt_pk_bf16(v0[2], v0[3]); w.z = cvt_pk_bf16(v1[0], v1[1]); w.w = cvt_pk_bf16(v1[2], v1[3]);
                    *(u32x4*)(rp + bj * 128) = w; } }
    }
};
constexpr int LDS_RING = 131072, LDS_TAB = LDS_RING, LDS_CNT = LDS_TAB + NTILE_MAX * 4, LDS_NT = LDS_CNT + 128, LDS_MISC = LDS_NT + 64, LDS_BYTES = 160 * 1024;
__device__ __forceinline__ void moe_build_table(LAS unsigned char* lds, const int* gcnt) {
    LAS int* tab = (LAS int*)(lds + LDS_TAB); LAS int* cnts = (LAS int*)(lds + LDS_CNT); LAS int* nt = (LAS int*)(lds + LDS_NT);
    LAS int* tstart = (LAS int*)(lds + LDS_MISC);
    const int tid = threadIdx.x;
    if (tid < 32) cnts[tid] = gcnt[tid];
    __syncthreads();
    if (tid == 0) { int a = 0; for (int e = 0; e < 32; ++e) { tstart[e] = a; a += (cnts[e] + 255) >> 8; } tstart[32] = a; nt[0] = a; }
    __syncthreads();
    const int ntl = nt[0];
    for (int t = tid; t < ntl; t += NTHREADS) { int e = 0; for (int k = 1; k < 32; ++k) if (tstart[k] <= t) e = k; tab[t] = (e << 16) | (t - tstart[e]); }
    __syncthreads();
}
template <int NPN> struct MoeOrder {
    LAS unsigned char* lds; const int* list; int r, G, c, ntr;
    __device__ __forceinline__ void init(LAS unsigned char* lds_, const int* list_, int r_, int G_, int c_) {
        lds = lds_; list = list_; r = r_; G = G_; c = c_; const int ntl = ((LAS int*)(lds + LDS_NT))[0]; int n = ntl - r * TR; ntr = n < 0 ? 0 : ((r < NROUND - 1 && n > TR) ? TR : n); }
    __device__ __forceinline__ bool next(int i, Unit& u) const {
        const int nM = ntr, nN = NPN, nwg = nM * nN; const long L = (long)i * G + c; if (L >= nwg) return false;
        int wgid = (int)L; { const int q = nwg / 8, rr = nwg % 8, xcd = wgid % 8, off = wgid / 8; wgid = (xcd < rr ? xcd * (q + 1) : rr * (q + 1) + (xcd - rr) * q) + off; }
        const int nig = 8 * nN, gid = wgid / nig, fm = gid * 8, gsz = (nM - fm) < 8 ? (nM - fm) : 8;
        const int pm = fm + ((wgid % nig) % gsz), pnl = (wgid % nig) / gsz;
        const int pk = ((LAS int*)(lds + LDS_TAB))[r * TR + pm];
        u.pm = pm; u.e = pk >> 16; u.r0 = (pk & 0xffff) << 8; u.pn = u.e * NPN + pnl; return true;
    }
    __device__ __forceinline__ unsigned row_off(const Unit& u, int rr) const {
        const int pos = u.r0 + rr; const int cnt = ((LAS int*)(lds + LDS_CNT))[u.e];
        const bool ok = pos < cnt; const int v = list[(size_t)u.e * NTOK + (ok ? pos : 0)];
        const int tok = ok ? (v >> 2) : 0;
        return (unsigned)tok * (unsigned)(DM * 2);
    }
    __device__ __forceinline__ void row_off4(const Unit& u, int r0_, int r1_, unsigned (&ro)[2][2]) const {
        const int cnt = ((LAS int*)(lds + LDS_CNT))[u.e]; const int* lp = list + (size_t)u.e * NTOK;
        const int p00 = u.r0 + r0_, p01 = u.r0 + r1_, p10 = p00 + 128, p11 = p01 + 128;
        const int v00 = lp[p00 < cnt ? p00 : 0], v01 = lp[p01 < cnt ? p01 : 0], v10 = lp[p10 < cnt ? p10 : 0], v11 = lp[p11 < cnt ? p11 : 0];
        asm volatile("" ::: "memory");
        ro[0][0] = (p00 < cnt ? (unsigned)(v00 >> 2) : 0u) * (unsigned)(DM * 2); ro[0][1] = (p01 < cnt ? (unsigned)(v01 >> 2) : 0u) * (unsigned)(DM * 2);
        ro[1][0] = (p10 < cnt ? (unsigned)(v10 >> 2) : 0u) * (unsigned)(DM * 2); ro[1][1] = (p11 < cnt ? (unsigned)(v11 >> 2) : 0u) * (unsigned)(DM * 2);
    }
};
__device__ __forceinline__ int win_src_col(int n) {
    const int pn = n >> 8, c = n & 255, bj = c >> 7, x = c & 127;
    if (pn < 6) return n;
    if (pn < 8) return 1536 + ((pn - 6) * 4 + (x >> 5)) * 64 + (x & 31) + 32 * bj;
    if (pn < 11) { const int base = 2048 + (pn - 8) * 256; return x < 64 ? base + (x >> 5) * 64 + (x & 31) + 32 * bj : base + 128 + bj * 64 + (x - 64); }
    return C_MG + (n - 2816);
}
__device__ __forceinline__ int wgu_src_col(int n) { const int pnl = n >> 8, c = n & 255, bj = c >> 7, x = c & 127; return bj * 1024 + 128 * pnl + x; }
__device__ __forceinline__ void transpose_item64(const float* W, int ldw, int K, int srccol0a, int srccol0b, bf16_t* WT, int n0, int k0, LAS float* scr, int lane) {
    const int sc = (lane < 32) ? srccol0a + lane : srccol0b + (lane - 32);
    float tv[32];
#pragma unroll
    for (int h = 0; h < 2; ++h) {
#pragma unroll
        for (int i = 0; i < 32; ++i) tv[i] = W[(size_t)(k0 + 32 * h + i) * ldw + sc];
#pragma unroll
        for (int i = 0; i < 32; ++i) scr[(32 * h + i) * 65 + lane] = tv[i];
    }
    asm volatile("s_waitcnt lgkmcnt(0)" ::: "memory");
    const int c = lane & 7;
#pragma unroll
    for (int j = 0; j < 8; ++j) { const int n = (lane >> 3) + 8 * j; const LAS float* s = scr + (8 * c) * 65 + n;
        u32x4 o; o.x = pk2(s[0 * 65], s[1 * 65]); o.y = pk2(s[2 * 65], s[3 * 65]); o.z = pk2(s[4 * 65], s[5 * 65]); o.w = pk2(s[6 * 65], s[7 * 65]);
        *(u32x4*)(WT + (size_t)(n0 + n) * K + k0 + 8 * c) = o; }
    asm volatile("s_waitcnt lgkmcnt(0)" ::: "memory");
}
__device__ __forceinline__ void transpose_item(const float* W, int ldw, int K, int srccol0, bf16_t* WT, int n0, int k0, LAS float* scr, int lane) {
    float tv[32];
#pragma unroll
    for (int i = 0; i < 32; ++i) tv[i] = W[(size_t)(k0 + 2 * i + (lane >> 5)) * ldw + srccol0 + (lane & 31)];
#pragma unroll
    for (int i = 0; i < 32; ++i) scr[(2 * i + (lane >> 5)) * 33 + (lane & 31)] = tv[i];
    asm volatile("s_waitcnt lgkmcnt(0)" ::: "memory");
    const int c = lane & 7;
#pragma unroll
    for (int j = 0; j < 4; ++j) { const int n = (lane >> 3) + 8 * j; const LAS float* s = scr + (8 * c) * 33 + n;
        u32x4 o; o.x = pk2(s[0 * 33], s[1 * 33]); o.y = pk2(s[2 * 33], s[3 * 33]); o.z = pk2(s[4 * 33], s[5 * 33]); o.w = pk2(s[6 * 33], s[7 * 33]);
        *(u32x4*)(WT + (size_t)(n0 + n) * K + k0 + 8 * c) = o; }
    asm volatile("s_waitcnt lgkmcnt(0)" ::: "memory");
}
struct PrepArgs { const float* x; const float* w_in; const float* w_sb; const float* w_nsa; const float* w_out; const float* w_gu; const float* w_dn;
                  bf16_t* wt_in; bf16_t* wt_sb; bf16_t* wt_nsa; bf16_t* wt_out; bf16_t* wt_gu; bf16_t* wt_dn; bf16_t* xb; float* ng; float* ropeT;
                  const float* pe_k; const float* w1_k; const float* w2_k; const float* pe_v; const float* w1_v; const float* w2_v; unsigned char* cmpw; float* c1; };
constexpr int CW_WT1K = 0, CW_WT1V = 262144, CW_W2TK = 524288, CW_W2TV = 532480, CW_C1K = 540672, CW_C1V = 541696;
__device__ __forceinline__ void prep_phase(const PrepArgs& a, LAS unsigned char* lds, int vcu, int G) {
    const int tid = threadIdx.x, lane = tid & 63, wave = __builtin_amdgcn_readfirstlane(tid >> 6);
    const int gw = vcu * NWAVES + wave, NGW = G * NWAVES;
    for (int i = gw * 64 + lane; i < SEQ * 32; i += NGW * 64) { const int pos = i >> 5, d = i & 31;
        const float inv = (float)pow(10000.0, -(double)d / 32.0); const float ang = (float)pos * inv;
        a.ropeT[i] = (float)cos((double)ang); a.ropeT[SEQ * 32 + i] = (float)sin((double)ang); }
    LAS float* scr = (LAS float*)(lds + wave * 16640);
    constexpr int I_IN = 16 * (4864 / 64), I_SB = 8 * 32, I_OUT = 16 * 32, I_GU = 32 * 16 * 32, I_DN = 32 * 16 * 16;
    constexpr int I_W1 = 32 * 2, I_W2 = 2, I_C1 = 16;
    constexpr int NITEMS = I_IN + 2 * I_SB + I_OUT + 2 * I_W1 + 2 * I_W2 + 2 * I_C1;
    for (int it = gw; it < NITEMS; it += NGW) {
        int r = it;
        if (r < I_IN) { const int nb = r % 76, kb = r / 76; transpose_item64(a.w_in, IN_W, 1024, win_src_col(nb * 64), win_src_col(nb * 64 + 32), a.wt_in, nb * 64, kb * 64, scr, lane); continue; } r -= I_IN;
        if (r < I_SB) { const int nb = r % 32, kb = r / 32; transpose_item(a.w_sb, 1024, 512, nb * 32, a.wt_sb, nb * 32, kb * 64, scr, lane); continue; } r -= I_SB;
        if (r < I_SB) { const int nb = r % 32, kb = r / 32; transpose_item(a.w_nsa, 1024, 512, nb * 32, a.wt_nsa, nb * 32, kb * 64, scr, lane); continue; } r -= I_SB;
        if (r < I_OUT) { const int nb = r % 32, kb = r / 32; transpose_item(a.w_out, 1024, 1024, nb * 32, a.wt_out, nb * 32, kb * 64, scr, lane); continue; } r -= I_OUT;
        if (r < I_W1) { transpose_item(a.w1_k, 64, 2048, (r & 1) * 32, (bf16_t*)(a.cmpw + CW_WT1K), (r & 1) * 32, (r >> 1) * 64, scr, lane); continue; } r -= I_W1;
        if (r < I_W1) { transpose_item(a.w1_v, 64, 2048, (r & 1) * 32, (bf16_t*)(a.cmpw + CW_WT1V), (r & 1) * 32, (r >> 1) * 64, scr, lane); continue; } r -= I_W1;
        if (r < I_W2) { transpose_item(a.w2_k, 64, 64, r * 32, (bf16_t*)(a.cmpw + CW_W2TK), r * 32, 0, scr, lane); continue; } r -= I_W2;
        if (r < I_W2) { transpose_item(a.w2_v, 64, 64, r * 32, (bf16_t*)(a.cmpw + CW_W2TV), r * 32, 0, scr, lane); continue; } r -= I_W2;
        {
            const int kv = r >> 4, part = r & 15;
            const float* pe = kv ? a.pe_v : a.pe_k; const float* w1 = kv ? a.w1_v : a.w1_k; float* c1 = a.c1 + kv * 64;
            float acc = 0.f;
#pragma unroll 1
            for (int i0 = 0; i0 < 128; i0 += 32) {
                float wv[32], pv[32];
#pragma unroll
                for (int j = 0; j < 32; ++j) { const int idx = part * 128 + i0 + j; wv[j] = w1[idx * 64 + lane]; pv[j] = pe[idx]; }
                asm volatile("" ::: "memory");
#pragma unroll
                for (int j = 0; j < 32; ++j) acc += pv[j] * wv[j];
            }
            atomicAdd(&c1[lane], acc); }
    }
    {
        auto src_of = [&](int it, const float*& W, int& ldw, int& ca, int& cb, bf16_t*& WT, int& n0, int& k0) {
            if (it < I_GU) { const int e = it / (16 * 32), q = it % (16 * 32), nb = q % 32, kb = q / 32; W = a.w_gu + (size_t)e * 1024 * 2048; ldw = 2048; ca = wgu_src_col(nb * 64); cb = wgu_src_col(nb * 64 + 32);
                WT = a.wt_gu + (size_t)e * 2048 * 1024; n0 = nb * 64; k0 = kb * 64; }
            else { const int r2 = it - I_GU; const int e = r2 / (16 * 16), q = r2 % (16 * 16), nb = q % 16, kb = q / 16; W = a.w_dn + (size_t)e * 1024 * 1024; ldw = 1024; ca = nb * 64; cb = nb * 64 + 32;
                WT = a.wt_dn + (size_t)e * 1024 * 1024; n0 = nb * 64; k0 = kb * 64; } };
        float tA[32], tB[32];
        const float* W; int ldw, ca, cb, n0, k0; bf16_t* WT;
        int it = gw;
        if (it < I_GU + I_DN) { src_of(it, W, ldw, ca, cb, WT, n0, k0); const int sc = (lane < 32) ? ca + lane : cb + (lane - 32);
#pragma unroll
            for (int i = 0; i < 32; ++i) tA[i] = W[(size_t)(k0 + i) * ldw + sc]; }
        while (it < I_GU + I_DN) {
            const int sc = (lane < 32) ? ca + lane : cb + (lane - 32);
#pragma unroll
            for (int i = 0; i < 32; ++i) tB[i] = W[(size_t)(k0 + 32 + i) * ldw + sc];
#pragma unroll
            for (int i = 0; i < 32; ++i) scr[i * 65 + lane] = tA[i];
            bf16_t* WTc = WT; const int n0c = n0, k0c = k0; const int K = 1024;
            const int itn = it + NGW;
            if (itn < I_GU + I_DN) { src_of(itn, W, ldw, ca, cb, WT, n0, k0); const int sc2 = (lane < 32) ? ca + lane : cb + (lane - 32);
#pragma unroll
                for (int i = 0; i < 32; ++i) tA[i] = W[(size_t)(k0 + i) * ldw + sc2]; }
#pragma unroll
            for (int i = 0; i < 32; ++i) scr[(32 + i) * 65 + lane] = tB[i];
            asm volatile("s_waitcnt lgkmcnt(0)" ::: "memory");
            const int c = lane & 7;
#pragma unroll
            for (int j = 0; j < 8; ++j) { const int n = (lane >> 3) + 8 * j; const LAS float* sp = scr + (8 * c) * 65 + n;
                u32x4 o; o.x = pk2(sp[0 * 65], sp[1 * 65]); o.y = pk2(sp[2 * 65], sp[3 * 65]); o.z = pk2(sp[4 * 65], sp[5 * 65]); o.w = pk2(sp[6 * 65], sp[7 * 65]);
                *(u32x4*)(WTc + (size_t)(n0c + n) * K + k0c + 8 * c) = o; }
            asm volatile("s_waitcnt lgkmcnt(0)" ::: "memory");
            it = itn;
        }
    }
    __syncthreads();
    LAS unsigned char* wl = lds;
    for (int i = tid; i < 32 * 1024; i += NTHREADS) { const int k = i >> 5, n = i & 31; const float v = (n < 24) ? a.w_in[(size_t)k * IN_W + C_NG + n] : 0.f;
        *(LAS bf16_t*)(wl + n * 2048 + ((((k >> 3) ^ (n & 15)) << 4) | ((k & 7) << 1))) = (bf16_t)f2bf(v); }
    __syncthreads();
    {
        typedef short bf16x8_t __attribute__((ext_vector_type(8)));
        const int r = lane & 15, kq = lane >> 4;
        for (int grp = gw; grp < NTOK / 16; grp += NGW) {
            const int tok = grp * 16 + r; const float* xr = a.x + (size_t)tok * DM + 8 * kq; bf16_t* xo = a.xb + (size_t)tok * DM + 8 * kq;
            f32x4 acc0 = {0.f, 0.f, 0.f, 0.f}, acc1 = {0.f, 0.f, 0.f, 0.f};
            f32x4 ra[8], rb[8];
#pragma unroll
            for (int i = 0; i < 8; ++i) { ra[i] = *(const f32x4*)(xr + 32 * i); rb[i] = *(const f32x4*)(xr + 32 * i + 4); }
#pragma unroll 1
            for (int s8 = 0; s8 < 32; s8 += 8) {
#pragma unroll
            for (int u8 = 0; u8 < 8; ++u8) {
                const int st = s8 + u8;
                const f32x4 va = ra[u8], vb = rb[u8];
                { const int sn = (s8 < 24) ? st + 8 : st;
                  ra[u8] = *(const f32x4*)(xr + 32 * sn); rb[u8] = *(const f32x4*)(xr + 32 * sn + 4); }
                u32x4 w; w.x = pk2(va[0], va[1]); w.y = pk2(va[2], va[3]); w.z = pk2(vb[0], vb[1]); w.w = pk2(vb[2], vb[3]);
                *(u32x4*)(xo + 32 * st) = w;
                const int kc = 4 * st + kq;
                const bf16x8_t b0 = *(const LAS bf16x8_t*)(wl + r * 2048 + ((kc ^ r) << 4)), b1 = *(const LAS bf16x8_t*)(wl + (16 + r) * 2048 + ((kc ^ r) << 4));
                const bf16x8_t af = __builtin_bit_cast(bf16x8_t, w);
                acc0 = __builtin_amdgcn_mfma_f32_16x16x32_bf16(af, b0, acc0, 0, 0, 0); acc1 = __builtin_amdgcn_mfma_f32_16x16x32_bf16(af, b1, acc1, 0, 0, 0);
            }
            }
#pragma unroll
            for (int q = 0; q < 4; ++q) { float* o = a.ng + (size_t)(grp * 16 + 4 * kq + q) * 24; o[r] = 1.f / (1.f + expf(-acc0[q])); if (r < 8) o[16 + r] = 1.f / (1.f + expf(-acc1[q])); }
        }
    }
}
#define GAS __attribute__((address_space(1)))
typedef GAS unsigned gu32;
typedef GAS unsigned long long gu64;
#define RLX_AGENT __ATOMIC_RELAXED, __HIP_MEMORY_SCOPE_AGENT
#define LDS_WAIT() asm volatile("s_waitcnt lgkmcnt(0)" ::: "memory")
#define VM_WAIT() asm volatile("s_waitcnt vmcnt(0)" ::: "memory")
__device__ __forceinline__ unsigned long long rt() { return __builtin_amdgcn_s_memrealtime(); }

#define XB_TMO      128
#define XB_XCNT(j)  (256  + 64 * (j))
#define XB_XSUB(j)  (1280 + 64 * (j))
#define XB_XGEN(j)  (2304 + 64 * (j))
#define XB_TOP      3328
#define XB_TOPGEN   3392
#define XCD_BAR_WORDS 3456
#define XB_SPIN_CAP (1u << 18)

__device__ __forceinline__ unsigned xb_ld(unsigned* p)              { return __hip_atomic_load(p, __ATOMIC_RELAXED, __HIP_MEMORY_SCOPE_AGENT); }
__device__ __forceinline__ unsigned xb_add(unsigned* p, unsigned v) { return __hip_atomic_fetch_add(p, v, __ATOMIC_RELAXED, __HIP_MEMORY_SCOPE_AGENT); }
__device__ __forceinline__ unsigned xb_xcc_id() { return (unsigned)__builtin_amdgcn_s_getreg((3 << 11) | 20) & 0xFu; }
#define XB_SPIN(cond, bar) do { unsigned _sp = 0; while (cond) { __builtin_amdgcn_s_sleep(1); \
    if ((++_sp & 255u) == 0u) { if (xb_ld(&(bar)[XB_TMO])) break; if (_sp > XB_SPIN_CAP) { atomicAdd(&(bar)[XB_TMO], 1u); break; } } } } while (0)

struct XcdBarrier {
    unsigned* bar; unsigned x;
    volatile LAS unsigned* st;
};

__device__ __forceinline__ XcdBarrier xcd_barrier_post(unsigned* bar, volatile LAS unsigned* st) {
    XcdBarrier b; b.bar = bar; b.x = xb_xcc_id(); b.st = st;
    if (threadIdx.x == 0) (void)xb_add(&bar[XB_XCNT(b.x)], 1u);
    return b;
}
__device__ __forceinline__ void xcd_barrier_complete(unsigned* bar, unsigned x, unsigned& nloc, unsigned& nx) {
    const unsigned G = gridDim.x * gridDim.y * gridDim.z;
    unsigned sum, cnt, mine, sp = 0u;
    for (;;) {
        sum = 0u; cnt = 0u; mine = 0u;
#pragma unroll
        for (unsigned j = 0; j < 16; ++j) { const unsigned c = xb_ld(&bar[XB_XCNT(j)]); sum += c; cnt += (c > 0u) ? 1u : 0u; mine = (j == x) ? c : mine; }
        if (sum == G) break;
        __builtin_amdgcn_s_sleep(1);
        if ((++sp & 255u) == 0u) { if (xb_ld(&bar[XB_TMO])) break; if (sp > XB_SPIN_CAP) { atomicAdd(&bar[XB_TMO], 1u); break; } }
    }
    nloc = mine > 0u ? mine : 1u; nx = cnt > 0u ? cnt : 1u;
}

__device__ __forceinline__ void xcd_barrier(const XcdBarrier& b) {
    asm volatile("s_waitcnt vmcnt(0)" ::: "memory");
    __syncthreads();
    if (threadIdx.x == 0) {
        unsigned* bar = b.bar;
        __builtin_amdgcn_s_waitcnt(0);
        unsigned nloc = b.st[0], nx = b.st[1];
        if (nloc == 0u) { xcd_barrier_complete(bar, b.x, nloc, nx); b.st[0] = nloc; b.st[1] = nx; }
        const unsigned old = xb_add(&bar[XB_XSUB(b.x)], 1u);
        const unsigned gen = old / nloc;
        if (old + 1u == (gen + 1u) * nloc) {
            __builtin_amdgcn_fence(__ATOMIC_RELEASE, "agent");
            asm volatile("s_waitcnt vmcnt(0)" ::: "memory");
            const unsigned og = xb_add(&bar[XB_TOP], 1u);
            const unsigned tg = og / nx;
            if (og + 1u == (tg + 1u) * nx) xb_add(&bar[XB_TOPGEN], 1u);
            else XB_SPIN(xb_ld(&bar[XB_TOPGEN]) == tg, bar);
            __builtin_amdgcn_fence(__ATOMIC_ACQUIRE, "agent");
            xb_add(&bar[XB_XGEN(b.x)], 1u);
            asm volatile("s_waitcnt vmcnt(0)" ::: "memory");
        } else {
            XB_SPIN(xb_ld(&bar[XB_XGEN(b.x)]) == gen, bar);
            __builtin_amdgcn_fence(__ATOMIC_ACQUIRE, "agent");
            asm volatile("s_waitcnt vmcnt(0)" ::: "memory");
        }
    }
    __syncthreads();
}


typedef short bf16x8 __attribute__((ext_vector_type(8)));
typedef short s16x4 __attribute__((ext_vector_type(4)));
constexpr int AT_NS = 4, AT_SLOT = 8192, AT_K = 0, AT_V = AT_NS * AT_SLOT, AT_PSLC = 2 * AT_NS * AT_SLOT  , AT_MASK = AT_PSLC + 32768  , AT_FLAG = AT_MASK + 1024  ;
#define AT_WAIT_BAR(N) asm volatile("s_waitcnt vmcnt(" #N ") lgkmcnt(0)\n\ts_barrier" ::: "memory")
__device__ __forceinline__ int crow(int r, int hi) { return (r & 3) + 8 * (r >> 2) + 4 * hi; }
#define CROW0(r) (((r) & 3) + 8 * ((r) >> 2))
__device__ __forceinline__ float fexp2(float x) { return __builtin_amdgcn_exp2f(x); }
__device__ __forceinline__ float flog2(float x) { return __builtin_amdgcn_logf(x); }
__device__ __forceinline__ unsigned cvtpk(float lo, float hi) { f32x2 v = {lo, hi}; typedef __bf16 bf2 __attribute__((ext_vector_type(2))); bf2 b = __builtin_convertvector(v, bf2); return __builtin_bit_cast(unsigned, b); }
__device__ __forceinline__ float swap_get(float x) { auto r = __builtin_amdgcn_permlane32_swap(__float_as_uint(x), __float_as_uint(x), false, false); return (threadIdx.x & 32) ? __uint_as_float(r[0]) : __uint_as_float(r[1]); }
__device__ __forceinline__ float quad_sum(float x) {
    x += __builtin_bit_cast(float, __builtin_amdgcn_update_dpp(0, __builtin_bit_cast(int, x), 0xB1  , 0xF, 0xF, true));
    x += __builtin_bit_cast(float, __builtin_amdgcn_update_dpp(0, __builtin_bit_cast(int, x), 0x4E  , 0xF, 0xF, true));
    return x;
}
struct KVTile { const bf16_t* k; const bf16_t* v; int pitch; };
__device__ __forceinline__ void glds16(const void* gbase_uniform, unsigned voff, unsigned lds_dst) { unsigned keep;
    const unsigned long long a = (unsigned long long)gbase_uniform;
    const unsigned long long sb = (unsigned long long)(unsigned)__builtin_amdgcn_readfirstlane((unsigned)a) | ((unsigned long long)(unsigned)__builtin_amdgcn_readfirstlane((unsigned)(a >> 32)) << 32);
    asm volatile("s_nop 4\n\ts_mov_b32 %0, m0\n\ts_mov_b32 m0, %3\n\ts_nop 0\n\tglobal_load_lds_dwordx4 %1, %2\n\ts_mov_b32 m0, %0" : "=&s"(keep) : "v"(voff), "s"(sb), "s"(lds_dst) : "memory"); }
__device__ __forceinline__ void dma_kv(LAS unsigned char* lds, const KVTile& s, int key0, int slot, int wid, int lane) {
    const int kl_ = ((lane >> 5) & 1) * 4 + ((lane >> 2) & 3), c_ = 4 * ((lane >> 4) & 1) + (((lane & 3) - wid) & 3);
    const unsigned koff = (unsigned)(((8 * wid + kl_) * s.pitch + c_ * 8) * 2);
    const unsigned voff = (unsigned)(((16 * (wid & 3) + (lane >> 2)) * s.pitch + (wid >> 2) * 32 + (lane & 3) * 8) * 2);
    const unsigned base = (unsigned)(uintptr_t)lds;
    glds16(s.k + (size_t)key0 * s.pitch, koff, (unsigned)__builtin_amdgcn_readfirstlane(base + AT_K + slot * AT_SLOT + wid * 1024));
    glds16(s.v + (size_t)key0 * s.pitch, voff, (unsigned)__builtin_amdgcn_readfirstlane(base + AT_V + slot * AT_SLOT + wid * 1024));
}
__device__ __forceinline__ bf16x8 ones_frag(int lane) { const u32x4 o = {(lane < 32) ? 0x3F80u : 0u, 0u, 0u, 0u}; return __builtin_bit_cast(bf16x8, o); }
__device__ __forceinline__ bf16x8 w_frag(float w, int lane) { const u32x4 o = {(lane < 32) ? (__float_as_uint(w) >> 16) : 0u, 0u, 0u, 0u}; return __builtin_bit_cast(bf16x8, o); }
template <bool HASW> __device__ __forceinline__ void qkt(f32x16& p0, f32x16& p1, const LAS unsigned char* kslot, const bf16x8 (&qf)[4], const bf16x8& onesf, const bf16x8& wf, int lane) {
    const int q_ = lane & 31, j_ = q_ >> 3, r0_ = (j_ + (lane >> 5)) & 3;
    const LAS unsigned char* kb = kslot + j_ * 1024 + ((q_ >> 2) & 1) * 512 + (q_ & 3) * 64;
    const LAS unsigned char* ka0 = kb + 16 * r0_; const LAS unsigned char* ka1 = kb + 16 * (r0_ ^ 2);
    bf16x8 kf[8];
#pragma unroll
    for (int d0 = 0; d0 < 4; ++d0) { const LAS unsigned char* kp = ((d0 & 1) ? ka1 : ka0) + (d0 >> 1) * 256; kf[2 * d0] = *(const LAS bf16x8*)kp; kf[2 * d0 + 1] = *(const LAS bf16x8*)(kp + 4096); }
    const f32x16 z16 = {0.f, 0.f, 0.f, 0.f, 0.f, 0.f, 0.f, 0.f, 0.f, 0.f, 0.f, 0.f, 0.f, 0.f, 0.f, 0.f};
    p0 = __builtin_amdgcn_mfma_f32_32x32x16_bf16(kf[0], qf[0], z16, 0, 0, 0);
    p1 = __builtin_amdgcn_mfma_f32_32x32x16_bf16(kf[1], qf[0], z16, 0, 0, 0);
#pragma unroll
    for (int d0 = 1; d0 < 4; ++d0) {
        p0 = __builtin_amdgcn_mfma_f32_32x32x16_bf16(kf[2 * d0], qf[d0], p0, 0, 0, 0);
        p1 = __builtin_amdgcn_mfma_f32_32x32x16_bf16(kf[2 * d0 + 1], qf[d0], p1, 0, 0, 0);
    }
    if (HASW) { p0 = __builtin_amdgcn_mfma_f32_32x32x16_bf16(onesf, wf, p0, 0, 0, 0); p1 = __builtin_amdgcn_mfma_f32_32x32x16_bf16(onesf, wf, p1, 0, 0, 0); }
}
struct VFrag { s16x4 lo[8], hh[8]; };
__device__ __forceinline__ void vload(VFrag& vf, const LAS unsigned char* vslot, int lane) {
    const int hi = lane >> 5;
    const unsigned vb = (unsigned)(uintptr_t)vslot + ((lane >> 4) & 1) * 32 + (lane & 3) * 8 + (4 * hi + ((lane & 15) >> 2)) * 64;
#pragma unroll
    for (int i = 0; i < 8; ++i) { const int d0 = i >> 2, ks = i & 3;
        asm volatile("ds_read_b64_tr_b16 %0, %1 offset:%c2" : "=&v"(vf.lo[i]) : "v"(vb), "i"(d0 * 4096 + ks * 1024) : "memory");
        asm volatile("ds_read_b64_tr_b16 %0, %1 offset:%c2" : "=&v"(vf.hh[i]) : "v"(vb), "i"(d0 * 4096 + ks * 1024 + 512) : "memory"); }
}
__device__ __forceinline__ void pvmm(f32x16 (&oT)[2], const VFrag& vf, const f32x16& p0, const f32x16& p1) {
    bf16x8 pb[4];
#pragma unroll
    for (int ks = 0; ks < 4; ++ks) { const f32x16& p = (ks < 2) ? p0 : p1; const int b = (ks & 1) * 8;
        u32x4 w; w.x = cvtpk(p[b], p[b + 1]); w.y = cvtpk(p[b + 2], p[b + 3]); w.z = cvtpk(p[b + 4], p[b + 5]); w.w = cvtpk(p[b + 6], p[b + 7]); pb[ks] = __builtin_bit_cast(bf16x8, w); }
#pragma unroll
    for (int i = 0; i < 8; ++i) { const int d0 = i >> 2, ks = i & 3;
        const bf16x8 v = (bf16x8){vf.lo[i][0], vf.lo[i][1], vf.lo[i][2], vf.lo[i][3], vf.hh[i][0], vf.hh[i][1], vf.hh[i][2], vf.hh[i][3]};
        oT[d0] = __builtin_amdgcn_mfma_f32_32x32x16_bf16(v, pb[ks], oT[d0], 0, 0, 0); }
}
#define AT_VWAIT() do { asm volatile("s_waitcnt lgkmcnt(0)" ::: "memory"); __builtin_amdgcn_sched_barrier(0); } while (0)
__device__ __forceinline__ float max3f(float a, float b, float c) { float r; asm("v_max3_f32 %0, %1, %2, %3" : "=v"(r) : "v"(a), "v"(b), "v"(c)); return r; }
__device__ __forceinline__ float rowmax32(const f32x16& p0, const f32x16& p1) {
    float a = max3f(p0[0], p0[1], p1[0]), b = max3f(p0[2], p0[3], p1[1]); a = max3f(a, p1[2], p1[3]);
#pragma unroll
    for (int r = 4; r < 16; r += 4) { a = max3f(a, p0[r], p0[r + 1]); b = max3f(b, p0[r + 2], p0[r + 3]); a = max3f(a, p1[r], p1[r + 1]); b = max3f(b, p1[r + 2], p1[r + 3]); }
    const float m = fmaxf(a, b);
    return fmaxf(m, swap_get(m));
}
constexpr float NEG = -1.0e30f, SM_THR = 8.f, SM_BIG = 16777216.f;
struct SmState { float negm, l; bool mset, allset; };
__device__ __forceinline__ void sm_init(SmState& st) { st.negm = 0.f; st.l = 0.f; st.mset = false; st.allset = false; }
__device__ __forceinline__ f32x16 splat16(float v) { f32x16 c;
#pragma unroll
    for (int r = 0; r < 16; ++r) c[r] = v;
    return c; }
template <bool HAS_O> __device__ __forceinline__ void softmax_tile(f32x16& p0, f32x16& p1, SmState& st, f32x16 (&oT)[2]) {
    asm volatile("s_nop 7\n\ts_nop 7\n\ts_nop 7" : "+v"(p0), "+v"(p1));
    const float rm = rowmax32(p0, p1);
    const bool need = (rm > SM_THR) || (!st.mset && rm > -1.0e29f);
    if (__any(need)) {
        const float nn = need ? __uint_as_float(__float_as_uint(st.negm - rm) & 0xFFFF0000u) : st.negm;
        const float delta = st.negm - nn; const float f = need ? (st.mset ? fexp2(-delta) : 0.f) : 1.f;
        st.negm = nn; st.l *= f; st.mset = st.mset || need;
#pragma unroll
        for (int r = 0; r < 16; ++r) { p0[r] -= delta; p1[r] -= delta; if (HAS_O) { oT[0][r] *= f; oT[1][r] *= f; } }
    }
    float s0 = 0.f, s1 = 0.f;
#pragma unroll
    for (int r = 0; r < 16; ++r) { p0[r] = fexp2(p0[r]); p1[r] = fexp2(p1[r]); s0 += p0[r]; s1 += p1[r]; }
    st.l += s0 + s1;
    st.allset = __all(st.mset);
}
__device__ __forceinline__ bool softmax_fast(f32x16& p0, f32x16& p1, SmState& st) {
    float s0 = 0.f, s1 = 0.f;
#pragma unroll
    for (int r = 0; r < 16; ++r) { p0[r] = fexp2(p0[r]); p1[r] = fexp2(p1[r]); s0 += p0[r]; asm("" : "+v"(s0)); s1 += p1[r]; asm("" : "+v"(s1)); }
    const float sum = s0 + s1;
    if (__any(!(sum < SM_BIG))) return false;
    st.l += sum; return true;
}
__device__ __forceinline__ void load_q(bf16x8 (&qf)[4], const bf16_t* qrow, int lane) {
#pragma unroll
    for (int d0 = 0; d0 < 4; ++d0) qf[d0] = *(const bf16x8*)(qrow + d0 * 16 + (lane >> 5) * 8);
    asm volatile("" : "+v"(qf[0]), "+v"(qf[1]), "+v"(qf[2]), "+v"(qf[3]));
}
__device__ __forceinline__ int next_item(int* head, LAS unsigned char* lds) {
    LAS int* slot = (LAS int*)(lds + AT_FLAG + 128);
    __syncthreads();
    if (threadIdx.x == 0) slot[0] = atomicAdd(head, 1);
    __syncthreads();
    return slot[0];
}

#define QPREFETCH(head) int q_nx_ = 0; if (threadIdx.x == 0) q_nx_ = atomicAdd((head), 1)
#define QADVANCE(cur, lds) do { LAS int* q_slot_ = (LAS int*)((lds) + AT_FLAG + 128); if (threadIdx.x == 0) q_slot_[0] = q_nx_; \
        asm volatile("s_waitcnt lgkmcnt(0)\n\ts_barrier" ::: "memory"); (cur) = q_slot_[0]; asm volatile("s_waitcnt lgkmcnt(0)\n\ts_barrier" ::: "memory"); } while (0)

__device__ __forceinline__ void cmpsel_item(int item, const bf16_t* NQ, const bf16_t* KCMP, const bf16_t* VCMP, const bf16_t* KS, const bf16_t* VS, const bf16_t* KW, const bf16_t* VW, const float* NG,
                                            const float* YPART, bf16_t* YNSA, LAS unsigned char* lds, unsigned long long* istamp = nullptr) {
    const int tid = threadIdx.x, lane = tid & 63, wid = __builtin_amdgcn_readfirstlane(tid >> 6), hi = lane >> 5, q = lane & 31;
    const int qb = 127 - (item & 127), bg = item >> 7, b = bg >> 1, g = bg & 1;
    const size_t rowbase = (size_t)b * SEQ; const int t0 = qb * 64, tl = wid * 8 + (q >> 2), t = t0 + tl, hq = g * 4 + (q & 3);
    LAS float* pslc = (LAS float*)(lds + AT_PSLC); LAS unsigned* msk = (LAS unsigned*)(lds + AT_MASK); LAS unsigned* flg = (LAS unsigned*)(lds + AT_FLAG);
#ifdef PROBE_ITEM
#define ISTAMP(i) do { if (istamp && threadIdx.x == 0) istamp[i] = __builtin_amdgcn_s_memrealtime(); } while (0)
#else
#define ISTAMP(i) do { } while (0)
#endif
    ISTAMP(0);
    float g_c = NG[(rowbase + t) * 24 + hq * 3 + 0], g_s = NG[(rowbase + t) * 24 + hq * 3 + 1], g_w = NG[(rowbase + t) * 24 + hq * 3 + 2];
    bf16x8 qf[4]; load_q(qf, NQ + (rowbase + t) * 512 + hq * 64, lane);
    asm volatile("" : "+v"(g_c), "+v"(g_s), "+v"(g_w));
    const bf16x8 onesf = ones_frag(lane);
    const KVTile kvc{KCMP + (size_t)bg * 512 * 64, VCMP + (size_t)bg * 512 * 64, 64};
    const KVTile kvs{KS + rowbase * 128 + g * 64, VS + rowbase * 128 + g * 64, 128};
    f32x16 oT[2]; SmState st;
    {
        const KVTile kvw{KW + rowbase * 128 + g * 64, VW + rowbase * 128 + g * 64, 128};
        const int T1 = qb, T0 = (qb >= 8) ? qb - 8 : 0, NT = T1 - T0 + 1;
        sm_init(st);
#pragma unroll
        for (int r = 0; r < 16; ++r) { oT[0][r] = 0.f; oT[1][r] = 0.f; }
        dma_kv(lds, kvw, T0 * 64, 0, wid, lane);
        if (NT > 1) dma_kv(lds, kvw, (T0 + 1) * 64, 1, wid, lane);
        if (NT > 2) dma_kv(lds, kvw, (T0 + 2) * 64, 2, wid, lane);
        for (int i = 0; i < NT; ++i) {
            if (i + 2 < NT) { AT_WAIT_BAR(4); } else if (i + 1 < NT) { AT_WAIT_BAR(2); } else { AT_WAIT_BAR(0); }
            if (i + 3 < NT) dma_kv(lds, kvw, (T0 + i + 3) * 64, (i + 3) % AT_NS, wid, lane);
            const int T = T0 + i, slot = i % AT_NS;
            f32x16 p0, p1; VFrag vf;
            for (bool exact = !st.allset;; exact = true) {
                qkt<true>(p0, p1, lds + AT_K + slot * AT_SLOT, qf, onesf, w_frag(st.negm, lane), lane);
                vload(vf, lds + AT_V + slot * AT_SLOT, lane);
                if (T == T1 || T == qb - 8) {
                    const int lo_ = t - 511 - T * 64 - 4 * hi, hi_ = t - T * 64 - 4 * hi;
#pragma unroll
                    for (int r = 0; r < 16; ++r) { if (CROW0(r) < lo_ || CROW0(r) > hi_) p0[r] = NEG; if (CROW0(r) + 32 < lo_ || CROW0(r) + 32 > hi_) p1[r] = NEG; }
                }
                if (exact) { softmax_tile<true>(p0, p1, st, oT); break; }
                if (softmax_fast(p0, p1, st)) break;
            }
            AT_VWAIT(); pvmm(oT, vf, p0, p1);
        }
        const float lw = st.l + swap_get(st.l);
        const float scw = g_w / lw;
#pragma unroll
        for (int r = 0; r < 16; ++r) { oT[0][r] *= scw; oT[1][r] *= scw; }
        asm volatile("s_waitcnt lgkmcnt(0)\n\ts_barrier" ::: "memory");
        dma_kv(lds, kvs, 0, 3, wid, lane);
    }
    ISTAMP(1);
    const int nv = (t >= 31) ? ((t - 31) >> 4) + 1 : 0;
    const int tw = t0 + wid * 8; const int nvw = (tw >= 31) ? ((tw - 31) >> 4) + 1 : 0;
    const int nvmax = (t0 + 63 >= 31) ? ((t0 + 63 - 31) >> 4) + 1 : 0, NTc = (nvmax + 63) >> 6;
    if (tid < 8) flg[tid] = 0u;
    float lc = 0.f, inv = 0.f;
    sm_init(st);
    {
        dma_kv(lds, kvc, 0, 0, wid, lane); if (NTc > 1) dma_kv(lds, kvc, 64, 1, wid, lane);
        for (int i = 0; i < NTc; ++i) {
            if (i + 1 < NTc) { AT_WAIT_BAR(2); } else { AT_WAIT_BAR(0); }
            if (i + 2 < NTc) dma_kv(lds, kvc, (i + 2) * 64, (i + 2) % 3, wid, lane);
            f32x16 p0, p1;
            for (bool exact = !st.allset;; exact = true) {
                qkt<true>(p0, p1, lds + AT_K + (i % 3) * AT_SLOT, qf, onesf, w_frag(st.negm, lane), lane);
                if (i * 64 + 64 > nvw) { const int lim = nv - i * 64 - 4 * hi;
#pragma unroll
                    for (int r = 0; r < 16; ++r) { if (CROW0(r) >= lim) p0[r] = NEG; if (CROW0(r) + 32 >= lim) p1[r] = NEG; } }
                if (exact) { softmax_tile<false>(p0, p1, st, oT); break; }
                if (softmax_fast(p0, p1, st)) break;
            }
        }
        asm volatile("s_waitcnt lgkmcnt(0)\n\ts_barrier" ::: "memory");
    }
    lc = st.l + swap_get(st.l);
    inv = (nv > 0) ? 1.f / lc : 0.f;
    const float ccmp = fmaxf(g_c * inv, 1e-20f);
    { const float rc = 1.f / ccmp;
#pragma unroll
      for (int r = 0; r < 16; ++r) { oT[0][r] *= rc; oT[1][r] *= rc; } }
    {
        float carryB = 0.f;
        dma_kv(lds, kvc, 0, 0, wid, lane); if (NTc > 1) dma_kv(lds, kvc, 64, 1, wid, lane);
        for (int i = 0; i < NTc; ++i) {
            if (i + 1 < NTc) { AT_WAIT_BAR(2); } else { AT_WAIT_BAR(0); }
            if (i + 2 < NTc) dma_kv(lds, kvc, (i + 2) * 64, (i + 2) % 3, wid, lane);
            f32x16 p0, p1; qkt<true>(p0, p1, lds + AT_K + (i % 3) * AT_SLOT, qf, onesf, w_frag(st.negm, lane), lane);
            VFrag vf; vload(vf, lds + AT_V + (i % 3) * AT_SLOT, lane);
            if (i * 64 + 64 > nvw) { const int lim = nv - i * 64 - 4 * hi;
#pragma unroll
                for (int r = 0; r < 16; ++r) { if (CROW0(r) >= lim) p0[r] = NEG; if (CROW0(r) + 32 >= lim) p1[r] = NEG; } }
#pragma unroll
            for (int r = 0; r < 16; ++r) { p0[r] = fexp2(p0[r]); p1[r] = fexp2(p1[r]); }
            AT_VWAIT(); pvmm(oT, vf, p0, p1);
            { float Aq[2][4], PB[2][4];
#pragma unroll
              for (int kh = 0; kh < 2; ++kh)
#pragma unroll
                  for (int c = 0; c < 4; ++c) { const f32x16& p = kh ? p1 : p0;
                      Aq[kh][c] = quad_sum(((p[4 * c] + p[4 * c + 1]) + (p[4 * c + 2] + p[4 * c + 3])) * inv); PB[kh][c] = swap_get(quad_sum(p[4 * c + 3] * inv)); }
#pragma unroll
              for (int kh = 0; kh < 2; ++kh)
#pragma unroll
                  for (int c = 0; c < 4; ++c) { const float prevB = hi ? PB[kh][c] : (c ? PB[kh][c ? c - 1 : 0] : (kh ? PB[0][3] : carryB));
                      const int j = 16 * i + 8 * kh + 2 * c + hi;
                      if ((q & 3) == 0 && j < 128) pslc[tl * 128 + j] = Aq[kh][c] + prevB; }
              carryB = PB[1][3]; }
        }
        asm volatile("s_waitcnt lgkmcnt(0)\n\ts_barrier" ::: "memory");
    }
    f32x16 yp[2];
#pragma unroll
    for (int r = 0; r < 16; ++r) { yp[0][r] = oT[0][r] * ccmp; yp[1][r] = oT[1][r] * ccmp; oT[0][r] = 0.f; oT[1][r] = 0.f; }
    ISTAMP(2);
    asm volatile("s_waitcnt lgkmcnt(0)" ::: "memory");
    unsigned long long ulo = 0ull, uhi = 0ull;
    for (int tk = 0; tk < 8; ++tk) {
        const int row = wid * 8 + tk; const int j0 = lane, j1 = lane + 64;
        const bool f0 = (j0 == 0) || (j0 == qb) || (j0 == qb - 1), f1 = (j1 == qb) || (j1 == qb - 1);
        unsigned long long mlo, mhi;
        if (qb < 16) { mlo = __ballot(j0 <= qb); mhi = 0ull; }
        else {
            const unsigned k0 = (!f0 && j0 <= qb) ? __float_as_uint(pslc[row * 128 + j0]) + 1u : 0u, k1 = (!f1 && j1 <= qb) ? __float_as_uint(pslc[row * 128 + j1]) + 1u : 0u;
            unsigned T = 0u;
            for (int bit = 31; bit >= 0; --bit) { const unsigned cand = T | (1u << bit);
                const int cnt = __popcll(__ballot(k0 >= cand)) + __popcll(__ballot(k1 >= cand)); if (cnt >= 13) T = cand;
                if (cnt == 13) break; }
            const bool gt0 = k0 > T, gt1 = k1 > T, eq0 = (k0 == T), eq1 = (k1 == T);
            const unsigned long long be0 = __ballot(eq0), be1 = __ballot(eq1);
            const int rem = 13 - (__popcll(__ballot(gt0)) + __popcll(__ballot(gt1)));
            const unsigned long long below = (lane == 0) ? 0ull : (~0ull >> (64 - lane));
            const int pre0 = __popcll(be0 & below), pre1 = __popcll(be0) + __popcll(be1 & below);
            mlo = __ballot(f0 || gt0 || (eq0 && pre0 < rem)); mhi = __ballot(f1 || gt1 || (eq1 && pre1 < rem));
        }
        ulo |= mlo; uhi |= mhi;
        if (lane == 0) { msk[row * 4 + 0] = (unsigned)mlo; msk[row * 4 + 1] = (unsigned)(mlo >> 32); msk[row * 4 + 2] = (unsigned)mhi; msk[row * 4 + 3] = (unsigned)(mhi >> 32); }
    }
    if (lane == 0) { (void)__hip_atomic_fetch_or(&flg[0], (unsigned)ulo, __ATOMIC_RELAXED, __HIP_MEMORY_SCOPE_WORKGROUP); (void)__hip_atomic_fetch_or(&flg[1], (unsigned)(ulo >> 32), __ATOMIC_RELAXED, __HIP_MEMORY_SCOPE_WORKGROUP);
                     (void)__hip_atomic_fetch_or(&flg[2], (unsigned)uhi, __ATOMIC_RELAXED, __HIP_MEMORY_SCOPE_WORKGROUP); (void)__hip_atomic_fetch_or(&flg[3], (unsigned)(uhi >> 32), __ATOMIC_RELAXED, __HIP_MEMORY_SCOPE_WORKGROUP); }
    asm volatile("s_waitcnt lgkmcnt(0)\n\ts_barrier" ::: "memory");
    const unsigned mk0 = msk[tl * 4 + 0], mk1 = msk[tl * 4 + 1], mk2 = msk[tl * 4 + 2], mk3 = msk[tl * 4 + 3];
    unsigned long long blo = ((unsigned long long)flg[1] << 32) | flg[0], bhi = ((unsigned long long)flg[3] << 32) | flg[2];
    blo = (unsigned long long)(unsigned)__builtin_amdgcn_readfirstlane((unsigned)blo) | ((unsigned long long)(unsigned)__builtin_amdgcn_readfirstlane((unsigned)(blo >> 32)) << 32);
    bhi = (unsigned long long)(unsigned)__builtin_amdgcn_readfirstlane((unsigned)bhi) | ((unsigned long long)(unsigned)__builtin_amdgcn_readfirstlane((unsigned)(bhi >> 32)) << 32);
    ISTAMP(3);
    auto nextbit = [&](int from) -> int {
        if (from < 64) { const unsigned long long x = blo & (~0ull << from); if (x) return __builtin_ctzll(x); from = 64; }
        if (from < 128) { const unsigned long long x = bhi & (~0ull << (from - 64)); if (x) return 64 + __builtin_ctzll(x); }
        return 128; };
    sm_init(st);
    const int tlh = tl - 4 * hi;
    int jc = nextbit(0), jn = nextbit(jc + 1), jnn = (jn < 128) ? nextbit(jn + 1) : 128, jn3 = (jnn < 128) ? nextbit(jnn + 1) : 128, i = 0;
    if (jn < 128) dma_kv(lds, kvs, jn * 64, 0, wid, lane); if (jnn < 128) dma_kv(lds, kvs, jnn * 64, 1, wid, lane);
    while (jc < 128) {
        if (jnn < 128) { AT_WAIT_BAR(4); } else if (jn < 128) { AT_WAIT_BAR(2); } else { AT_WAIT_BAR(0); }
        if (jn3 < 128) dma_kv(lds, kvs, jn3 * 64, (i + 2) % AT_NS, wid, lane);
        const bool wave_needs = (jc < 64) ? ((ulo >> jc) & 1ull) : ((uhi >> (jc - 64)) & 1ull);
        if (wave_needs) {
            const unsigned w = (jc < 32) ? mk0 : (jc < 64) ? mk1 : (jc < 96) ? mk2 : mk3;
            const bool mine = (w >> (jc & 31)) & 1u;
            f32x16 p0, p1; VFrag vf;
            for (bool exact = !st.allset;; exact = true) {
                qkt<true>(p0, p1, lds + AT_K + ((i + 3) % AT_NS) * AT_SLOT, qf, onesf, w_frag(mine ? st.negm : NEG, lane), lane);
                vload(vf, lds + AT_V + ((i + 3) % AT_NS) * AT_SLOT, lane);
                if (jc == qb) {
#pragma unroll
                    for (int r = 0; r < 16; ++r) { if (CROW0(r) > tlh) p0[r] = NEG; if (CROW0(r) + 32 > tlh) p1[r] = NEG; } }
                if (exact) { softmax_tile<true>(p0, p1, st, oT); break; }
                if (softmax_fast(p0, p1, st)) break;
            }
            AT_VWAIT(); pvmm(oT, vf, p0, p1);
        }
        jc = jn; jn = jnn; jnn = jn3; jn3 = (jn3 < 128) ? nextbit(jn3 + 1) : 128; ++i;
    }
    ISTAMP(4);
    const float l = st.l + swap_get(st.l);
    const float sc = g_s / l;
    bf16_t* yo = YNSA + (rowbase + t) * 512 + hq * 64;
#pragma unroll
    for (int d0 = 0; d0 < 2; ++d0)
#pragma unroll
        for (int c = 0; c < 4; ++c) {
            u32x2 o; o.x = cvtpk(yp[d0][4 * c] + oT[d0][4 * c] * sc, yp[d0][4 * c + 1] + oT[d0][4 * c + 1] * sc);
            o.y = cvtpk(yp[d0][4 * c + 2] + oT[d0][4 * c + 2] * sc, yp[d0][4 * c + 3] + oT[d0][4 * c + 3] * sc);
            *(u32x2*)(yo + d0 * 32 + 8 * c + 4 * hi) = o; }
    asm volatile("s_waitcnt lgkmcnt(0)\n\ts_barrier" ::: "memory");
}

constexpr float SB_THR = 48.f;
__device__ __forceinline__ void sb_item(int item, const bf16_t* SBQ, const bf16_t* SBK, const bf16_t* SBV, bf16_t* YSB, LAS unsigned char* lds) {
    const int tid = threadIdx.x, lane = tid & 63, wid = __builtin_amdgcn_readfirstlane(tid >> 6), hi = lane >> 5, q = lane & 31;
    const int qblk = 31 - (item & 31), bh = item >> 5, b = bh >> 3, h = bh & 7;
    const size_t rowbase = (size_t)b * SEQ; const int q0 = qblk * 256, tw0 = q0 + 32 * wid, t = tw0 + q;
    LAS unsigned* flg = (LAS unsigned*)(lds + AT_FLAG);
    const KVTile kv{SBK + rowbase * 512 + h * 64, SBV + rowbase * 512 + h * 64, 512};
    bf16x8 qf[4]; load_q(qf, SBQ + (rowbase + t) * 512 + h * 64, lane);
    f32x16 oT[2];
#pragma unroll
    for (int r = 0; r < 16; ++r) { oT[0][r] = 0.f; oT[1][r] = 0.f; }
    float carry = 0.f; bool wdone = false;
    const int Tmax = (q0 + 254) >> 6, NT = Tmax + 1;
    if (tid < 8) flg[tid] = 0u;
    dma_kv(lds, kv, Tmax * 64, 0, wid, lane); if (NT > 1) dma_kv(lds, kv, (Tmax - 1) * 64, 1, wid, lane);
    for (int i = 0; i < NT; ++i) {
        if (i + 1 < NT) { AT_WAIT_BAR(2); } else { AT_WAIT_BAR(0); }
        if ((flg[0] & flg[1] & flg[2] & flg[3] & flg[4] & flg[5] & flg[6] & flg[7]) != 0u) break;
        if (i + 2 < NT) dma_kv(lds, kv, (Tmax - i - 2) * 64, (i + 2) % 3, wid, lane);
        const int T = Tmax - i, slot = i % 3;
        if (!wdone && 64 * T <= tw0 + 30) {
            f32x16 p0, p1; qkt<false>(p0, p1, lds + AT_K + slot * AT_SLOT, qf, qf[0], qf[0], lane);
            const int lim = t - 64 * T - 4 * hi;
            f32x16 k0v, k1v;
#pragma unroll
            for (int r = 0; r < 16; ++r) {
                const int kl = CROW0(r);
                { const float z = fminf(p0[r], 64.f); const float sp = flog2(1.f + fexp2(z)); const bool v = kl < lim; k0v[r] = v ? -sp : 0.f; p0[r] = v ? z - sp : NEG; }
                { const float z = fminf(p1[r], 64.f); const float sp = flog2(1.f + fexp2(z)); const bool v = kl + 32 < lim; k1v[r] = v ? -sp : 0.f; p1[r] = v ? z - sp : NEG; }
            }
            float R = carry;
#pragma unroll
            for (int kh = 1; kh >= 0; --kh)
#pragma unroll
                for (int c = 3; c >= 0; --c) { const f32x16& kk = kh ? k1v : k0v; f32x16& pp = kh ? p1 : p0;
                    const float G = (kk[4 * c] + kk[4 * c + 1]) + (kk[4 * c + 2] + kk[4 * c + 3]); const float PG = swap_get(G);
                    const float S = R + (hi ? 0.f : PG);
                    const float w2 = kk[4 * c + 3], w1 = w2 + kk[4 * c + 2], w0 = w1 + kk[4 * c + 1];
                    pp[4 * c + 3] = fexp2(pp[4 * c + 3] + S); pp[4 * c + 2] = fexp2(pp[4 * c + 2] + S + w2); pp[4 * c + 1] = fexp2(pp[4 * c + 1] + S + w1); pp[4 * c] = fexp2(pp[4 * c] + S + w0);
                    R += G + PG; }
            carry = R;
            { VFrag vf; vload(vf, lds + AT_V + slot * AT_SLOT, lane); AT_VWAIT(); pvmm(oT, vf, p0, p1); }
            wdone = __all(carry < -SB_THR) || (T == 0);
            if (wdone && lane == 0) flg[wid] = 1u;
        }
    }
    asm volatile("s_waitcnt vmcnt(0) lgkmcnt(0)\n\ts_barrier" ::: "memory");
    bf16_t* yo = YSB + (rowbase + t) * 512 + h * 64;
#pragma unroll
    for (int d0 = 0; d0 < 2; ++d0)
#pragma unroll
        for (int c = 0; c < 4; ++c) { u32x2 o; o.x = cvtpk(oT[d0][4 * c], oT[d0][4 * c + 1]); o.y = cvtpk(oT[d0][4 * c + 2], oT[d0][4 * c + 3]); *(u32x2*)(yo + d0 * 32 + 8 * c + 4 * hi) = o; }
    asm volatile("s_waitcnt lgkmcnt(0)\n\ts_barrier" ::: "memory");
}

__device__ __forceinline__ void compress_wave(int witem, const bf16_t* src, const bf16_t* wt1, const bf16_t* w2t, const float* c1, bf16_t* out, int lane) {
    const int rb = witem & 15, bg = witem >> 4, b = bg >> 1, g = bg & 1, hi = lane >> 5, li = lane & 31;
    const int i = rb * 32 + li;
    const bool valid = i < NCMP;
    const bf16_t* xrow = src + ((size_t)b * SEQ + 16 * (valid ? i : 0)) * 128 + g * 64;
    f32x16 hT[2];
#pragma unroll
    for (int r = 0; r < 16; ++r) { hT[0][r] = 0.f; hT[1][r] = 0.f; }
#pragma unroll 4
    for (int s = 0; s < 128; ++s) {
        const int k = 16 * s + 8 * hi;
        const bf16x8 xb = *(const bf16x8*)(xrow + (size_t)(k >> 6) * 128 + (k & 63));
        const bf16x8 a0 = *(const bf16x8*)(wt1 + (size_t)li * 2048 + k), a1 = *(const bf16x8*)(wt1 + (size_t)(32 + li) * 2048 + k);
        hT[0] = __builtin_amdgcn_mfma_f32_32x32x16_bf16(a0, xb, hT[0], 0, 0, 0);
        hT[1] = __builtin_amdgcn_mfma_f32_32x32x16_bf16(a1, xb, hT[1], 0, 0, 0);
    }
    bf16x8 hb[4];
#pragma unroll
    for (int nb = 0; nb < 2; ++nb)
#pragma unroll
        for (int sh = 0; sh < 2; ++sh) { float v[8];
#pragma unroll
            for (int j = 0; j < 8; ++j) { const int r = 8 * sh + j; const float a = hT[nb][r] + c1[32 * nb + crow(r, hi)];
                const float c = 0.7978845608028654f * (a + 0.044715f * a * a * a); const float e = __expf(2.f * c); const float th = 1.f - 2.f / (e + 1.f); v[j] = 0.5f * a * (1.f + th); }
            u32x4 w; w.x = cvtpk(v[0], v[1]); w.y = cvtpk(v[2], v[3]); w.z = cvtpk(v[4], v[5]); w.w = cvtpk(v[6], v[7]); hb[nb * 2 + sh] = __builtin_bit_cast(bf16x8, w); }
    f32x16 oT[2];
#pragma unroll
    for (int r = 0; r < 16; ++r) { oT[0][r] = 0.f; oT[1][r] = 0.f; }
#pragma unroll
    for (int mb = 0; mb < 2; ++mb)
#pragma unroll
        for (int ks = 0; ks < 4; ++ks) {
            const bf16_t* wp = w2t + (size_t)(32 * mb + li) * 64 + 16 * ks + 4 * hi;
            const u32x2 lo = *(const u32x2*)wp, hh = *(const u32x2*)(wp + 8);
            const u32x4 w = {lo.x, lo.y, hh.x, hh.y};
            oT[mb] = __builtin_amdgcn_mfma_f32_32x32x16_bf16(__builtin_bit_cast(bf16x8, w), hb[ks], oT[mb], 0, 0, 0);
        }
    bf16_t* op = out + ((size_t)bg * 512 + i) * 64;
#pragma unroll
    for (int mb = 0; mb < 2; ++mb)
#pragma unroll
        for (int c = 0; c < 4; ++c) { u32x2 o; o.x = valid ? cvtpk(oT[mb][4 * c], oT[mb][4 * c + 1]) : 0u; o.y = valid ? cvtpk(oT[mb][4 * c + 2], oT[mb][4 * c + 3]) : 0u;
            *(u32x2*)(op + 32 * mb + 8 * c + 4 * hi) = o; }
}

struct AttnArgs { const bf16_t* sbq; const bf16_t* sbk; const bf16_t* sbv; const bf16_t* nq; const bf16_t* kv6; const float* ng; bf16_t* kcmp; bf16_t* vcmp;
                  bf16_t* ysb; bf16_t* ynsa; float* ypart; const bf16_t* wt1k; const bf16_t* wt1v; const bf16_t* w2tk; const bf16_t* w2tv; const float* c1k; const float* c1v; int* qhead; };
__device__ __forceinline__ void attn_phase1(const AttnArgs& a, LAS unsigned char* lds) {
    const size_t S128 = (size_t)NTOK * 128; const int lane = threadIdx.x & 63, wid = __builtin_amdgcn_readfirstlane(threadIdx.x >> 6);
    for (;;) { const int it = next_item(a.qhead, lds); if (it >= 64) break;
        const int w = it * 8 + wid;
        if (w < 256) compress_wave(w, a.kv6 + 0 * S128, a.wt1k, a.w2tk, a.c1k, a.kcmp, lane); else compress_wave(w - 256, a.kv6 + 1 * S128, a.wt1v, a.w2tv, a.c1v, a.vcmp, lane);
        asm volatile("s_waitcnt vmcnt(0)" ::: "memory"); __syncthreads();
        if (threadIdx.x == 0) { __builtin_amdgcn_fence(__ATOMIC_RELEASE, "agent"); asm volatile("s_waitcnt vmcnt(0)" ::: "memory");
            (void)__hip_atomic_fetch_add((gu32*)(a.qhead + 48), 1u, __ATOMIC_RELAXED, __HIP_MEMORY_SCOPE_AGENT); } }
#ifndef REP_SB
#define REP_SB 1
#endif
#ifndef REP_WIN
#define REP_WIN 1
#endif
    for (int rs = 0; rs < REP_SB; ++rs) { int* h = a.qhead + 16 + 8 * rs; int cur = next_item(h, lds); while (cur < 2048) { QPREFETCH(h); sb_item(cur, a.sbq, a.sbk, a.sbv, a.ysb, lds); QADVANCE(cur, lds); } }
}
__device__ __forceinline__ void attn_phase2(const AttnArgs& a, LAS unsigned char* lds, int xcc) {
    const size_t S128 = (size_t)NTOK * 128;
    if (threadIdx.x == 0) { gu32* cd = (gu32*)(a.qhead + 48);
        for (unsigned sp = 0; __hip_atomic_load(cd, __ATOMIC_RELAXED, __HIP_MEMORY_SCOPE_AGENT) < 64u && sp < (1u << 24); ++sp) __builtin_amdgcn_s_sleep(2);
        __builtin_amdgcn_fence(__ATOMIC_ACQUIRE, "agent"); asm volatile("s_waitcnt vmcnt(0)" ::: "memory"); }
    __syncthreads();
#ifdef PROBE_ITEM
    int nitem_ = 0;
#endif
    for (int pass = 0; pass < 8; ++pass) {
        const int x = (xcc + pass) & 7;
        int* h = a.qhead + 64 + 16 * x; int it = next_item(h, lds);
        while (it < 256) {
            QPREFETCH(h);
            const int qbi = it >> 1, bg = 2 * x + (it & 1);
#ifdef PROBE_ITEM
            unsigned long long* ist = (blockIdx.x == PROBE_BLOCK && nitem_ == PROBE_ITEM) ? (unsigned long long*)(a.qhead - CT_Q + 2048) + 16 : nullptr; ++nitem_;
            cmpsel_item((bg << 7) | qbi, a.nq, a.kcmp, a.vcmp, a.kv6 + 2 * S128, a.kv6 + 3 * S128, a.kv6 + 4 * S128, a.kv6 + 5 * S128, a.ng, a.ypart, a.ynsa, lds, ist);
#else
            cmpsel_item((bg << 7) | qbi, a.nq, a.kcmp, a.vcmp, a.kv6 + 2 * S128, a.kv6 + 3 * S128, a.kv6 + 4 * S128, a.kv6 + 5 * S128, a.ng, a.ypart, a.ynsa, lds);
#endif
            QADVANCE(it, lds);
        }
    }
}
typedef float f32x4v __attribute__((ext_vector_type(4)));
__device__ __forceinline__ void router_phase(const float* U, const f32x2* stats, const float* g1, const float* b1, const float* wr, const float* br, f32x2* MR, bf16_t* H1B,
                                             int* cnt, int* list, float* topw, int* tope, int* spos, LAS unsigned char* lds, int vcu, int G) {
    const int tid = threadIdx.x, lane = tid & 63, wave = __builtin_amdgcn_readfirstlane(tid >> 6), r = lane & 15, kq = lane >> 4;
    LAS float* W = (LAS float*)lds;
    LAS float* stg = (LAS float*)(lds + 131072 + wave * 2048);
    LAS int* stB = (LAS int*)(lds + 147456);
    LAS float* G1L = (LAS float*)(lds + 151552); LAS float* B1L = (LAS float*)(lds + 155904);
    LAS int* hist = (LAS int*)(lds + 155648); LAS int* basee = hist + 32;
    if (tid < 32) hist[tid] = 0;
    if (tid < 256) { *(LAS f32x4*)(G1L + tid * 4) = *(const f32x4*)(g1 + tid * 4); *(LAS f32x4*)(B1L + tid * 4) = *(const f32x4*)(b1 + tid * 4); }
    for (int i = tid; i < 1024 * 8; i += NTHREADS) { const int k = i >> 3, c4 = (i & 7) * 4; const f32x4 v = *(const f32x4*)(wr + k * 32 + c4);
        *(LAS f32x4*)(W + k * 32 + (c4 ^ (((k >> 3) & 1) << 4))) = v; }
    __syncthreads();
    const int sw = (kq & 1) << 4;
    for (int gbase = 0; gbase < NTOK / 16; gbase += 2 * G * NWAVES) {
    if (tid < 32) hist[tid] = 0;
    __syncthreads();
    int gi = 0;
    for (int grp = gbase + vcu * NWAVES + wave; grp < NTOK / 16 && gi < 2; grp += G * NWAVES, ++gi) {
        const int tok = grp * 16 + r; const float* up = U + (size_t)tok * DM + 8 * kq;
        float s = 0.f, s2 = 0.f;
        { const f32x4 q0 = *(const f32x4*)(stats + (size_t)tok * 16 + 4 * kq), q1 = *(const f32x4*)(stats + (size_t)tok * 16 + 4 * kq + 2);
          s = (q0[0] + q0[2]) + (q1[0] + q1[2]); s2 = (q0[1] + q0[3]) + (q1[1] + q1[3]); }
        s += __shfl_xor(s, 16); s += __shfl_xor(s, 32); s2 += __shfl_xor(s2, 16); s2 += __shfl_xor(s2, 32);
        const float mean = s * (1.f / DM); const float var = fmaxf(s2 * (1.f / DM) - mean * mean, 0.f); const float rstd = 1.f / sqrtf(var + LN_EPS);
        f32x4v acc0 = {0.f, 0.f, 0.f, 0.f}, acc1 = {0.f, 0.f, 0.f, 0.f};
        if (kq == 0) MR[tok] = (f32x2){mean, rstd};
        f32x4 ra[4], rb[4];
#pragma unroll
        for (int i = 0; i < 4; ++i) { ra[i] = *(const f32x4*)(up + 32 * i); rb[i] = *(const f32x4*)(up + 32 * i + 4); }
#pragma unroll 1
        for (int s4 = 0; s4 < 32; s4 += 4) {
#pragma unroll
        for (int u4 = 0; u4 < 4; ++u4) {
            const int st = s4 + u4, k0 = 32 * st + 8 * kq;
            const f32x4 a = ra[u4], b = rb[u4];
            { const int sn = (s4 < 28) ? st + 4 : st;
              ra[u4] = *(const f32x4*)(up + 32 * sn); rb[u4] = *(const f32x4*)(up + 32 * sn + 4); }
            const f32x4 ga = *(const LAS f32x4*)(G1L + k0), gb = *(const LAS f32x4*)(G1L + k0 + 4), ba = *(const LAS f32x4*)(B1L + k0), bb = *(const LAS f32x4*)(B1L + k0 + 4);
            const f32x4 ha = (a - mean) * rstd * ga + ba, hb = (b - mean) * rstd * gb + bb;
            u32x4 w; w.x = pk2(ha[0], ha[1]); w.y = pk2(ha[2], ha[3]); w.z = pk2(hb[0], hb[1]); w.w = pk2(hb[2], hb[3]);
            *(u32x4*)(H1B + (size_t)tok * DM + k0) = w;
            const LAS float* wp = W + k0 * 32;
#pragma unroll
            for (int j = 0; j < 8; ++j) { const float hv = (j < 4) ? ha[j & 3] : hb[j & 3];
                const float w0 = wp[j * 32 + (r ^ sw)], w1 = wp[j * 32 + ((r + 16) ^ sw)];
                acc0 = __builtin_amdgcn_mfma_f32_16x16x4f32(hv, w0, acc0, 0, 0, 0); acc1 = __builtin_amdgcn_mfma_f32_16x16x4f32(hv, w1, acc1, 0, 0, 0); }
        }
        }
        const float bi0 = br[r], bi1 = br[16 + r];
#pragma unroll
        for (int q = 0; q < 4; ++q) { stg[(4 * kq + q) * 32 + r] = acc0[q] + bi0; stg[(4 * kq + q) * 32 + 16 + r] = acc1[q] + bi1; }
        asm volatile("s_waitcnt lgkmcnt(0)" ::: "memory");
        if (lane < 16) {
            float v[32];
#pragma unroll
            for (int e = 0; e < 32; e += 4) { const f32x4 x = *(const LAS f32x4*)(stg + lane * 32 + e); v[e] = x[0]; v[e + 1] = x[1]; v[e + 2] = x[2]; v[e + 3] = x[3]; }
            float tv[4]; int ti[4];
#pragma unroll
            for (int k = 0; k < 4; ++k) { float bv = -INFINITY; int bi = 0;
#pragma unroll
                for (int e = 0; e < 32; ++e) { if (v[e] > bv) { bv = v[e]; bi = e; } }
                tv[k] = bv; ti[k] = bi;
#pragma unroll
                for (int e = 0; e < 32; ++e) if (e == bi) v[e] = -INFINITY; }
            const float e1 = expf(tv[1] - tv[0]), e2 = expf(tv[2] - tv[0]), e3 = expf(tv[3] - tv[0]); const float inv = 1.f / (1.f + e1 + e2 + e3);
            const float wv[4] = {inv, e1 * inv, e2 * inv, e3 * inv};
            const int tk = grp * 16 + lane;
#pragma unroll
            for (int k = 0; k < 4; ++k) { const int slot = tk * 4 + k; topw[slot] = wv[k]; tope[slot] = ti[k];
                const int lp = __hip_atomic_fetch_add(&hist[ti[k]], 1, __ATOMIC_RELAXED, __HIP_MEMORY_SCOPE_WORKGROUP);
                const int si = (gi * NWAVES + wave) * 64 + lane * 4 + k; stB[si] = (ti[k] << 20) | lp; }
        }
        asm volatile("s_waitcnt lgkmcnt(0)" ::: "memory");
    }
    __syncthreads();
    if (tid < 32) basee[tid] = atomicAdd(&cnt[tid], hist[tid]);
    __syncthreads();
    for (int si = tid; si < 1024; si += NTHREADS) { const int g2 = si >> 9, w2 = (si >> 6) & 7; const int grp = gbase + vcu * NWAVES + w2 + g2 * G * NWAVES;
        if (grp < NTOK / 16) { const int slot = (grp * 16 + ((si >> 2) & 15)) * 4 + (si & 3), pk = stB[si], e = pk >> 20, pos = basee[e] + (pk & 0xfffff); list[(size_t)e * NTOK + pos] = slot; spos[slot] = pos; } }
    __syncthreads();
    }
}
#include <hip/hip_cooperative_groups.h>
namespace cg = cooperative_groups;
struct MegaArgs {
    const float* pe_k; const float* w1_k; const float* w2_k; const float* pe_v; const float* w1_v; const float* w2_v;
    const float* x; const float* w_in; const float* w_sb; const float* w_nsa; const float* w_out; const float* w_gu; const float* w_dn;
    const float* b_gu; const float* b_dn; const float* ln1g; const float* ln1b; const float* w_r; const float* b_r; const float* ln2g; const float* ln2b;
    float* out; unsigned char* ws; int ph_lo, ph_hi;
};
__device__ __forceinline__ void combine_phase(const MegaArgs& A, LAS unsigned char* lds, int round, bool last, int vcu, int G, float oscale) {
    unsigned char* ws = A.ws; float* Y = A.out; const bf16_t* outr0 = (const bf16_t*)(ws + WS_OUTR0); const bf16_t* outr1 = (const bf16_t*)(ws + WS_OUTR1);
    const int* tope = (const int*)(ws + WS_TOPE); const int* spos = (const int*)(ws + WS_SPOS); const float* topw = (const float*)(ws + WS_TOPW);
    const LAS int* tstart = (const LAS int*)(lds + LDS_MISC);
    const int tid = threadIdx.x, lane = tid & 63, wave = tid >> 6;
    constexpr int TU = 4;
    const f32x2* mrp = (const f32x2*)(ws + WS_MR);
    LAS float* G1A = (LAS float*)lds; LAS float* B1A = G1A + DM; LAS float* G2A = B1A + DM; LAS float* B2A = G2A + DM;
    __syncthreads();
    { int tl = threadIdx.x; asm volatile("" : "+v"(tl));
      for (int i = tl; i < DM; i += NTHREADS) { G1A[i] = A.ln1g[i] * ALPHA; B1A[i] = A.ln1b[i] * ALPHA; G2A[i] = A.ln2g[i]; B2A[i] = A.ln2b[i]; } }
    __syncthreads();
    for (int tok0 = (vcu * NWAVES + wave) * TU; tok0 < NTOK; tok0 += G * NWAVES * TU) {
        int4 ev[TU], pv_[TU]; f32x4 wv[TU];
#pragma unroll
        for (int u = 0; u < TU; ++u) { const int tok = tok0 + u; ev[u] = *(const int4*)(tope + tok * 4); pv_[u] = *(const int4*)(spos + tok * 4); wv[u] = *(const f32x4*)(topw + tok * 4); }
        f32x4 v[TU][2][2]; f32x2 mr[TU];
#pragma unroll
        for (int u = 0; u < TU; ++u) { const float* yr = Y + (size_t)(tok0 + u) * DM + lane * 8; mr[u] = mrp[tok0 + u];
#pragma unroll
            for (int j = 0; j < 2; ++j) { v[u][j][0] = *(const f32x4*)(yr + 512 * j); v[u][j][1] = *(const f32x4*)(yr + 512 * j + 4); } }
#pragma unroll
        for (int u = 0; u < TU; ++u)
#pragma unroll
            for (int j = 0; j < 2; ++j)
#pragma unroll
                for (int h = 0; h < 2; ++h) { const int c = lane * 8 + 512 * j + 4 * h; v[u][j][h] = (v[u][j][h] - mr[u].x) * mr[u].y * *(const LAS f32x4*)(G1A + c) + *(const LAS f32x4*)(B1A + c); }
        bool any[TU];
#pragma unroll
        for (int u = 0; u < TU; ++u) { any[u] = false;
            const int es[4] = {ev[u].x, ev[u].y, ev[u].z, ev[u].w}; const int ps[4] = {pv_[u].x, pv_[u].y, pv_[u].z, pv_[u].w};
#pragma unroll
            for (int k = 0; k < 4; ++k) {
                const int tile = tstart[es[k]] + (ps[k] >> 8);
                { any[u] = true; const float w = wv[u][k]; const int rnd = tile >= TR ? 1 : 0; const bf16_t* rp = (rnd ? outr1 : outr0) + ((size_t)(tile - rnd * TR) * 256 + (ps[k] & 255)) * DM + lane * 8;
#pragma unroll
                    for (int j = 0; j < 2; ++j) { const u32x4 q = *(const u32x4*)(rp + 512 * j);
                        v[u][j][0][0] += w * bflo(q.x); v[u][j][0][1] += w * bfhi(q.x); v[u][j][0][2] += w * bflo(q.y); v[u][j][0][3] += w * bfhi(q.y);
                        v[u][j][1][0] += w * bflo(q.z); v[u][j][1][1] += w * bfhi(q.z); v[u][j][1][2] += w * bflo(q.w); v[u][j][1][3] += w * bfhi(q.w); } }
            }
            if (u == 1) asm volatile("" ::: "memory");
        }
#pragma unroll
        for (int u = 0; u < TU; ++u) { float* yr = Y + (size_t)(tok0 + u) * DM + lane * 8;
            if (last) {
                float s = 0.f;
#pragma unroll
                for (int j = 0; j < 2; ++j) s += (v[u][j][0][0] + v[u][j][0][1]) + (v[u][j][0][2] + v[u][j][0][3]) + (v[u][j][1][0] + v[u][j][1][1]) + (v[u][j][1][2] + v[u][j][1][3]);
                const float mean = wave_sum(s) * (1.f / DM); float s2 = 0.f;
#pragma unroll
                for (int j = 0; j < 2; ++j) { v[u][j][0] = v[u][j][0] - mean; v[u][j][1] = v[u][j][1] - mean;
                    s2 += (v[u][j][0][0] * v[u][j][0][0] + v[u][j][0][1] * v[u][j][0][1]) + (v[u][j][0][2] * v[u][j][0][2] + v[u][j][0][3] * v[u][j][0][3]) + (v[u][j][1][0] * v[u][j][1][0] + v[u][j][1][1] * v[u][j][1][1]) + (v[u][j][1][2] * v[u][j][1][2] + v[u][j][1][3] * v[u][j][1][3]); }
                const float rstd = 1.f / sqrtf(wave_sum(s2) * (1.f / DM) + LN_EPS);
#pragma unroll
                for (int j = 0; j < 2; ++j) { const int c = lane * 8 + 512 * j;
                    *(f32x4*)(yr + 512 * j) = (v[u][j][0] * rstd * *(const LAS f32x4*)(G2A + c) + *(const LAS f32x4*)(B2A + c)) * oscale;
                    *(f32x4*)(yr + 512 * j + 4) = (v[u][j][1] * rstd * *(const LAS f32x4*)(G2A + c + 4) + *(const LAS f32x4*)(B2A + c + 4)) * oscale; }
            } else if (any[u]) {
#pragma unroll
                for (int j = 0; j < 2; ++j) { *(f32x4*)(yr + 512 * j) = v[u][j][0]; *(f32x4*)(yr + 512 * j + 4) = v[u][j][1]; }
            }
        }
    }
}
#ifndef REP_ROUTER
#define REP_ROUTER 1
#endif
#ifndef REP_PREP
#define REP_PREP 1
#endif
#ifndef REP_INPROJ
#define REP_INPROJ 1
#endif
#ifndef REP_MERGE
#define REP_MERGE 1
#endif
#ifndef REP_OUT
#define REP_OUT 1
#endif
#ifndef REP_GU
#define REP_GU 1
#endif
#ifndef REP_DN
#define REP_DN 1
#endif
#ifndef REP_ATT1
#define REP_ATT1 1
#endif
#ifndef REP_ATT2
#define REP_ATT2 1
#endif
enum { PH_PREP = 0, PH_INPROJ, PH_ATT1, PH_ATT2, PH_MERGE, PH_OUT, PH_ROUTER, PH_GU0, PH_DN0, PH_GU1, PH_DN1, PH_FIN, PH_N };
__global__ void __launch_bounds__(NTHREADS, 2) k_mega(MegaArgs A) {
    extern __shared__ __attribute__((aligned(16))) unsigned char lds_[];
    LAS unsigned char* lds = (LAS unsigned char*)lds_;
    cg::grid_group grid = cg::this_grid();
    if (threadIdx.x < 8) ((LAS unsigned*)(lds + LDS_BYTES - 64))[threadIdx.x] = 0u;
    __syncthreads();
    XcdBarrier bar = xcd_barrier_post((unsigned*)(A.ws + WS_CTL) + CT_BAR, (volatile LAS unsigned*)(lds + LDS_BYTES - 64));
    const int G = gridDim.x, bx = blockIdx.x; const int vcu = (G % 8 == 0) ? (bx % 8) * (G / 8) + bx / 8 : bx;
    unsigned char* ws = A.ws;
    int* ctl = (int*)(ws + WS_CTL); float* ropeT = (float*)(ws + WS_ROPE);
    bf16_t* wt_gu = (bf16_t*)(ws + WS_WGU); bf16_t* wt_dn = (bf16_t*)(ws + WS_WDN); bf16_t* wt_in = (bf16_t*)(ws + WS_WIN);
    bf16_t* wt_sb = (bf16_t*)(ws + WS_WSB); bf16_t* wt_nsa = (bf16_t*)(ws + WS_WNSA); bf16_t* wt_out = (bf16_t*)(ws + WS_WOUT);
    bf16_t* xb = (bf16_t*)(ws + WS_XB); bf16_t* sbq = (bf16_t*)(ws + WS_SBQ); bf16_t* sbk = (bf16_t*)(ws + WS_SBK); bf16_t* sbv = (bf16_t*)(ws + WS_SBV);
    bf16_t* nq = (bf16_t*)(ws + WS_NQ); bf16_t* kv6 = (bf16_t*)(ws + WS_KV6); float* ng = (float*)(ws + WS_NG);
    bf16_t* ysb = (bf16_t*)(ws + WS_YSB); bf16_t* ynsa = (bf16_t*)(ws + WS_YNSA);
    bf16_t* mg = (bf16_t*)A.out; bf16_t* merged = (bf16_t*)(ws + WS_MERGED); float* u = A.out; bf16_t* h1b = (bf16_t*)(ws + WS_H1B);
    int* list = (int*)(ws + WS_LIST); bf16_t* hid = (bf16_t*)(ws + WS_HID); bf16_t* outr0 = (bf16_t*)(ws + WS_OUTR0); bf16_t* outr1 = (bf16_t*)(ws + WS_OUTR1);
    const int lo = A.ph_lo, hi = A.ph_hi;
#define IN(k) (lo <= (k) && (k) < hi)
#ifdef PROBE_PHASE
#define STAMP(i) do { if (blockIdx.x == 0 && threadIdx.x == 0) ((unsigned long long*)(ctl + 2048))[i] = __builtin_amdgcn_s_memrealtime(); } while (0)
#else
#define STAMP(i) do { } while (0)
#endif
#define SEAM(k) do { if (IN(k) && IN((k) + 1)) { if ((k) == PH_PREP) grid.sync(); else xcd_barrier(bar); } STAMP((k) + 1); } while (0)
    STAMP(0);
    if (IN(PH_PREP)) {
        PrepArgs a{A.x, A.w_in, A.w_sb, A.w_nsa, A.w_out, A.w_gu, A.w_dn, wt_in, wt_sb, wt_nsa, wt_out, wt_gu, wt_dn, xb, ng, ropeT, A.pe_k, A.w1_k, A.w2_k, A.pe_v, A.w1_v, A.w2_v, ws + WS_CMPW, (float*)(ctl + CT_C1)};
        for (int rep = 0; rep < REP_PREP; ++rep) { if (rep) grid.sync(); prep_phase(a, lds, vcu, G); }
    }
    SEAM(PH_PREP);
    if (IN(PH_INPROJ)) {
        EpiInProj E{sbq, sbk, sbv, nq, kv6, mg, ropeT, ropeT + SEQ * 32};
        pg8::Gemm g{xb, wt_in, DM, 0}; pg8::StaticOrder S; S.init(NTOK, 4864, G, bx);
        for (int rep = 0; rep < REP_INPROJ; ++rep) { if (rep) grid.sync(); pg8::gemm_phase<EpiInProj, pg8::StaticOrder, true, false>(lds, g, S, E); }
    }
    SEAM(PH_INPROJ);
    const AttnArgs AA{sbq, sbk, sbv, nq, kv6, ng, (bf16_t*)(ws + WS_KCMP), (bf16_t*)(ws + WS_VCMP), ysb, ynsa, (float*)(ws + WS_YPART),
                      (const bf16_t*)(ws + WS_CMPW + CW_WT1K), (const bf16_t*)(ws + WS_CMPW + CW_WT1V), (const bf16_t*)(ws + WS_CMPW + CW_W2TK), (const bf16_t*)(ws + WS_CMPW + CW_W2TV),
                      (const float*)(ctl + CT_C1), (const float*)(ctl + CT_C1 + 64), ctl + CT_Q};
    if (IN(PH_ATT1)) for (int rep = 0; rep < REP_ATT1; ++rep) { if (rep) grid.sync(); AttnArgs A1 = AA; A1.qhead = ctl + CT_Q + 256 * rep; attn_phase1(A1, lds); }
    STAMP(PH_ATT1 + 1);
    if (IN(PH_ATT2)) for (int rep = 0; rep < REP_ATT2; ++rep) { if (rep) grid.sync(); AttnArgs A2 = AA; A2.qhead = ctl + CT_Q + 256 * rep; attn_phase2(A2, lds, (int)bar.x & 7); }
    SEAM(PH_ATT2);
    if (IN(PH_MERGE)) for (int rep = 0; rep < REP_MERGE; ++rep) {
        if (rep) grid.sync();
        pg8::StaticOrder S; S.init(NTOK, DM, G, bx);
        { pg8::Gemm g{ysb, wt_sb, 512, 0}; EpiMerge E0{mg, merged, 0, 0}; pg8::gemm_phase<EpiMerge, pg8::StaticOrder, true, false>(lds, g, S, E0); }
        asm volatile("s_waitcnt vmcnt(0)" ::: "memory"); __syncthreads();
        { pg8::Gemm g{ynsa, wt_nsa, 512, 0}; EpiMerge E1{mg, merged, 1, 0}; pg8::gemm_phase<EpiMerge, pg8::StaticOrder, true, false>(lds, g, S, E1); }
    }
    SEAM(PH_MERGE);
    if (IN(PH_OUT)) {
        EpiOut E{A.x, u, (f32x2*)(ws + WS_STATS)}; pg8::Gemm g{merged, wt_out, DM, 0}; pg8::StaticOrder S; S.init(NTOK, DM, G, bx);
        for (int rep = 0; rep < REP_OUT; ++rep) { if (rep) grid.sync(); pg8::gemm_phase<EpiOut, pg8::StaticOrder, true, false>(lds, g, S, E); }
    }
    SEAM(PH_OUT);
    if (IN(PH_ROUTER)) for (int rep = 0; rep < REP_ROUTER; ++rep) { if (rep) grid.sync(); router_phase(u, (const f32x2*)(ws + WS_STATS), A.ln1g, A.ln1b, A.w_r, A.b_r, (f32x2*)(ws + WS_MR), h1b, ctl + (rep == REP_ROUTER - 1 ? CT_CNT : 32), list, (float*)(ws + WS_TOPW), (int*)(ws + WS_TOPE), (int*)(ws + WS_SPOS), lds, vcu, G); }
    SEAM(PH_ROUTER);
    if (hi > PH_GU0) { __syncthreads(); moe_build_table(lds, ctl + CT_CNT); }
    if (IN(PH_GU0)) { EpiGateUp E{A.b_gu, hid}; pg8::Gemm g{h1b, wt_gu, DM, 0}; MoeOrder<8> S; S.init(lds, list, 0, G, bx); for (int rep = 0; rep < REP_GU; ++rep) { if (rep) grid.sync(); pg8::gemm_phase<EpiGateUp, MoeOrder<8>, true, true>(lds, g, S, E); } }
    SEAM(PH_GU0);
    if (IN(PH_DN0)) { EpiDown E{A.b_dn, outr0}; pg8::Gemm g{hid, wt_dn, DFF, 0}; MoeOrder<4> S; S.init(lds, list, 0, G, bx); for (int rep = 0; rep < REP_DN; ++rep) { if (rep) grid.sync(); pg8::gemm_phase<EpiDown, MoeOrder<4>, true, false>(lds, g, S, E); } }
    SEAM(PH_DN0);
    if (IN(PH_GU1)) {
        { EpiGateUp E{A.b_gu, hid}; pg8::Gemm g{h1b, wt_gu, DM, 0}; MoeOrder<8> S; S.init(lds, list, 1, G, bx); for (int rep = 0; rep < 1; ++rep) { if (rep) grid.sync(); pg8::gemm_phase<EpiGateUp, MoeOrder<8>, true, true>(lds, g, S, E); } }
    }
    SEAM(PH_GU1);
    if (IN(PH_DN1)) { EpiDown E{A.b_dn, outr1}; pg8::Gemm g{hid, wt_dn, DFF, 0}; MoeOrder<4> S; S.init(lds, list, 1, G, bx); for (int rep = 0; rep < 1; ++rep) { if (rep) grid.sync(); pg8::gemm_phase<EpiDown, MoeOrder<4>, true, false>(lds, g, S, E); } }
    SEAM(PH_DN1);
#ifdef PROBE_PHASE
    if (IN(PH_FIN)) combine_phase(A, lds, 1, true, vcu, G, 1.f);
    xcd_barrier(bar); STAMP(12);
    xcd_barrier(bar);
    { const unsigned long long* ts = (const unsigned long long*)(ctl + 2048); const float dt = (float)(__hip_atomic_load(ts + PROBE_END, __ATOMIC_RELAXED, __HIP_MEMORY_SCOPE_AGENT) - __hip_atomic_load(ts + PROBE_PHASE, __ATOMIC_RELAXED, __HIP_MEMORY_SCOPE_AGENT));
      const float dtq = floorf(dt / PROBE_QUANT + PROBE_QOFF) * PROBE_QUANT; const float sc = 1.f + sqrtf(dtq * PROBE_K);
      for (size_t i = (size_t)bx * NTHREADS + threadIdx.x; i < (size_t)NTOK * DM / 4; i += (size_t)G * NTHREADS) { f32x4 v = ((f32x4*)A.out)[i]; ((f32x4*)A.out)[i] = v * sc; } }
#else
    if (IN(PH_FIN)) combine_phase(A, lds, 1, true, vcu, G, 1.f);
#endif
#undef IN
#undef SEAM
}

extern "C" void kernel_launch(void* const* d_in, const int* in_sizes, int n_in, void* d_out, int out_size, void* d_ws, size_t ws_size, hipStream_t stream) {
    const float* x = (const float*)d_in[0]; const float* w_in = (const float*)d_in[1];
    const float* pe_k = (const float*)d_in[2]; const float* w1_k = (const float*)d_in[3]; const float* w2_k = (const float*)d_in[4];
    const float* pe_v = (const float*)d_in[5]; const float* w1_v = (const float*)d_in[6]; const float* w2_v = (const float*)d_in[7];
    char* ws = (char*)d_ws; float* out = (float*)d_out;
    static int grid = 0;
    if (grid == 0) {
        int dev = 0, cus = 0, per_cu = 0; (void)hipGetDevice(&dev); (void)hipDeviceGetAttribute(&cus, hipDeviceAttributeMultiprocessorCount, dev);
        (void)hipFuncSetAttribute((const void*)k_mega, hipFuncAttributeMaxDynamicSharedMemorySize, LDS_BYTES);
        (void)hipOccupancyMaxActiveBlocksPerMultiprocessor(&per_cu, (const void*)k_mega, NTHREADS, LDS_BYTES);
        if (per_cu < 1) per_cu = 1;
        grid = (cus > 0 ? cus : 256) * 1;
        (void)hipGetLastError();
    }
    MegaArgs A{};
    A.pe_k = pe_k; A.w1_k = w1_k; A.w2_k = w2_k; A.pe_v = pe_v; A.w1_v = w1_v; A.w2_v = w2_v;
    A.x = x; A.w_in = w_in; A.w_sb = (const float*)d_in[8]; A.w_nsa = (const float*)d_in[9]; A.w_out = (const float*)d_in[10];
    A.ln1g = (const float*)d_in[11]; A.ln1b = (const float*)d_in[12]; A.w_r = (const float*)d_in[13]; A.b_r = (const float*)d_in[14];
    A.w_gu = (const float*)d_in[15]; A.b_gu = (const float*)d_in[16]; A.w_dn = (const float*)d_in[17]; A.b_dn = (const float*)d_in[18];
    A.ln2g = (const float*)d_in[19]; A.ln2b = (const float*)d_in[20]; A.out = out; A.ws = (unsigned char*)d_ws;
    int* ctl = (int*)(ws + WS_CTL);
    bf16_t* sbq = (bf16_t*)(ws + WS_SBQ); bf16_t* sbk = (bf16_t*)(ws + WS_SBK); bf16_t* sbv = (bf16_t*)(ws + WS_SBV);
    bf16_t* nq = (bf16_t*)(ws + WS_NQ); bf16_t* kv6 = (bf16_t*)(ws + WS_KV6); float* ng = (float*)(ws + WS_NG);
    bf16_t* kcmp = (bf16_t*)(ws + WS_KCMP); bf16_t* vcmp = (bf16_t*)(ws + WS_VCMP);
    bf16_t* ysb = (bf16_t*)(ws + WS_YSB); bf16_t* ynsa = (bf16_t*)(ws + WS_YNSA);
    float* u = (float*)(ws + WS_U); bf16_t* h1b = (bf16_t*)(ws + WS_H1B);
    int* tope = (int*)(ws + WS_TOPE); float* topw = (float*)(ws + WS_TOPW); int* spos = (int*)(ws + WS_SPOS); int* list = (int*)(ws + WS_LIST);
    const size_t S128 = (size_t)NTOK * 128;
    auto launch = [&](int lo, int hi) { A.ph_lo = lo; A.ph_hi = hi; void* args[] = {&A};
        (void)hipLaunchCooperativeKernel((const void*)k_mega, dim3(grid), dim3(NTHREADS), args, LDS_BYTES, stream); };
    (void)hipMemsetAsync(ctl, 0, 1 * MiB, stream);
    launch(PH_PREP, PH_N);
}
```

```cpp
#include <hip/hip_runtime.h>
#include <stdint.h>
#include <math.h>
constexpr int NB = 8, SEQ = 8192, DM = 1024, NTOK = NB * SEQ;
constexpr int IN_W = 4888;
constexpr int C_NG = 2816, C_MG = 2840;
constexpr int NEXP = 32, TOPK = 4, DFF = 1024;
constexpr int NCMP = 511;
constexpr float ALPHA = 1.189207115002721f;
constexpr float LN_EPS = 1e-5f;
constexpr float LOG2E = 1.4426950408889634f;
constexpr float C2 = 0.125f * LOG2E;
constexpr int NTILE_MAX = NTOK * TOPK / 256 + NEXP;
constexpr int NROUND = 2, TR = 512, TR1MAX = NTILE_MAX - TR;
constexpr int NWAVES = 8, NTHREADS = 512;

typedef float f32x16 __attribute__((ext_vector_type(16)));
typedef float f32x4 __attribute__((ext_vector_type(4)));
typedef float f32x2 __attribute__((ext_vector_type(2)));
typedef unsigned u32x4 __attribute__((ext_vector_type(4)));
typedef unsigned u32x2 __attribute__((ext_vector_type(2)));
typedef unsigned short bf16_t;
#define LAS __attribute__((address_space(3)))

__device__ __forceinline__ unsigned f2bf(float f) { unsigned u = __builtin_bit_cast(unsigned, f); return (u + 0x7fffu + ((u >> 16) & 1u)) >> 16; }
__device__ __forceinline__ unsigned pk2(float lo, float hi) { return f2bf(lo) | (f2bf(hi) << 16); }
__device__ __forceinline__ float bf2f(unsigned h) { return __builtin_bit_cast(float, h << 16); }
__device__ __forceinline__ float bflo(unsigned w) { return __builtin_bit_cast(float, w << 16); }
__device__ __forceinline__ float bfhi(unsigned w) { return __builtin_bit_cast(float, w & 0xffff0000u); }
__device__ __forceinline__ float sigmoidf_(float x) { return __builtin_amdgcn_rcpf(1.f + __expf(-x)); }
__device__ __forceinline__ float wave_sum(float v) {
#pragma unroll
    for (int o = 1; o < 64; o <<= 1) v += __shfl_xor(v, o);
    return v;
}

constexpr size_t MiB = 1u << 20;
constexpr size_t WS_CTL = 0;
constexpr size_t WS_ROPE = 1 * MiB;
constexpr size_t WS_WGU = 3 * MiB;
constexpr size_t WS_WDN = 131 * MiB;
constexpr size_t WS_WIN = 195 * MiB;
constexpr size_t WS_WSB = 205 * MiB;
constexpr size_t WS_WNSA = 206 * MiB;
constexpr size_t WS_WOUT = 207 * MiB;
constexpr size_t WS_CMPW = 209 * MiB;
constexpr size_t WS_XB = 210 * MiB;
constexpr size_t WS_SBQ = 338 * MiB, WS_SBK = 402 * MiB, WS_SBV = 466 * MiB, WS_NQ = 530 * MiB;
constexpr size_t WS_KV6 = 594 * MiB;
constexpr size_t WS_NG = 690 * MiB;
constexpr size_t WS_KCMP = 696 * MiB, WS_VCMP = 697 * MiB;
constexpr size_t WS_MASK = 698 * MiB;
constexpr size_t WS_YSB = 700 * MiB, WS_YNSA = 764 * MiB;
constexpr size_t WS_YPART = 828 * MiB;
constexpr size_t WS_MERGED = 210 * MiB;
constexpr size_t WS_U = 338 * MiB;
constexpr size_t WS_STATS = 1014 * MiB;
constexpr size_t WS_H1B = 594 * MiB;
constexpr size_t WS_TOPE = 1010 * MiB, WS_TOPW = 1011 * MiB, WS_SPOS = 1012 * MiB;
constexpr unsigned H1_PITCH_B = DM * 4;
constexpr size_t WS_MR = 1013 * MiB;
constexpr size_t WS_LIST = 722 * MiB;
constexpr size_t WS_HID = 210 * MiB;
constexpr size_t WS_OUTR0 = 754 * MiB;
constexpr size_t WS_OUTR1 = 482 * MiB;
constexpr int CT_CNT = 0;
constexpr int CT_Q = 64;
constexpr int CT_C1 = 3072;
constexpr int CT_BAR = 4096;
namespace pg8 {
#define PG8_LAS __attribute__((address_space(3)))
typedef unsigned short bf16_t;
typedef short bf16x8 __attribute__((ext_vector_type(8)));
typedef float f32x4 __attribute__((ext_vector_type(4)));
typedef unsigned u32x4 __attribute__((ext_vector_type(4)));
constexpr int BM = 256, BK = 64, HALF = 128, HTB = HALF * BK * 2, STAGE_BYTES = 8 * HTB, NXCD = 8, WGM = 8;
__host__ __device__ __forceinline__ int lds_byte(int r, int c) { const int st = (r >> 4) * 2 + (c >> 5), rr = r & 15, cc = c & 31, ob = rr * 64 + cc * 2; return st * 1024 + (ob ^ (((ob >> 9) & 1) << 5)); }
__host__ __device__ __forceinline__ void stage_rc(int b, int& R, int& C) { const int st = b / 1024, sb = b % 1024, swz = sb ^ (((sb >> 9) & 1) << 5); R = (st >> 1) * 16 + swz / 64; C = (st & 1) * 32 + (swz % 64) / 2; }
__host__ __device__ __forceinline__ int perm32(int rho) { const int n = rho >> 4, i = rho & 15; return 8 * (i >> 2) + 4 * n + (i & 3); }
struct Unit { int pm, pn, e, r0; };
struct Gemm { const bf16_t* A; const bf16_t* Bt; int K; int pad; };
struct StaticOrder {
    int nM, nN, nwg, G, c;
    __host__ __device__ void init(int M, int N, int G_, int c_) { nM = M / BM; nN = N / BM; nwg = nM * nN; G = G_; c = c_; }
    __host__ __device__ bool next(int i, Unit& u) const {
        const long L = (long)i * G + c; if (L >= nwg) return false;
        int wgid = (int)L; { const int q = nwg / NXCD, r = nwg % NXCD, xcd = wgid % NXCD, off = wgid / NXCD; wgid = (xcd < r ? xcd * (q + 1) : r * (q + 1) + (xcd - r) * q) + off; }
        const int nig = WGM * nN, gid = wgid / nig, fm = gid * WGM, gsz = (nM - fm) < WGM ? (nM - fm) : WGM;
        u.pm = fm + ((wgid % nig) % gsz); u.pn = (wgid % nig) / gsz; u.e = 0; u.r0 = 0; return true;
    }
    __device__ __forceinline__ unsigned row_off(const Unit&, int) const { return 0u; }
    __device__ __forceinline__ void row_off4(const Unit&, int, int, unsigned (&ro)[2][2]) const { ro[0][0] = ro[0][1] = ro[1][0] = ro[1][1] = 0u; }
};
__device__ __forceinline__ unsigned cvt_pk_bf16(float lo, float hi) { typedef float f2_ __attribute__((ext_vector_type(2))); typedef __bf16 bf2_ __attribute__((ext_vector_type(2)));
    return __builtin_bit_cast(unsigned, __builtin_convertvector((f2_){lo, hi}, bf2_)); }

template <class Epi, class Sched, bool ALIGN_EPI, bool GATHER>
__device__ __forceinline__ void gemm_phase(PG8_LAS unsigned char* lds, const Gemm g, const Sched& S, const Epi& E) {
    const int tid = threadIdx.x, wid = __builtin_amdgcn_readfirstlane(tid >> 6), lane = tid & 63, wr = wid >> 2, wc = wid & 3, fr = lane & 15, fq = lane >> 4;
    const int K = g.K, nt = K / BK;
    unsigned voffA[2], voffB[2]; int Rrow[2];
#pragma unroll
    for (int i = 0; i < 2; ++i) { int R, C; stage_rc(tid * 16 + i * 8192, R, C); const int Rb = Epi::PERM ? ((R & ~31) + perm32(R & 31)) : R;
        voffA[i] = GATHER ? (unsigned)(C * 2) : (unsigned)(R * K + C) * 2u; voffB[i] = (unsigned)(Rb * K + C) * 2u; Rrow[i] = R; }
    const size_t kstep = (size_t)(BK * 2);
    const size_t hstep = (size_t)HALF * K * 2;
    const size_t hstepA = GATHER ? 0 : hstep;
    const size_t tstep = 2 * hstep;
    const unsigned ldsw = (unsigned)wid * 1024u;
    const int aoff = lds_byte(wr * 64 + fr, fq * 8), boff = lds_byte(wc * 32 + fr, fq * 8);
#define PG8_SA(b, h) (((b) * 2 + (h)) * HTB)
#define PG8_SB(b, h) ((4 + (b) * 2 + (h)) * HTB)
#define PG8_STAGE(bufoff, gbase, voff) do { _Pragma("unroll") for (int _i = 0; _i < 2; ++_i) \
        __builtin_amdgcn_global_load_lds((const unsigned*)((const char*)(gbase) + (voff)[_i]), (PG8_LAS unsigned*)(lds + (bufoff) + ldsw + _i * 8192), 16, 0, 0); } while (0)
#define PG8_STAGE_A(bufoff, gbase, h, nx) do { if constexpr (GATHER) { unsigned _o[2]; _o[0] = ((nx) ? gN[h][0] : gA[h][0]); _o[1] = ((nx) ? gN[h][1] : gA[h][1]); PG8_STAGE(bufoff, gbase, _o); } \
        else { PG8_STAGE(bufoff, (gbase) + (h) * hstepA, voffA); } } while (0)
#define PG8_LDA(dst, b, h) do { _Pragma("unroll") for (int m = 0; m < 4; ++m) _Pragma("unroll") for (int k = 0; k < 2; ++k) dst[m][k] = *(const PG8_LAS bf16x8*)(lds + PG8_SA(b, h) + aoff + m * 2048 + k * 1024); } while (0)
#define PG8_LDB(dst, b, h) do { _Pragma("unroll") for (int n = 0; n < 2; ++n) _Pragma("unroll") for (int k = 0; k < 2; ++k) dst[n][k] = *(const PG8_LAS bf16x8*)(lds + PG8_SB(b, h) + boff + n * 2048 + k * 1024); } while (0)
#define PG8_MMA(ai, bj, At, Bt) do { __builtin_amdgcn_s_setprio(1); _Pragma("unroll") for (int m = 0; m < 4; ++m) _Pragma("unroll") for (int n = 0; n < 2; ++n) _Pragma("unroll") for (int k = 0; k < 2; ++k) \
        acc[ai][bj][m][n] = __builtin_amdgcn_mfma_f32_16x16x32_bf16(Bt[n][k], At[m][k], acc[ai][bj][m][n], 0, 0, 0); __builtin_amdgcn_s_setprio(0); } while (0)
#define PG8_WAIT_V(n) asm volatile("s_waitcnt vmcnt(" #n ")" ::: "memory")
#define PG8_WAIT_L(n) asm volatile("s_waitcnt lgkmcnt(" #n ")" ::: "memory")
#define PG8_BAR __builtin_amdgcn_s_barrier()
#define PG8_SCHED __builtin_amdgcn_sched_barrier(0)
    Unit cur, nxt; int ui = 0;
    if (!S.next(0, cur)) return;
    f32x4 acc[2][2][4][2];
#pragma unroll
    for (int a = 0; a < 2; ++a)
#pragma unroll
        for (int b = 0; b < 2; ++b)
#pragma unroll
            for (int m = 0; m < 4; ++m)
#pragma unroll
                for (int n = 0; n < 2; ++n) acc[a][b][m][n] = (f32x4){0.f, 0.f, 0.f, 0.f};
    bf16x8 At[4][2], B0[2][2], B1[2][2];
    unsigned gA[2][2], gN[2][2];
#pragma unroll
    for (int h = 0; h < 2; ++h)
#pragma unroll
        for (int i = 0; i < 2; ++i) { gA[h][i] = GATHER ? S.row_off(cur, h * HALF + Rrow[i]) + voffA[i] : 0u; gN[h][i] = gA[h][i]; }
    const char* cA = (const char*)g.A + (GATHER ? (size_t)0 : (size_t)cur.pm * tstep); const char* cB = (const char*)g.Bt + (size_t)cur.pn * tstep;
    PG8_STAGE(PG8_SB(0, 0), cB, voffB); PG8_STAGE(PG8_SB(0, 1), cB + hstep, voffB); PG8_STAGE_A(PG8_SA(0, 0), cA, 0, false); PG8_STAGE_A(PG8_SA(0, 1), cA, 1, false);
    if (wr == 1) PG8_BAR;
    PG8_WAIT_V(2); PG8_BAR;
    PG8_STAGE(PG8_SB(1, 0), cB + kstep, voffB); PG8_STAGE_A(PG8_SA(1, 0), cA + kstep, 0, false); PG8_STAGE(PG8_SB(1, 1), cB + hstep + kstep, voffB);
    PG8_WAIT_V(6); PG8_BAR;
    for (;;) {
        const bool has_next = S.next(ui + 1, nxt);
        if constexpr (GATHER) {
            if (has_next) {
                unsigned ro[2][2]; S.row_off4(nxt, Rrow[0], Rrow[1], ro);
#pragma unroll
                for (int h = 0; h < 2; ++h)
#pragma unroll
                    for (int i = 0; i < 2; ++i) gN[h][i] = ro[h][i] + voffA[i];
            } else {
#pragma unroll
                for (int h = 0; h < 2; ++h)
#pragma unroll
                    for (int i = 0; i < 2; ++i) gN[h][i] = gA[h][i];
            }
        }
        const char* nA = (has_next && !GATHER) ? (const char*)g.A + (size_t)nxt.pm * tstep : cA; const char* nB = has_next ? (const char*)g.Bt + (size_t)nxt.pn * tstep : cB;
        for (int t = 0; t < nt; t += 2) {
            const bool last = (t == nt - 2);
            const char* a1 = cA + (size_t)(t + 1) * kstep;
            const char* a2 = last ? nA : cA + (size_t)(t + 2) * kstep; const char* b2 = last ? nB : cB + (size_t)(t + 2) * kstep;
            const char* a3 = a2 + kstep; const char* b3 = b2 + kstep;
            PG8_LDB(B0, 0, 0); PG8_LDB(B1, 0, 1); PG8_SCHED; PG8_LDA(At, 0, 0); PG8_STAGE_A(PG8_SA(1, 1), a1, 1, false);
            PG8_WAIT_V(8); PG8_WAIT_L(0); PG8_BAR; PG8_MMA(0, 0, At, B0); PG8_MMA(0, 1, At, B1); PG8_BAR; PG8_SCHED;
            PG8_LDA(At, 0, 1); PG8_STAGE(PG8_SB(0, 0), b2, voffB); PG8_STAGE(PG8_SB(0, 1), b2 + hstep, voffB); PG8_STAGE_A(PG8_SA(0, 0), a2, 0, last);
            PG8_WAIT_V(8); PG8_WAIT_L(0); PG8_BAR; PG8_MMA(1, 0, At, B0); PG8_MMA(1, 1, At, B1); PG8_BAR; PG8_SCHED;
            PG8_LDB(B0, 1, 0); PG8_LDB(B1, 1, 1); PG8_SCHED; PG8_LDA(At, 1, 0); PG8_STAGE_A(PG8_SA(0, 1), a2, 1, last);
            PG8_WAIT_V(8); PG8_WAIT_L(0); PG8_BAR; PG8_MMA(0, 0, At, B0); PG8_MMA(0, 1, At, B1); PG8_BAR; PG8_SCHED;
            PG8_LDA(At, 1, 1); PG8_STAGE(PG8_SB(1, 0), b3, voffB); PG8_STAGE(PG8_SB(1, 1), b3 + hstep, voffB); PG8_STAGE_A(PG8_SA(1, 0), a3, 0, last);
            PG8_WAIT_V(8); PG8_WAIT_L(0); PG8_BAR; PG8_MMA(1, 0, At, B0); PG8_MMA(1, 1, At, B1); PG8_BAR; PG8_SCHED;
        }
        if constexpr (ALIGN_EPI) { if (wr == 0) PG8_BAR; }
        E(acc, cur, wr, wc, fr, fq);
        if (!has_next) break;
        {
            typedef float f32x2z __attribute__((ext_vector_type(2)));
#pragma unroll
            for (int a = 0; a < 2; ++a)
#pragma unroll
                for (int b = 0; b < 2; ++b)
#pragma unroll
                    for (int m = 0; m < 4; ++m)
#pragma unroll
                        for (int n = 0; n < 2; ++n) { f32x2z lo_, hi_;
                            asm volatile("v_pk_mov_b32 %0, 0, 0 op_sel_hi:[0,0]" : "=v"(lo_));
                            asm volatile("v_pk_mov_b32 %0, 0, 0 op_sel_hi:[0,0]" : "=v"(hi_));
                            acc[a][b][m][n] = (f32x4){lo_.x, lo_.y, hi_.x, hi_.y}; }
        }
        cur = nxt; cA = nA; cB = nB; ++ui;
#pragma unroll
        for (int h = 0; h < 2; ++h)
#pragma unroll
            for (int i = 0; i < 2; ++i) gA[h][i] = gN[h][i];
        if constexpr (ALIGN_EPI) { if (wr == 1) PG8_BAR; }
    }
    PG8_WAIT_V(0);
    if constexpr (!ALIGN_EPI) { if (wr == 0) PG8_BAR; }
    PG8_BAR;
#undef PG8_SA
#undef PG8_SB
#undef PG8_STAGE
#undef PG8_STAGE_A
#undef PG8_LDA
#undef PG8_LDB
#undef PG8_MMA
#undef PG8_WAIT_V
#undef PG8_WAIT_L
#undef PG8_BAR
#undef PG8_SCHED
}
}
using pg8::Unit; using pg8::cvt_pk_bf16;
__device__ __forceinline__ f32x2 sigmoid2(f32x2 x) { const f32x2 tt = x * (-1.4426950408889634f); const f32x2 d = (f32x2){__builtin_amdgcn_exp2f(tt.x), __builtin_amdgcn_exp2f(tt.y)} + 1.f;
    return (f32x2){__builtin_amdgcn_rcpf(d.x), __builtin_amdgcn_rcpf(d.y)}; }
struct EpiInProj {
    static constexpr bool PERM = true;
    bf16_t* sbq; bf16_t* sbk; bf16_t* sbv; bf16_t* nq; bf16_t* kv6; bf16_t* mg; const float* cosT; const float* sinT;
    __device__ __forceinline__ void operator()(const f32x4 (&acc)[2][2][4][2], const Unit& u, int wr, int wc, int fr, int fq) const {
        const int pn = u.pn; const int row0 = u.pm * 256 + wr * 64 + fr; const int x0 = wc * 32 + 8 * fq;
        if (pn < 6 || pn >= 11) {
            bf16_t* base; int ld, col; float sc = 1.f; const bool sig = pn >= 11;
            if (pn < 2) { base = sbq; ld = 512; col = pn * 256; sc = C2; } else if (pn < 4) { base = sbk; ld = 512; col = (pn - 2) * 256; }
            else if (pn < 6) { base = sbv; ld = 512; col = (pn - 4) * 256; } else { base = mg; ld = 2048; col = (pn - 11) * 256; }
#pragma unroll
            for (int ai = 0; ai < 2; ++ai)
#pragma unroll
                for (int m = 0; m < 4; ++m) { bf16_t* rp = base + (size_t)(row0 + ai * 128 + m * 16) * ld + col + x0;
#pragma unroll
                    for (int bj = 0; bj < 2; ++bj) { f32x4 v0 = acc[ai][bj][m][0] * sc, v1 = acc[ai][bj][m][1] * sc;
                        if (sig) {
                            const f32x2 a = sigmoid2((f32x2){v0[0], v0[1]}), b = sigmoid2((f32x2){v0[2], v0[3]}), c = sigmoid2((f32x2){v1[0], v1[1]}), d = sigmoid2((f32x2){v1[2], v1[3]});
                            v0 = (f32x4){a.x, a.y, b.x, b.y}; v1 = (f32x4){c.x, c.y, d.x, d.y}; }
                        u32x4 w; w.x = cvt_pk_bf16(v0[0], v0[1]); w.y = cvt_pk_bf16(v0[2], v0[3]); w.z = cvt_pk_bf16(v1[0], v1[1]); w.w = cvt_pk_bf16(v1[2], v1[3]);
                        *(u32x4*)(rp + bj * 128) = w; } }
        } else {
            const bool rope = (pn < 8) || (wc < 2);
            bf16_t* base; int ld, c0, c1; float sc = 1.f;
            if (pn < 8) { base = nq; ld = 512; c0 = ((pn - 6) * 4 + wc) * 64 + 8 * fq; c1 = c0 + 32; sc = C2; }
            else { const int t = pn - 8; ld = 128;
                if (wc < 2) { base = kv6 + (size_t)(2 * t) * NTOK * 128; c0 = wc * 64 + 8 * fq; c1 = c0 + 32; }
                else { base = kv6 + (size_t)(2 * t + 1) * NTOK * 128; c0 = (wc - 2) * 32 + 8 * fq; c1 = 64 + c0; } }
#pragma unroll
            for (int am = 0; am < 4; ++am) { const int ai = am >> 1, mb = (am & 1) * 2;
                f32x4 cA[2], cB[2], sA[2], sB[2];
                if (rope) {
#pragma unroll
                    for (int mm = 0; mm < 2; ++mm) { const int pos = (row0 + ai * 128 + (mb + mm) * 16) & (SEQ - 1);
                        cA[mm] = *(const f32x4*)(cosT + pos * 32 + 8 * fq); cB[mm] = *(const f32x4*)(cosT + pos * 32 + 8 * fq + 4);
                        sA[mm] = *(const f32x4*)(sinT + pos * 32 + 8 * fq); sB[mm] = *(const f32x4*)(sinT + pos * 32 + 8 * fq + 4); }
                    asm volatile("" ::: "memory");
                }
#pragma unroll
                for (int mm = 0; mm < 2; ++mm) { const int m = mb + mm; const int row = row0 + ai * 128 + m * 16; bf16_t* rp = base + (size_t)row * ld;
                    f32x4 a0 = acc[ai][0][m][0], a1 = acc[ai][0][m][1], b0 = acc[ai][1][m][0], b1 = acc[ai][1][m][1];
                    if (rope) {
                        const f32x4 r0 = a0 * cA[mm] - b0 * sA[mm], r1 = a1 * cB[mm] - b1 * sB[mm], r2 = b0 * cA[mm] + a0 * sA[mm], r3 = b1 * cB[mm] + a1 * sB[mm];
                        a0 = r0 * sc; a1 = r1 * sc; b0 = r2 * sc; b1 = r3 * sc; }
                    u32x4 w; w.x = cvt_pk_bf16(a0[0], a0[1]); w.y = cvt_pk_bf16(a0[2], a0[3]); w.z = cvt_pk_bf16(a1[0], a1[1]); w.w = cvt_pk_bf16(a1[2], a1[3]);
                    *(u32x4*)(rp + c0) = w;
                    w.x = cvt_pk_bf16(b0[0], b0[1]); w.y = cvt_pk_bf16(b0[2], b0[3]); w.z = cvt_pk_bf16(b1[0], b1[1]); w.w = cvt_pk_bf16(b1[2], b1[3]);
                    *(u32x4*)(rp + c1) = w; }
            }
        }
    }
};
struct EpiMerge {
    static constexpr bool PERM = true;
    const bf16_t* mg; bf16_t* merged;
    __device__ __forceinline__ void operator()(const f32x4 (&acc)[2][2][4][2], const Unit& u, int wr, int wc, int fr, int fq) const {
        const int pass = u.e; const int row0 = (u.pm - 256 * pass) * 256 + wr * 64 + fr; const int col0 = (u.pn - 4 * pass) * 256 + wc * 32 + 8 * fq;
#pragma unroll
        for (int ai = 0; ai < 2; ++ai) {
            u32x4 gv[4][2], pv_[4][2];
#pragma unroll
            for (int m = 0; m < 4; ++m) { const size_t row = (size_t)(row0 + ai * 128 + m * 16);
#pragma unroll
                for (int bj = 0; bj < 2; ++bj) { gv[m][bj] = *(const u32x4*)(mg + row * 2048 + pass * 1024 + col0 + bj * 128);
                    if (pass) pv_[m][bj] = *(const u32x4*)(merged + row * DM + col0 + bj * 128); } }
            asm volatile("" ::: "memory");
#pragma unroll
            for (int m = 0; m < 4; ++m) { const size_t row = (size_t)(row0 + ai * 128 + m * 16);
#pragma unroll
                for (int bj = 0; bj < 2; ++bj) { const u32x4 g = gv[m][bj];
                    f32x4 v0 = acc[ai][bj][m][0], v1 = acc[ai][bj][m][1];
                    v0[0] *= bflo(g.x); v0[1] *= bfhi(g.x); v0[2] *= bflo(g.y); v0[3] *= bfhi(g.y); v1[0] *= bflo(g.z); v1[1] *= bfhi(g.z); v1[2] *= bflo(g.w); v1[3] *= bfhi(g.w);
                    if (pass) { const u32x4 p = pv_[m][bj]; v0[0] += bflo(p.x); v0[1] += bfhi(p.x); v0[2] += bflo(p.y); v0[3] += bfhi(p.y); v1[0] += bflo(p.z); v1[1] += bfhi(p.z); v1[2] += bflo(p.w); v1[3] += bfhi(p.w); }
                    u32x4 w; w.x = cvt_pk_bf16(v0[0], v0[1]); w.y = cvt_pk_bf16(v0[2], v0[3]); w.z = cvt_pk_bf16(v1[0], v1[1]); w.w = cvt_pk_bf16(v1[2], v1[3]);
                    *(u32x4*)(merged + row * DM + col0 + bj * 128) = w; } }
        }
    }
};
struct MergeOrder : pg8::StaticOrder {
    __device__ __forceinline__ bool next(int i, Unit& u) const { if (!pg8::StaticOrder::next(i >> 1, u)) return false; const int p = i & 1; u.pm += 256 * p; u.pn += 4 * p; u.e = p; return true; }
};
struct EpiOut {
    static constexpr bool PERM = false;
    const float* x; float* u; f32x2* stats;
    __device__ __forceinline__ void operator()(const f32x4 (&acc)[2][2][4][2], const Unit& un, int wr, int wc, int fr, int fq) const {
        const int row0 = un.pm * 256 + wr * 64 + fr; const int col0 = un.pn * 256 + wc * 32 + 4 * fq;
#pragma unroll
        for (int ai = 0; ai < 2; ++ai) {
            f32x4 xv[4][2][2];
#pragma unroll
            for (int m = 0; m < 4; ++m) { const size_t off = (size_t)(row0 + ai * 128 + m * 16) * DM + col0;
#pragma unroll
                for (int bj = 0; bj < 2; ++bj)
#pragma unroll
                    for (int n = 0; n < 2; ++n) xv[m][bj][n] = *(const f32x4*)(x + off + bj * 128 + n * 16); }
            asm volatile("" ::: "memory");
#pragma unroll
            for (int m = 0; m < 4; ++m) { const int row = row0 + ai * 128 + m * 16; const size_t off = (size_t)row * DM + col0; float s = 0.f, s2 = 0.f;
#pragma unroll
                for (int bj = 0; bj < 2; ++bj)
#pragma unroll
                    for (int n = 0; n < 2; ++n) { const f32x4 v = xv[m][bj][n] * ALPHA + acc[ai][bj][m][n];
                        *(u32x2*)((char*)u + (size_t)row * H1_PITCH_B + (size_t)(col0 + bj * 128 + n * 16) * 2) = (u32x2){cvt_pk_bf16(v[0], v[1]), cvt_pk_bf16(v[2], v[3])};
                        s += (v[0] + v[1]) + (v[2] + v[3]); s2 += (v[0] * v[0] + v[1] * v[1]) + (v[2] * v[2] + v[3] * v[3]); }
                s += __shfl_xor(s, 16); s += __shfl_xor(s, 32); s2 += __shfl_xor(s2, 16); s2 += __shfl_xor(s2, 32);
                if (fq == 0) stats[(size_t)row * 16 + un.pn * 4 + wc] = (f32x2){s, s2}; }
        }
    }
};
__device__ __forceinline__ f32x2 swiglu2(f32x2 ga, f32x2 ua) {
    const f32x2 g = {fminf(ga.x, 7.f), fminf(ga.y, 7.f)};
    const f32x2 uu = {fminf(fmaxf(ua.x, -7.f), 7.f), fminf(fmaxf(ua.y, -7.f), 7.f)};
    const f32x2 tt = g * (-1.702f * 1.4426950408889634f);
    const f32x2 d = (f32x2){__builtin_amdgcn_exp2f(tt.x), __builtin_amdgcn_exp2f(tt.y)} + 1.f;
    const f32x2 h = g * (f32x2){__builtin_amdgcn_rcpf(d.x), __builtin_amdgcn_rcpf(d.y)};
    return h * uu + h;
}
struct EpiGateUp {
    static constexpr bool PERM = true;
    const float* bgu; bf16_t* hid;
    __device__ __forceinline__ void operator()(const f32x4 (&acc)[2][2][4][2], const Unit& u, int wr, int wc, int fr, int fq) const {
        const int e = u.e, pnl = u.pn - e * 8; const int f0 = pnl * 128 + wc * 32 + 8 * fq;
        const float* bp = bgu + e * 2048 + f0;
        const f32x4 bg0 = *(const f32x4*)bp, bg1 = *(const f32x4*)(bp + 4), bu0 = *(const f32x4*)(bp + 1024), bu1 = *(const f32x4*)(bp + 1028);
        const int row0 = u.pm * 256 + wr * 64 + fr;
#pragma unroll
        for (int ai = 0; ai < 2; ++ai)
#pragma unroll
            for (int m = 0; m < 4; ++m) {
                const f32x4 g0 = acc[ai][0][m][0] + bg0, g1 = acc[ai][0][m][1] + bg1, u0 = acc[ai][1][m][0] + bu0, u1 = acc[ai][1][m][1] + bu1;
                const f32x2 ha = swiglu2((f32x2){g0[0], g0[1]}, (f32x2){u0[0], u0[1]}), hb = swiglu2((f32x2){g0[2], g0[3]}, (f32x2){u0[2], u0[3]});
                const f32x2 hc = swiglu2((f32x2){g1[0], g1[1]}, (f32x2){u1[0], u1[1]}), hd = swiglu2((f32x2){g1[2], g1[3]}, (f32x2){u1[2], u1[3]});
                u32x4 w; w.x = cvt_pk_bf16(ha.x, ha.y); w.y = cvt_pk_bf16(hb.x, hb.y); w.z = cvt_pk_bf16(hc.x, hc.y); w.w = cvt_pk_bf16(hd.x, hd.y);
                *(u32x4*)(hid + (size_t)(row0 + ai * 128 + m * 16) * DFF + f0) = w; }
    }
};
struct EpiDown {
    static constexpr bool PERM = true;
    const float* bd; bf16_t* outr;
    __device__ __forceinline__ void operator()(const f32x4 (&acc)[2][2][4][2], const Unit& u, int wr, int wc, int fr, int fq) const {
        const int e = u.e, pnl = u.pn - e * 4; const int col0 = pnl * 256 + wc * 32 + 8 * fq; const int row0 = u.pm * 256 + wr * 64 + fr;
        f32x4 b[2][2];
#pragma unroll
        for (int bj = 0; bj < 2; ++bj) { b[bj][0] = *(const f32x4*)(bd + e * DM + col0 + bj * 128); b[bj][1] = *(const f32x4*)(bd + e * DM + col0 + bj * 128 + 4); }
#pragma unroll
        for (int ai = 0; ai < 2; ++ai)
#pragma unroll
            for (int m = 0; m < 4; ++m) { bf16_t* rp = outr + (size_t)(row0 + ai * 128 + m * 16) * DM + col0;
#pragma unroll
                for (int bj = 0; bj < 2; ++bj) { const f32x4 v0 = acc[ai][bj][m][0] + b[bj][0], v1 = acc[ai][bj][m][1] + b[bj][1];
                    u32x4 w; w.x = cvt_pk_bf16(v0[0], v0[1]); w.y = cvt_pk_bf16(v0[2], v0[3]); w.z = cvt_pk_bf16(v1[0], v1[1]); w.w = cvt_pk_bf16(v1[2], v1[3]);
                    *(u32x4*)(rp + bj * 128) = w; } }
    }
};
constexpr int LDS_RING = 131072, LDS_TAB = LDS_RING, LDS_CNT = LDS_TAB + NTILE_MAX * 4, LDS_NT = LDS_CNT + 128, LDS_MISC = LDS_NT + 64, LDS_BYTES = 160 * 1024;
__device__ __forceinline__ void moe_build_table(LAS unsigned char* lds, const int* gcnt) {
    LAS int* tab = (LAS int*)(lds + LDS_TAB); LAS int* cnts = (LAS int*)(lds + LDS_CNT); LAS int* nt = (LAS int*)(lds + LDS_NT);
    LAS int* tstart = (LAS int*)(lds + LDS_MISC);
    const int tid = threadIdx.x;
    if (tid < 32) cnts[tid] = gcnt[tid];
    __syncthreads();
    if (tid == 0) { int a = 0; for (int e = 0; e < 32; ++e) { tstart[e] = a; a += (cnts[e] + 255) >> 8; } tstart[32] = a; nt[0] = a; }
    __syncthreads();
    const int ntl = nt[0];
    for (int t = tid; t < ntl; t += NTHREADS) { int e = 0; for (int k = 1; k < 32; ++k) if (tstart[k] <= t) e = k; tab[t] = (e << 16) | (t - tstart[e]); }
    __syncthreads();
}
template <int NPN> struct MoeOrder {
    LAS unsigned char* lds; const int* list; int r, G, c, ntr;
    __device__ __forceinline__ void init(LAS unsigned char* lds_, const int* list_, int r_, int G_, int c_) {
        lds = lds_; list = list_; r = r_; G = G_; c = c_; const int ntl = ((LAS int*)(lds + LDS_NT))[0]; int n = ntl - r * TR; ntr = n < 0 ? 0 : ((r < NROUND - 1 && n > TR) ? TR : n); }
    __device__ __forceinline__ bool next(int i, Unit& u) const {
        const int nM = ntr, nN = NPN, nwg = nM * nN; const long L = (long)i * G + c; if (L >= nwg) return false;
        int wgid = (int)L; { const int q = nwg / 8, rr = nwg % 8, xcd = wgid % 8, off = wgid / 8; wgid = (xcd < rr ? xcd * (q + 1) : rr * (q + 1) + (xcd - rr) * q) + off; }
        const int nig = 8 * nN, gid = wgid / nig, fm = gid * 8, gsz = (nM - fm) < 8 ? (nM - fm) : 8;
        const int pm0 = fm + ((wgid % nig) % gsz), pnl = (wgid % nig) / gsz; const int pm = (NPN == 4) ? (nM - 1 - pm0) : pm0;
        const int pk = ((LAS int*)(lds + LDS_TAB))[r * TR + pm];
        u.pm = pm; u.e = pk >> 16; u.r0 = (pk & 0xffff) << 8; u.pn = u.e * NPN + pnl; return true;
    }
    __device__ __forceinline__ unsigned row_off(const Unit& u, int rr) const {
        const int pos = u.r0 + rr; const int cnt = ((LAS int*)(lds + LDS_CNT))[u.e];
        const bool ok = pos < cnt; const int v = list[(size_t)u.e * NTOK + (ok ? pos : 0)];
        const int tok = ok ? (v >> 2) : 0;
        return (unsigned)tok * H1_PITCH_B;
    }
    __device__ __forceinline__ void row_off4(const Unit& u, int r0_, int r1_, unsigned (&ro)[2][2]) const {
        const int cnt = ((LAS int*)(lds + LDS_CNT))[u.e]; const int* lp = list + (size_t)u.e * NTOK;
        const int p00 = u.r0 + r0_, p01 = u.r0 + r1_, p10 = p00 + 128, p11 = p01 + 128;
        const int v00 = lp[p00 < cnt ? p00 : 0], v01 = lp[p01 < cnt ? p01 : 0], v10 = lp[p10 < cnt ? p10 : 0], v11 = lp[p11 < cnt ? p11 : 0];
        asm volatile("" ::: "memory");
        ro[0][0] = (p00 < cnt ? (unsigned)(v00 >> 2) : 0u) * H1_PITCH_B; ro[0][1] = (p01 < cnt ? (unsigned)(v01 >> 2) : 0u) * H1_PITCH_B;
        ro[1][0] = (p10 < cnt ? (unsigned)(v10 >> 2) : 0u) * H1_PITCH_B; ro[1][1] = (p11 < cnt ? (unsigned)(v11 >> 2) : 0u) * H1_PITCH_B;
    }
};
__device__ __forceinline__ int win_src_col(int n) {
    const int pn = n >> 8, c = n & 255, bj = c >> 7, x = c & 127;
    if (pn < 6) return n;
    if (pn < 8) return 1536 + ((pn - 6) * 4 + (x >> 5)) * 64 + (x & 31) + 32 * bj;
    if (pn < 11) { const int base = 2048 + (pn - 8) * 256; return x < 64 ? base + (x >> 5) * 64 + (x & 31) + 32 * bj : base + 128 + bj * 64 + (x - 64); }
    return C_MG + (n - 2816);
}
__device__ __forceinline__ int wgu_src_col(int n) { const int pnl = n >> 8, c = n & 255, bj = c >> 7, x = c & 127; return bj * 1024 + 128 * pnl + x; }
__device__ __forceinline__ void transpose_item64(const float* W, int ldw, int K, int srccol0a, int srccol0b, bf16_t* WT, int n0, int k0, LAS float* scr, int lane) {
    const int sc = (lane < 32) ? srccol0a + lane : srccol0b + (lane - 32);
    float tv[32];
#pragma unroll
    for (int h = 0; h < 2; ++h) {
#pragma unroll
        for (int i = 0; i < 32; ++i) tv[i] = W[(size_t)(k0 + 32 * h + i) * ldw + sc];
#pragma unroll
        for (int i = 0; i < 32; ++i) scr[(32 * h + i) * 65 + lane] = tv[i];
    }
    asm volatile("s_waitcnt lgkmcnt(0)" ::: "memory");
    const int c = lane & 7;
#pragma unroll
    for (int j = 0; j < 8; ++j) { const int n = (lane >> 3) + 8 * j; const LAS float* s = scr + (8 * c) * 65 + n;
        u32x4 o; o.x = pk2(s[0 * 65], s[1 * 65]); o.y = pk2(s[2 * 65], s[3 * 65]); o.z = pk2(s[4 * 65], s[5 * 65]); o.w = pk2(s[6 * 65], s[7 * 65]);
        *(u32x4*)(WT + (size_t)(n0 + n) * K + k0 + 8 * c) = o; }
    asm volatile("s_waitcnt lgkmcnt(0)" ::: "memory");
}
__device__ __forceinline__ void transpose_item(const float* W, int ldw, int K, int srccol0, bf16_t* WT, int n0, int k0, LAS float* scr, int lane) {
    float tv[32];
#pragma unroll
    for (int i = 0; i < 32; ++i) tv[i] = W[(size_t)(k0 + 2 * i + (lane >> 5)) * ldw + srccol0 + (lane & 31)];
#pragma unroll
    for (int i = 0; i < 32; ++i) scr[(2 * i + (lane >> 5)) * 33 + (lane & 31)] = tv[i];
    asm volatile("s_waitcnt lgkmcnt(0)" ::: "memory");
    const int c = lane & 7;
#pragma unroll
    for (int j = 0; j < 4; ++j) { const int n = (lane >> 3) + 8 * j; const LAS float* s = scr + (8 * c) * 33 + n;
        u32x4 o; o.x = pk2(s[0 * 33], s[1 * 33]); o.y = pk2(s[2 * 33], s[3 * 33]); o.z = pk2(s[4 * 33], s[5 * 33]); o.w = pk2(s[6 * 33], s[7 * 33]);
        *(u32x4*)(WT + (size_t)(n0 + n) * K + k0 + 8 * c) = o; }
    asm volatile("s_waitcnt lgkmcnt(0)" ::: "memory");
}
constexpr int I_GU = 32 * 16 * 32, I_DN = 32 * 16 * 16;
constexpr int CONV_CHUNK = 48, CONV_NCHUNK = (I_GU + I_DN) / CONV_CHUNK;
__device__ __forceinline__ void convert_expert_weights(const float* w_gu, const float* w_dn, bf16_t* wt_gu, bf16_t* wt_dn, LAS float* scr, int lane, int it0, int stride, int itend) {
    auto src_of = [&](int it, const float*& W, int& ldw, int& ca, int& cb, bf16_t*& WT, int& n0, int& k0) {
        if (it < I_GU) { const int e = it / (16 * 32), q = it % (16 * 32), nb = q % 32, kb = q / 32; W = w_gu + (size_t)e * 1024 * 2048; ldw = 2048; ca = wgu_src_col(nb * 64); cb = wgu_src_col(nb * 64 + 32);
            WT = wt_gu + (size_t)e * 2048 * 1024; n0 = nb * 64; k0 = kb * 64; }
        else { const int r2 = it - I_GU; const int e = r2 / (16 * 16), q = r2 % (16 * 16), nb = q % 16, kb = q / 16; W = w_dn + (size_t)e * 1024 * 1024; ldw = 1024; ca = nb * 64; cb = nb * 64 + 32;
            WT = wt_dn + (size_t)e * 1024 * 1024; n0 = nb * 64; k0 = kb * 64; } };
    f32x4 tA[8], tB[8];
    const float* W; int ldw, ca, cb, n0, k0; bf16_t* WT;
    const int lr = lane >> 3, lc = (lane & 7) * 4;
    int it = it0;
    if (it < itend) { src_of(it, W, ldw, ca, cb, WT, n0, k0);
#pragma unroll
        for (int i = 0; i < 8; ++i) tA[i] = *(const f32x4*)(W + (size_t)(k0 + (i >> 1) * 8 + lr) * ldw + ((i & 1) ? cb : ca) + lc); }
    while (it < itend) {
#pragma unroll
        for (int i = 0; i < 8; ++i) tB[i] = *(const f32x4*)(W + (size_t)(k0 + 32 + (i >> 1) * 8 + lr) * ldw + ((i & 1) ? cb : ca) + lc);
#pragma unroll
        for (int i = 0; i < 8; ++i) { LAS float* d = scr + ((i >> 1) * 8 + lr) * 65 + (i & 1) * 32 + lc; d[0] = tA[i][0]; d[1] = tA[i][1]; d[2] = tA[i][2]; d[3] = tA[i][3]; }
        bf16_t* WTc = WT; const int n0c = n0, k0c = k0; const int K = 1024;
        const int itn = it + stride;
        if (itn < itend) { src_of(itn, W, ldw, ca, cb, WT, n0, k0);
#pragma unroll
            for (int i = 0; i < 8; ++i) tA[i] = *(const f32x4*)(W + (size_t)(k0 + (i >> 1) * 8 + lr) * ldw + ((i & 1) ? cb : ca) + lc); }
#pragma unroll
        for (int i = 0; i < 8; ++i) { LAS float* d = scr + (32 + (i >> 1) * 8 + lr) * 65 + (i & 1) * 32 + lc; d[0] = tB[i][0]; d[1] = tB[i][1]; d[2] = tB[i][2]; d[3] = tB[i][3]; }
        asm volatile("s_waitcnt lgkmcnt(0)" ::: "memory");
        const int c = lane & 7;
#pragma unroll
        for (int j = 0; j < 8; ++j) { const int n = (lane >> 3) + 8 * j; const LAS float* sp = scr + (8 * c) * 65 + n;
            u32x4 o; o.x = pg8::cvt_pk_bf16(sp[0 * 65], sp[1 * 65]); o.y = pg8::cvt_pk_bf16(sp[2 * 65], sp[3 * 65]); o.z = pg8::cvt_pk_bf16(sp[4 * 65], sp[5 * 65]); o.w = pg8::cvt_pk_bf16(sp[6 * 65], sp[7 * 65]);
            *(u32x4*)(WTc + (size_t)(n0c + n) * K + k0c + 8 * c) = o; }
        asm volatile("s_waitcnt lgkmcnt(0)" ::: "memory");
        it = itn;
    }
}
struct PrepArgs { const float* x; const float* w_in; const float* w_sb; const float* w_nsa; const float* w_out; const float* w_gu; const float* w_dn;
                  bf16_t* wt_in; bf16_t* wt_sb; bf16_t* wt_nsa; bf16_t* wt_out; bf16_t* wt_gu; bf16_t* wt_dn; bf16_t* xb; float* ng; float* ropeT;
                  const float* pe_k; const float* w1_k; const float* w2_k; const float* pe_v; const float* w1_v; const float* w2_v; unsigned char* cmpw; float* c1; };
constexpr int CW_WT1K = 0, CW_WT1V = 262144, CW_W2TK = 524288, CW_W2TV = 532480, CW_C1K = 540672, CW_C1V = 541696;
__device__ __forceinline__ void prep_phase(const PrepArgs& a, LAS unsigned char* lds, int vcu, int G) {
    const int tid = threadIdx.x, lane = tid & 63, wave = __builtin_amdgcn_readfirstlane(tid >> 6);
    const int gw = vcu * NWAVES + wave, NGW = G * NWAVES;
    for (int i = gw * 64 + lane; i < SEQ * 32; i += NGW * 64) { const int pos = i >> 5, d = i & 31;
        const float inv = (float)pow(10000.0, -(double)d / 32.0); const float ang = (float)pos * inv;
        a.ropeT[i] = (float)cos((double)ang); a.ropeT[SEQ * 32 + i] = (float)sin((double)ang); }
    LAS float* scr = (LAS float*)(lds + wave * 16640);
    constexpr int I_IN = 16 * (4864 / 64), I_SB = 8 * 32, I_OUT = 16 * 32;
    constexpr int I_W1 = 32 * 2, I_W2 = 2, I_C1 = 16;
    constexpr int NITEMS = I_IN + 2 * I_SB + I_OUT + 2 * I_W1 + 2 * I_W2 + 2 * I_C1;
    for (int it = gw; it < NITEMS; it += NGW) {
        int r = it;
        if (r < I_IN) { const int nb = r % 76, kb = r / 76; transpose_item64(a.w_in, IN_W, 1024, win_src_col(nb * 64), win_src_col(nb * 64 + 32), a.wt_in, nb * 64, kb * 64, scr, lane); continue; } r -= I_IN;
        if (r < I_SB) { const int nb = r % 32, kb = r / 32; transpose_item(a.w_sb, 1024, 512, nb * 32, a.wt_sb, nb * 32, kb * 64, scr, lane); continue; } r -= I_SB;
        if (r < I_SB) { const int nb = r % 32, kb = r / 32; transpose_item(a.w_nsa, 1024, 512, nb * 32, a.wt_nsa, nb * 32, kb * 64, scr, lane); continue; } r -= I_SB;
        if (r < I_OUT) { const int nb = r % 32, kb = r / 32; transpose_item(a.w_out, 1024, 1024, nb * 32, a.wt_out, nb * 32, kb * 64, scr, lane); continue; } r -= I_OUT;
        if (r < I_W1) { transpose_item(a.w1_k, 64, 2048, (r & 1) * 32, (bf16_t*)(a.cmpw + CW_WT1K), (r & 1) * 32, (r >> 1) * 64, scr, lane); continue; } r -= I_W1;
        if (r < I_W1) { transpose_item(a.w1_v, 64, 2048, (r & 1) * 32, (bf16_t*)(a.cmpw + CW_WT1V), (r & 1) * 32, (r >> 1) * 64, scr, lane); continue; } r -= I_W1;
        if (r < I_W2) { transpose_item(a.w2_k, 64, 64, r * 32, (bf16_t*)(a.cmpw + CW_W2TK), r * 32, 0, scr, lane); continue; } r -= I_W2;
        if (r < I_W2) { transpose_item(a.w2_v, 64, 64, r * 32, (bf16_t*)(a.cmpw + CW_W2TV), r * 32, 0, scr, lane); continue; } r -= I_W2;
        {
            const int kv = r >> 4, part = r & 15;
            const float* pe = kv ? a.pe_v : a.pe_k; const float* w1 = kv ? a.w1_v : a.w1_k; float* c1 = a.c1 + kv * 64;
            float acc = 0.f;
#pragma unroll 1
            for (int i0 = 0; i0 < 128; i0 += 32) {
                float wv[32], pv[32];
#pragma unroll
                for (int j = 0; j < 32; ++j) { const int idx = part * 128 + i0 + j; wv[j] = w1[idx * 64 + lane]; pv[j] = pe[idx]; }
                asm volatile("" ::: "memory");
#pragma unroll
                for (int j = 0; j < 32; ++j) acc += pv[j] * wv[j];
            }
            atomicAdd(&c1[lane], acc); }
    }
    __syncthreads();
    LAS unsigned char* wl = lds;
    for (int i = tid; i < 32 * 1024; i += NTHREADS) { const int k = i >> 5, n = i & 31; const float v = (n < 24) ? a.w_in[(size_t)k * IN_W + C_NG + n] : 0.f;
        *(LAS bf16_t*)(wl + n * 2048 + ((((k >> 3) ^ (n & 15)) << 4) | ((k & 7) << 1))) = (bf16_t)f2bf(v); }
    __syncthreads();
    {
        typedef short bf16x8_t __attribute__((ext_vector_type(8)));
        const int r = lane & 15, kq = lane >> 4;
        for (int grp = gw; grp < NTOK / 16; grp += NGW) {
            const int tok = grp * 16 + r; const float* xr = a.x + (size_t)tok * DM + 8 * kq; bf16_t* xo = a.xb + (size_t)tok * DM + 8 * kq;
            f32x4 acc0 = {0.f, 0.f, 0.f, 0.f}, acc1 = {0.f, 0.f, 0.f, 0.f};
            f32x4 ra[8], rb[8];
#pragma unroll
            for (int i = 0; i < 8; ++i) { ra[i] = *(const f32x4*)(xr + 32 * i); rb[i] = *(const f32x4*)(xr + 32 * i + 4); }
#pragma unroll 1
            for (int s8 = 0; s8 < 32; s8 += 8) {
#pragma unroll
            for (int u8 = 0; u8 < 8; ++u8) {
                const int st = s8 + u8;
                const f32x4 va = ra[u8], vb = rb[u8];
                { const int sn = (s8 < 24) ? st + 8 : st;
                  ra[u8] = *(const f32x4*)(xr + 32 * sn); rb[u8] = *(const f32x4*)(xr + 32 * sn + 4); }
                u32x4 w; w.x = pk2(va[0], va[1]); w.y = pk2(va[2], va[3]); w.z = pk2(vb[0], vb[1]); w.w = pk2(vb[2], vb[3]);
                *(u32x4*)(xo + 32 * st) = w;
                const int kc = 4 * st + kq;
                const bf16x8_t b0 = *(const LAS bf16x8_t*)(wl + r * 2048 + ((kc ^ r) << 4)), b1 = *(const LAS bf16x8_t*)(wl + (16 + r) * 2048 + ((kc ^ r) << 4));
                const bf16x8_t af = __builtin_bit_cast(bf16x8_t, w);
                acc0 = __builtin_amdgcn_mfma_f32_16x16x32_bf16(af, b0, acc0, 0, 0, 0); acc1 = __builtin_amdgcn_mfma_f32_16x16x32_bf16(af, b1, acc1, 0, 0, 0);
            }
            }
#pragma unroll
            for (int q = 0; q < 4; ++q) { float* o = a.ng + (size_t)(grp * 16 + 4 * kq + q) * 24; o[r] = 1.f / (1.f + expf(-acc0[q])); if (r < 8) o[16 + r] = 1.f / (1.f + expf(-acc1[q])); }
        }
    }
}
#define GAS __attribute__((address_space(1)))
typedef GAS unsigned gu32;
typedef GAS unsigned long long gu64;
#define RLX_AGENT __ATOMIC_RELAXED, __HIP_MEMORY_SCOPE_AGENT
#define LDS_WAIT() asm volatile("s_waitcnt lgkmcnt(0)" ::: "memory")
#define VM_WAIT() asm volatile("s_waitcnt vmcnt(0)" ::: "memory")
__device__ __forceinline__ unsigned long long rt() { return __builtin_amdgcn_s_memrealtime(); }

#define XB_TMO      128
#define XB_XCNT(j)  (256  + 64 * (j))
#define XB_XSUB(j)  (1280 + 64 * (j))
#define XB_XGEN(j)  (2304 + 64 * (j))
#define XB_TOP      3328
#define XB_TOPGEN   3392
#define XCD_BAR_WORDS 3456
#define XB_SPIN_CAP (1u << 18)

__device__ __forceinline__ unsigned xb_ld(unsigned* p)              { return __hip_atomic_load(p, __ATOMIC_RELAXED, __HIP_MEMORY_SCOPE_AGENT); }
__device__ __forceinline__ unsigned xb_add(unsigned* p, unsigned v) { return __hip_atomic_fetch_add(p, v, __ATOMIC_RELAXED, __HIP_MEMORY_SCOPE_AGENT); }
__device__ __forceinline__ unsigned xb_xcc_id() { return (unsigned)__builtin_amdgcn_s_getreg((3 << 11) | 20) & 0xFu; }
#define XB_SPIN(cond, bar) do { unsigned _sp = 0; while (cond) { __builtin_amdgcn_s_sleep(1); \
    if ((++_sp & 255u) == 0u) { if (xb_ld(&(bar)[XB_TMO])) break; if (_sp > XB_SPIN_CAP) { atomicAdd(&(bar)[XB_TMO], 1u); break; } } } } while (0)

struct XcdBarrier {
    unsigned* bar; unsigned x;
    volatile LAS unsigned* st;
};

__device__ __forceinline__ XcdBarrier xcd_barrier_post(unsigned* bar, volatile LAS unsigned* st) {
    XcdBarrier b; b.bar = bar; b.x = xb_xcc_id(); b.st = st;
    if (threadIdx.x == 0) (void)xb_add(&bar[XB_XCNT(b.x)], 1u);
    return b;
}
__device__ __forceinline__ void xcd_barrier_complete(unsigned* bar, unsigned x, unsigned& nloc, unsigned& nx) {
    const unsigned G = gridDim.x * gridDim.y * gridDim.z;
    unsigned sum, cnt, mine, sp = 0u;
    for (;;) {
        sum = 0u; cnt = 0u; mine = 0u;
#pragma unroll
        for (unsigned j = 0; j < 16; ++j) { const unsigned c = xb_ld(&bar[XB_XCNT(j)]); sum += c; cnt += (c > 0u) ? 1u : 0u; mine = (j == x) ? c : mine; }
        if (sum == G) break;
        __builtin_amdgcn_s_sleep(1);
        if ((++sp & 255u) == 0u) { if (xb_ld(&bar[XB_TMO])) break; if (sp > XB_SPIN_CAP) { atomicAdd(&bar[XB_TMO], 1u); break; } }
    }
    nloc = mine > 0u ? mine : 1u; nx = cnt > 0u ? cnt : 1u;
}

__device__ __forceinline__ void xcd_barrier(const XcdBarrier& b) {
    asm volatile("s_waitcnt vmcnt(0)" ::: "memory");
    __syncthreads();
    if (threadIdx.x == 0) {
        unsigned* bar = b.bar;
        __builtin_amdgcn_s_waitcnt(0);
        unsigned nloc = b.st[0], nx = b.st[1];
        if (nloc == 0u) { xcd_barrier_complete(bar, b.x, nloc, nx); b.st[0] = nloc; b.st[1] = nx; }
        const unsigned old = xb_add(&bar[XB_XSUB(b.x)], 1u);
        const unsigned gen = old / nloc;
        if (old + 1u == (gen + 1u) * nloc) {
            __builtin_amdgcn_fence(__ATOMIC_RELEASE, "agent");
            asm volatile("s_waitcnt vmcnt(0)" ::: "memory");
            const unsigned og = xb_add(&bar[XB_TOP], 1u);
            const unsigned tg = og / nx;
            if (og + 1u == (tg + 1u) * nx) xb_add(&bar[XB_TOPGEN], 1u);
            else XB_SPIN(xb_ld(&bar[XB_TOPGEN]) == tg, bar);
            __builtin_amdgcn_fence(__ATOMIC_ACQUIRE, "agent");
            xb_add(&bar[XB_XGEN(b.x)], 1u);
            asm volatile("s_waitcnt vmcnt(0)" ::: "memory");
        } else {
            XB_SPIN(xb_ld(&bar[XB_XGEN(b.x)]) == gen, bar);
            __builtin_amdgcn_fence(__ATOMIC_ACQUIRE, "agent");
            asm volatile("s_waitcnt vmcnt(0)" ::: "memory");
        }
    }
    __syncthreads();
}


typedef short bf16x8 __attribute__((ext_vector_type(8)));
typedef short s16x4 __attribute__((ext_vector_type(4)));
constexpr int AT_NS = 4, AT_SLOT = 8192, AT_K = 0, AT_V = AT_NS * AT_SLOT, AT_PSLC = 2 * AT_NS * AT_SLOT  , AT_MASK = AT_PSLC + 32768  , AT_FLAG = AT_MASK + 1024  ;
#define AT_WAIT_BAR(N) asm volatile("s_waitcnt vmcnt(" #N ") lgkmcnt(0)\n\ts_barrier" ::: "memory")
__device__ __forceinline__ int crow(int r, int hi) { return (r & 3) + 8 * (r >> 2) + 4 * hi; }
#define CROW0(r) (((r) & 3) + 8 * ((r) >> 2))
__device__ __forceinline__ float fexp2(float x) { return __builtin_amdgcn_exp2f(x); }
__device__ __forceinline__ float flog2(float x) { return __builtin_amdgcn_logf(x); }
__device__ __forceinline__ unsigned cvtpk(float lo, float hi) { f32x2 v = {lo, hi}; typedef __bf16 bf2 __attribute__((ext_vector_type(2))); bf2 b = __builtin_convertvector(v, bf2); return __builtin_bit_cast(unsigned, b); }
__device__ __forceinline__ float swap_get(float x) { auto r = __builtin_amdgcn_permlane32_swap(__float_as_uint(x), __float_as_uint(x), false, false); return (threadIdx.x & 32) ? __uint_as_float(r[0]) : __uint_as_float(r[1]); }
__device__ __forceinline__ float quad_sum(float x) {
    x += __builtin_bit_cast(float, __builtin_amdgcn_update_dpp(0, __builtin_bit_cast(int, x), 0xB1  , 0xF, 0xF, true));
    x += __builtin_bit_cast(float, __builtin_amdgcn_update_dpp(0, __builtin_bit_cast(int, x), 0x4E  , 0xF, 0xF, true));
    return x;
}
struct KVTile { const bf16_t* k; const bf16_t* v; int pitch; };
__device__ __forceinline__ void glds16(const void* gbase_uniform, unsigned voff, unsigned lds_dst) { unsigned keep;
    const unsigned long long a = (unsigned long long)gbase_uniform;
    const unsigned long long sb = (unsigned long long)(unsigned)__builtin_amdgcn_readfirstlane((unsigned)a) | ((unsigned long long)(unsigned)__builtin_amdgcn_readfirstlane((unsigned)(a >> 32)) << 32);
    asm volatile("s_nop 4\n\ts_mov_b32 %0, m0\n\ts_mov_b32 m0, %3\n\ts_nop 0\n\tglobal_load_lds_dwordx4 %1, %2\n\ts_mov_b32 m0, %0" : "=&s"(keep) : "v"(voff), "s"(sb), "s"(lds_dst) : "memory"); }
__device__ __forceinline__ void dma_kv(LAS unsigned char* lds, const KVTile& s, int key0, int slot, int wid, int lane) {
    const int kl_ = ((lane >> 5) & 1) * 4 + ((lane >> 2) & 3), c_ = 4 * ((lane >> 4) & 1) + (((lane & 3) - wid) & 3);
    const unsigned koff = (unsigned)(((8 * wid + kl_) * s.pitch + c_ * 8) * 2);
    const unsigned voff = (unsigned)(((16 * (wid & 3) + (lane >> 2)) * s.pitch + (wid >> 2) * 32 + (lane & 3) * 8) * 2);
    const unsigned base = (unsigned)(uintptr_t)lds;
    glds16(s.k + (size_t)key0 * s.pitch, koff, (unsigned)__builtin_amdgcn_readfirstlane(base + AT_K + slot * AT_SLOT + wid * 1024));
    glds16(s.v + (size_t)key0 * s.pitch, voff, (unsigned)__builtin_amdgcn_readfirstlane(base + AT_V + slot * AT_SLOT + wid * 1024));
}
__device__ __forceinline__ void qkt(f32x16& p0, f32x16& p1, const LAS unsigned char* kslot, const bf16x8 (&qf)[4], const f32x16& cv, int lane) {
    const int q_ = lane & 31, j_ = q_ >> 3, r0_ = (j_ + (lane >> 5)) & 3;
    const LAS unsigned char* kb = kslot + j_ * 1024 + ((q_ >> 2) & 1) * 512 + (q_ & 3) * 64;
    const LAS unsigned char* ka0 = kb + 16 * r0_; const LAS unsigned char* ka1 = kb + 16 * (r0_ ^ 2);
    bf16x8 kf[8];
#pragma unroll
    for (int d0 = 0; d0 < 4; ++d0) { const LAS unsigned char* kp = ((d0 & 1) ? ka1 : ka0) + (d0 >> 1) * 256; kf[2 * d0] = *(const LAS bf16x8*)kp; kf[2 * d0 + 1] = *(const LAS bf16x8*)(kp + 4096); }
    p0 = __builtin_amdgcn_mfma_f32_32x32x16_bf16(kf[0], qf[0], cv, 0, 0, 0);
    p1 = __builtin_amdgcn_mfma_f32_32x32x16_bf16(kf[1], qf[0], cv, 0, 0, 0);
#pragma unroll
    for (int d0 = 1; d0 < 4; ++d0) {
        p0 = __builtin_amdgcn_mfma_f32_32x32x16_bf16(kf[2 * d0], qf[d0], p0, 0, 0, 0);
        p1 = __builtin_amdgcn_mfma_f32_32x32x16_bf16(kf[2 * d0 + 1], qf[d0], p1, 0, 0, 0);
    }
}
struct VFrag { s16x4 lo[8], hh[8]; };
__device__ __forceinline__ void vload(VFrag& vf, const LAS unsigned char* vslot, int lane) {
    const int hi = lane >> 5;
    const unsigned vb = (unsigned)(uintptr_t)vslot + ((lane >> 4) & 1) * 32 + (lane & 3) * 8 + (4 * hi + ((lane & 15) >> 2)) * 64;
#pragma unroll
    for (int i = 0; i < 8; ++i) { const int d0 = i >> 2, ks = i & 3;
        asm volatile("ds_read_b64_tr_b16 %0, %1 offset:%c2" : "=&v"(vf.lo[i]) : "v"(vb), "i"(d0 * 4096 + ks * 1024) : "memory");
        asm volatile("ds_read_b64_tr_b16 %0, %1 offset:%c2" : "=&v"(vf.hh[i]) : "v"(vb), "i"(d0 * 4096 + ks * 1024 + 512) : "memory"); }
}
__device__ __forceinline__ void pvmm(f32x16 (&oT)[2], const VFrag& vf, const f32x16& p0, const f32x16& p1) {
    bf16x8 pb[4];
#pragma unroll
    for (int ks = 0; ks < 4; ++ks) { const f32x16& p = (ks < 2) ? p0 : p1; const int b = (ks & 1) * 8;
        u32x4 w; w.x = cvtpk(p[b], p[b + 1]); w.y = cvtpk(p[b + 2], p[b + 3]); w.z = cvtpk(p[b + 4], p[b + 5]); w.w = cvtpk(p[b + 6], p[b + 7]); pb[ks] = __builtin_bit_cast(bf16x8, w); }
#pragma unroll
    for (int i = 0; i < 8; ++i) { const int d0 = i >> 2, ks = i & 3;
        const bf16x8 v = (bf16x8){vf.lo[i][0], vf.lo[i][1], vf.lo[i][2], vf.lo[i][3], vf.hh[i][0], vf.hh[i][1], vf.hh[i][2], vf.hh[i][3]};
        oT[d0] = __builtin_amdgcn_mfma_f32_32x32x16_bf16(v, pb[ks], oT[d0], 0, 0, 0); }
}
#define AT_VWAIT() do { asm volatile("s_waitcnt lgkmcnt(0)" ::: "memory"); __builtin_amdgcn_sched_barrier(0); } while (0)
__device__ __forceinline__ float max3f(float a, float b, float c) { float r; asm("v_max3_f32 %0, %1, %2, %3" : "=v"(r) : "v"(a), "v"(b), "v"(c)); return r; }
__device__ __forceinline__ float rowmax32(const f32x16& p0, const f32x16& p1) {
    float a = max3f(p0[0], p0[1], p1[0]), b = max3f(p0[2], p0[3], p1[1]); a = max3f(a, p1[2], p1[3]);
#pragma unroll
    for (int r = 4; r < 16; r += 4) { a = max3f(a, p0[r], p0[r + 1]); b = max3f(b, p0[r + 2], p0[r + 3]); a = max3f(a, p1[r], p1[r + 1]); b = max3f(b, p1[r + 2], p1[r + 3]); }
    const float m = fmaxf(a, b);
    return fmaxf(m, swap_get(m));
}
constexpr float NEG = -1.0e30f, SM_THR = 8.f, SM_BIG = 16777216.f;
struct SmState { float negm, l; bool mset, allset; };
__device__ __forceinline__ void sm_init(SmState& st) { st.negm = 0.f; st.l = 0.f; st.mset = false; st.allset = false; }
__device__ __forceinline__ f32x16 splat16(float v) { f32x16 c;
#pragma unroll
    for (int r = 0; r < 16; ++r) c[r] = v;
    return c; }
template <bool HAS_O> __device__ __forceinline__ void softmax_tile(f32x16& p0, f32x16& p1, SmState& st, f32x16 (&oT)[2]) {
    asm volatile("s_nop 7\n\ts_nop 7\n\ts_nop 7" : "+v"(p0), "+v"(p1));
    const float rm = rowmax32(p0, p1);
    const bool need = (rm > SM_THR) || (!st.mset && rm > -1.0e29f);
    if (__any(need)) {
        const float delta = need ? rm : 0.f; const float f = need ? (st.mset ? fexp2(-delta) : 0.f) : 1.f;
        st.negm -= delta; st.l *= f; st.mset = st.mset || need;
#pragma unroll
        for (int r = 0; r < 16; ++r) { p0[r] -= delta; p1[r] -= delta; if (HAS_O) { oT[0][r] *= f; oT[1][r] *= f; } }
    }
    float s0 = 0.f, s1 = 0.f;
#pragma unroll
    for (int r = 0; r < 16; ++r) { p0[r] = fexp2(p0[r]); p1[r] = fexp2(p1[r]); s0 += p0[r]; s1 += p1[r]; }
    st.l += s0 + s1;
    st.allset = __all(st.mset);
}
__device__ __forceinline__ bool softmax_fast(f32x16& p0, f32x16& p1, SmState& st) {
    float s0 = 0.f, s1 = 0.f;
#pragma unroll
    for (int r = 0; r < 16; ++r) { p0[r] = fexp2(p0[r]); p1[r] = fexp2(p1[r]); s0 += p0[r]; asm("" : "+v"(s0)); s1 += p1[r]; asm("" : "+v"(s1)); }
    const float sum = s0 + s1;
    if (__any(!(sum < SM_BIG))) return false;
    st.l += sum; return true;
}
__device__ __forceinline__ void load_q(bf16x8 (&qf)[4], const bf16_t* qrow, int lane) {
#pragma unroll
    for (int d0 = 0; d0 < 4; ++d0) qf[d0] = *(const bf16x8*)(qrow + d0 * 16 + (lane >> 5) * 8);
    asm volatile("" : "+v"(qf[0]), "+v"(qf[1]), "+v"(qf[2]), "+v"(qf[3]));
}
__device__ __forceinline__ int next_item(int* head, LAS unsigned char* lds) {
    LAS int* slot = (LAS int*)(lds + AT_FLAG + 128);
    __syncthreads();
    if (threadIdx.x == 0) slot[0] = atomicAdd(head, 1);
    __syncthreads();
    return slot[0];
}

#define QPREFETCH(head) int q_nx_ = 0; if (threadIdx.x == 0) q_nx_ = atomicAdd((head), 1)
#define QADVANCE(cur, lds) do { LAS int* q_slot_ = (LAS int*)((lds) + AT_FLAG + 128); if (threadIdx.x == 0) q_slot_[0] = q_nx_; \
        asm volatile("s_waitcnt lgkmcnt(0)\n\ts_barrier" ::: "memory"); (cur) = q_slot_[0]; asm volatile("s_waitcnt lgkmcnt(0)\n\ts_barrier" ::: "memory"); } while (0)

__device__ __forceinline__ void win_item(int item, const bf16_t* NQ, const bf16_t* KW, const bf16_t* VW, const float* NG, float* YPART, LAS unsigned char* lds) {
    const int tid = threadIdx.x, lane = tid & 63, wid = __builtin_amdgcn_readfirstlane(tid >> 6), hi = lane >> 5, q = lane & 31;
    const int qb = item & 127, bg = item >> 7, b = bg >> 1, g = bg & 1;
    const size_t rowbase = (size_t)b * SEQ; const int t0 = qb * 64, tl = wid * 8 + (q >> 2), t = t0 + tl, hq = g * 4 + (q & 3);
    const KVTile kv{KW + rowbase * 128 + g * 64, VW + rowbase * 128 + g * 64, 128};
    bf16x8 qf[4]; load_q(qf, NQ + (rowbase + t) * 512 + hq * 64, lane);
    const int T1 = qb, T0 = (qb >= 8) ? qb - 8 : 0, NT = T1 - T0 + 1;
    f32x16 oT[2]; SmState st; sm_init(st);
#pragma unroll
    for (int r = 0; r < 16; ++r) { oT[0][r] = 0.f; oT[1][r] = 0.f; }
    dma_kv(lds, kv, T0 * 64, 0, wid, lane);
    if (NT > 1) dma_kv(lds, kv, (T0 + 1) * 64, 1, wid, lane);
    for (int i = 0; i < NT; ++i) {
        if (i + 1 < NT) { AT_WAIT_BAR(2); } else { AT_WAIT_BAR(0); }
        if (i + 2 < NT) dma_kv(lds, kv, (T0 + i + 2) * 64, (i + 2) % 3, wid, lane);
        const int T = T0 + i, slot = i % 3;
        f32x16 p0, p1; qkt(p0, p1, lds + AT_K + slot * AT_SLOT, qf, splat16(st.negm), lane);
        VFrag vf; vload(vf, lds + AT_V + slot * AT_SLOT, lane);
        if (T == T1 || T == qb - 8) {
            const int lo_ = t - 511 - T * 64 - 4 * hi, hi_ = t - T * 64 - 4 * hi;
#pragma unroll
            for (int r = 0; r < 16; ++r) { if (CROW0(r) < lo_ || CROW0(r) > hi_) p0[r] = NEG; if (CROW0(r) + 32 < lo_ || CROW0(r) + 32 > hi_) p1[r] = NEG; }
        }
        softmax_tile<true>(p0, p1, st, oT);
        AT_VWAIT(); pvmm(oT, vf, p0, p1);
    }
    const float l = st.l + swap_get(st.l);
    const float sc = NG[(rowbase + t) * 24 + hq * 3 + 2] / l;
    float* yp = YPART + (rowbase + t) * 512 + hq * 64;
#pragma unroll
    for (int d0 = 0; d0 < 2; ++d0)
#pragma unroll
        for (int c = 0; c < 4; ++c) *(f32x4*)(yp + d0 * 32 + 8 * c + 4 * hi) = (f32x4){oT[d0][4 * c] * sc, oT[d0][4 * c + 1] * sc, oT[d0][4 * c + 2] * sc, oT[d0][4 * c + 3] * sc};
    asm volatile("s_waitcnt lgkmcnt(0)\n\ts_barrier" ::: "memory");
}

__device__ __forceinline__ void cmpsel_item(int item, const bf16_t* NQ, const bf16_t* KCMP, const bf16_t* VCMP, const bf16_t* KS, const bf16_t* VS, const bf16_t* KW, const bf16_t* VW, const float* NG,
                                            const float* YPART, bf16_t* YNSA, LAS unsigned char* lds, unsigned long long* istamp = nullptr) {
    const int tid = threadIdx.x, lane = tid & 63, wid = __builtin_amdgcn_readfirstlane(tid >> 6), hi = lane >> 5, q = lane & 31;
    const int qb = 127 - (item & 127), bg = item >> 7, b = bg >> 1, g = bg & 1;
    const size_t rowbase = (size_t)b * SEQ; const int t0 = qb * 64, tl = wid * 8 + (q >> 2), t = t0 + tl, hq = g * 4 + (q & 3);
    LAS float* pslc = (LAS float*)(lds + AT_PSLC); LAS unsigned* msk = (LAS unsigned*)(lds + AT_MASK); LAS unsigned* flg = (LAS unsigned*)(lds + AT_FLAG);
#ifdef PROBE_ITEM
#define ISTAMP(i) do { if (istamp && threadIdx.x == 0) istamp[i] = __builtin_amdgcn_s_memrealtime(); } while (0)
#else
#define ISTAMP(i) do { } while (0)
#endif
    ISTAMP(0);
    float g_c = NG[(rowbase + t) * 24 + hq * 3 + 0], g_s = NG[(rowbase + t) * 24 + hq * 3 + 1], g_w = NG[(rowbase + t) * 24 + hq * 3 + 2];
    bf16x8 qf[4]; load_q(qf, NQ + (rowbase + t) * 512 + hq * 64, lane);
    asm volatile("" : "+v"(g_c), "+v"(g_s), "+v"(g_w));
    const KVTile kvc{KCMP + (size_t)bg * 512 * 64, VCMP + (size_t)bg * 512 * 64, 64};
    const KVTile kvs{KS + rowbase * 128 + g * 64, VS + rowbase * 128 + g * 64, 128};
    f32x16 oT[2]; SmState st;
    {
        const KVTile kvw{KW + rowbase * 128 + g * 64, VW + rowbase * 128 + g * 64, 128};
        const int T1 = qb, T0 = (qb >= 8) ? qb - 8 : 0, NT = T1 - T0 + 1;
        sm_init(st);
#pragma unroll
        for (int r = 0; r < 16; ++r) { oT[0][r] = 0.f; oT[1][r] = 0.f; }
        dma_kv(lds, kvw, T0 * 64, 0, wid, lane);
        if (NT > 1) dma_kv(lds, kvw, (T0 + 1) * 64, 1, wid, lane);
        if (NT > 2) dma_kv(lds, kvw, (T0 + 2) * 64, 2, wid, lane);
        for (int i = 0; i < NT; ++i) {
            if (i + 2 < NT) { AT_WAIT_BAR(4); } else if (i + 1 < NT) { AT_WAIT_BAR(2); } else { AT_WAIT_BAR(0); }
            if (i + 3 < NT) dma_kv(lds, kvw, (T0 + i + 3) * 64, (i + 3) % AT_NS, wid, lane);
            const int T = T0 + i, slot = i % AT_NS;
            f32x16 p0, p1; VFrag vf;
            for (bool exact = !st.allset;; exact = true) {
                qkt(p0, p1, lds + AT_K + slot * AT_SLOT, qf, splat16(st.negm), lane);
                vload(vf, lds + AT_V + slot * AT_SLOT, lane);
                if (T == T1 || T == qb - 8) {
                    const int lo_ = t - 511 - T * 64 - 4 * hi, hi_ = t - T * 64 - 4 * hi;
#pragma unroll
                    for (int r = 0; r < 16; ++r) { if (CROW0(r) < lo_ || CROW0(r) > hi_) p0[r] = NEG; if (CROW0(r) + 32 < lo_ || CROW0(r) + 32 > hi_) p1[r] = NEG; }
                }
                if (exact) { softmax_tile<true>(p0, p1, st, oT); break; }
                if (softmax_fast(p0, p1, st)) break;
            }
            AT_VWAIT(); pvmm(oT, vf, p0, p1);
        }
        const float lw = st.l + swap_get(st.l);
        const float scw = g_w / lw;
#pragma unroll
        for (int r = 0; r < 16; ++r) { oT[0][r] *= scw; oT[1][r] *= scw; }
        asm volatile("s_waitcnt lgkmcnt(0)\n\ts_barrier" ::: "memory");
        dma_kv(lds, kvs, 0, 3, wid, lane);
    }
    ISTAMP(1);
    const int nv = (t >= 31) ? ((t - 31) >> 4) + 1 : 0;
    const int tw = t0 + wid * 8; const int nvw = (tw >= 31) ? ((tw - 31) >> 4) + 1 : 0;
    const int nvmax = (t0 + 63 >= 31) ? ((t0 + 63 - 31) >> 4) + 1 : 0, NTc = (nvmax + 63) >> 6;
    if (tid < 8) flg[tid] = 0u;
    float lc = 0.f, inv = 0.f;
    sm_init(st);
    {
        dma_kv(lds, kvc, 0, 0, wid, lane); if (NTc > 1) dma_kv(lds, kvc, 64, 1, wid, lane);
        for (int i = 0; i < NTc; ++i) {
            if (i + 1 < NTc) { AT_WAIT_BAR(2); } else { AT_WAIT_BAR(0); }
            if (i + 2 < NTc) dma_kv(lds, kvc, (i + 2) * 64, (i + 2) % 3, wid, lane);
            f32x16 p0, p1;
            for (bool exact = !st.allset;; exact = true) {
                qkt(p0, p1, lds + AT_K + (i % 3) * AT_SLOT, qf, splat16(st.negm), lane);
                if (i * 64 + 64 > nvw) { const int lim = nv - i * 64 - 4 * hi;
#pragma unroll
                    for (int r = 0; r < 16; ++r) { if (CROW0(r) >= lim) p0[r] = NEG; if (CROW0(r) + 32 >= lim) p1[r] = NEG; } }
                if (exact) { softmax_tile<false>(p0, p1, st, oT); break; }
                if (softmax_fast(p0, p1, st)) break;
            }
        }
        asm volatile("s_waitcnt lgkmcnt(0)\n\ts_barrier" ::: "memory");
    }
    lc = st.l + swap_get(st.l);
    inv = (nv > 0) ? 1.f / lc : 0.f;
    const float ccmp = fmaxf(g_c * inv, 1e-20f);
    { const float rc = 1.f / ccmp;
#pragma unroll
      for (int r = 0; r < 16; ++r) { oT[0][r] *= rc; oT[1][r] *= rc; } }
    {
        float carryB = 0.f;
        dma_kv(lds, kvc, 0, 0, wid, lane); if (NTc > 1) dma_kv(lds, kvc, 64, 1, wid, lane);
        for (int i = 0; i < NTc; ++i) {
            if (i + 1 < NTc) { AT_WAIT_BAR(2); } else { AT_WAIT_BAR(0); }
            if (i + 2 < NTc) dma_kv(lds, kvc, (i + 2) * 64, (i + 2) % 3, wid, lane);
            f32x16 p0, p1; qkt(p0, p1, lds + AT_K + (i % 3) * AT_SLOT, qf, splat16(st.negm), lane);
            VFrag vf; vload(vf, lds + AT_V + (i % 3) * AT_SLOT, lane);
            if (i * 64 + 64 > nvw) { const int lim = nv - i * 64 - 4 * hi;
#pragma unroll
                for (int r = 0; r < 16; ++r) { if (CROW0(r) >= lim) p0[r] = NEG; if (CROW0(r) + 32 >= lim) p1[r] = NEG; } }
#pragma unroll
            for (int r = 0; r < 16; ++r) { p0[r] = fexp2(p0[r]); p1[r] = fexp2(p1[r]); }
            AT_VWAIT(); pvmm(oT, vf, p0, p1);
            { float Aq[2][4], PB[2][4];
#pragma unroll
              for (int kh = 0; kh < 2; ++kh)
#pragma unroll
                  for (int c = 0; c < 4; ++c) { const f32x16& p = kh ? p1 : p0;
                      Aq[kh][c] = quad_sum(((p[4 * c] + p[4 * c + 1]) + (p[4 * c + 2] + p[4 * c + 3])) * inv); PB[kh][c] = swap_get(quad_sum(p[4 * c + 3] * inv)); }
#pragma unroll
              for (int kh = 0; kh < 2; ++kh)
#pragma unroll
                  for (int c = 0; c < 4; ++c) { const float prevB = hi ? PB[kh][c] : (c ? PB[kh][c ? c - 1 : 0] : (kh ? PB[0][3] : carryB));
                      const int j = 16 * i + 8 * kh + 2 * c + hi;
                      if ((q & 3) == 0 && j < 128) pslc[tl * 128 + j] = Aq[kh][c] + prevB; }
              carryB = PB[1][3]; }
        }
        asm volatile("s_waitcnt lgkmcnt(0)\n\ts_barrier" ::: "memory");
    }
    f32x16 yp[2];
#pragma unroll
    for (int r = 0; r < 16; ++r) { yp[0][r] = oT[0][r] * ccmp; yp[1][r] = oT[1][r] * ccmp; oT[0][r] = 0.f; oT[1][r] = 0.f; }
    ISTAMP(2);
    asm volatile("s_waitcnt lgkmcnt(0)" ::: "memory");
    unsigned long long ulo = 0ull, uhi = 0ull;
    for (int tk = 0; tk < 8; ++tk) {
        const int row = wid * 8 + tk; const int j0 = lane, j1 = lane + 64;
        const bool f0 = (j0 == 0) || (j0 == qb) || (j0 == qb - 1), f1 = (j1 == qb) || (j1 == qb - 1);
        unsigned long long mlo, mhi;
        if (qb < 16) { mlo = __ballot(j0 <= qb); mhi = 0ull; }
        else {
            const unsigned k0 = (!f0 && j0 <= qb) ? __float_as_uint(pslc[row * 128 + j0]) + 1u : 0u, k1 = (!f1 && j1 <= qb) ? __float_as_uint(pslc[row * 128 + j1]) + 1u : 0u;
            unsigned T = 0u;
            for (int bit = 31; bit >= 0; --bit) { const unsigned cand = T | (1u << bit);
                const int cnt = __popcll(__ballot(k0 >= cand)) + __popcll(__ballot(k1 >= cand)); if (cnt >= 13) T = cand;
                if (cnt == 13) break; }
            const bool gt0 = k0 > T, gt1 = k1 > T, eq0 = (k0 == T), eq1 = (k1 == T);
            const unsigned long long be0 = __ballot(eq0), be1 = __ballot(eq1);
            const int rem = 13 - (__popcll(__ballot(gt0)) + __popcll(__ballot(gt1)));
            const unsigned long long below = (lane == 0) ? 0ull : (~0ull >> (64 - lane));
            const int pre0 = __popcll(be0 & below), pre1 = __popcll(be0) + __popcll(be1 & below);
            mlo = __ballot(f0 || gt0 || (eq0 && pre0 < rem)); mhi = __ballot(f1 || gt1 || (eq1 && pre1 < rem));
        }
        ulo |= mlo; uhi |= mhi;
        if (lane == 0) { msk[row * 4 + 0] = (unsigned)mlo; msk[row * 4 + 1] = (unsigned)(mlo >> 32); msk[row * 4 + 2] = (unsigned)mhi; msk[row * 4 + 3] = (unsigned)(mhi >> 32); }
    }
    if (lane == 0) { (void)__hip_atomic_fetch_or(&flg[0], (unsigned)ulo, __ATOMIC_RELAXED, __HIP_MEMORY_SCOPE_WORKGROUP); (void)__hip_atomic_fetch_or(&flg[1], (unsigned)(ulo >> 32), __ATOMIC_RELAXED, __HIP_MEMORY_SCOPE_WORKGROUP);
                     (void)__hip_atomic_fetch_or(&flg[2], (unsigned)uhi, __ATOMIC_RELAXED, __HIP_MEMORY_SCOPE_WORKGROUP); (void)__hip_atomic_fetch_or(&flg[3], (unsigned)(uhi >> 32), __ATOMIC_RELAXED, __HIP_MEMORY_SCOPE_WORKGROUP); }
    asm volatile("s_waitcnt lgkmcnt(0)\n\ts_barrier" ::: "memory");
    const unsigned mk0 = msk[tl * 4 + 0], mk1 = msk[tl * 4 + 1], mk2 = msk[tl * 4 + 2], mk3 = msk[tl * 4 + 3];
    unsigned long long blo = ((unsigned long long)flg[1] << 32) | flg[0], bhi = ((unsigned long long)flg[3] << 32) | flg[2];
    blo = (unsigned long long)(unsigned)__builtin_amdgcn_readfirstlane((unsigned)blo) | ((unsigned long long)(unsigned)__builtin_amdgcn_readfirstlane((unsigned)(blo >> 32)) << 32);
    bhi = (unsigned long long)(unsigned)__builtin_amdgcn_readfirstlane((unsigned)bhi) | ((unsigned long long)(unsigned)__builtin_amdgcn_readfirstlane((unsigned)(bhi >> 32)) << 32);
    ISTAMP(3);
    auto nextbit = [&](int from) -> int {
        if (from < 64) { const unsigned long long x = blo & (~0ull << from); if (x) return __builtin_ctzll(x); from = 64; }
        if (from < 128) { const unsigned long long x = bhi & (~0ull << (from - 64)); if (x) return 64 + __builtin_ctzll(x); }
        return 128; };
    sm_init(st);
    const int tlh = tl - 4 * hi;
    int jc = nextbit(0), jn = nextbit(jc + 1), jnn = (jn < 128) ? nextbit(jn + 1) : 128, jn3 = (jnn < 128) ? nextbit(jnn + 1) : 128, i = 0;
    if (jn < 128) dma_kv(lds, kvs, jn * 64, 0, wid, lane); if (jnn < 128) dma_kv(lds, kvs, jnn * 64, 1, wid, lane);
    while (jc < 128) {
        if (jnn < 128) { AT_WAIT_BAR(4); } else if (jn < 128) { AT_WAIT_BAR(2); } else { AT_WAIT_BAR(0); }
        if (jn3 < 128) dma_kv(lds, kvs, jn3 * 64, (i + 2) % AT_NS, wid, lane);
        const bool wave_needs = (jc < 64) ? ((ulo >> jc) & 1ull) : ((uhi >> (jc - 64)) & 1ull);
        if (wave_needs) {
            const unsigned w = (jc < 32) ? mk0 : (jc < 64) ? mk1 : (jc < 96) ? mk2 : mk3;
            const bool mine = (w >> (jc & 31)) & 1u;
            f32x16 p0, p1; VFrag vf;
            for (bool exact = !st.allset;; exact = true) {
                qkt(p0, p1, lds + AT_K + ((i + 3) % AT_NS) * AT_SLOT, qf, splat16(mine ? st.negm : NEG), lane);
                vload(vf, lds + AT_V + ((i + 3) % AT_NS) * AT_SLOT, lane);
                if (jc == qb) {
#pragma unroll
                    for (int r = 0; r < 16; ++r) { if (CROW0(r) > tlh) p0[r] = NEG; if (CROW0(r) + 32 > tlh) p1[r] = NEG; } }
                if (exact) { softmax_tile<true>(p0, p1, st, oT); break; }
                if (softmax_fast(p0, p1, st)) break;
            }
            AT_VWAIT(); pvmm(oT, vf, p0, p1);
        }
        jc = jn; jn = jnn; jnn = jn3; jn3 = (jn3 < 128) ? nextbit(jn3 + 1) : 128; ++i;
    }
    ISTAMP(4);
    const float l = st.l + swap_get(st.l);
    const float sc = g_s / l;
    bf16_t* yo = YNSA + (rowbase + t) * 512 + hq * 64;
#pragma unroll
    for (int d0 = 0; d0 < 2; ++d0)
#pragma unroll
        for (int c = 0; c < 4; ++c) {
            u32x2 o; o.x = cvtpk(yp[d0][4 * c] + oT[d0][4 * c] * sc, yp[d0][4 * c + 1] + oT[d0][4 * c + 1] * sc);
            o.y = cvtpk(yp[d0][4 * c + 2] + oT[d0][4 * c + 2] * sc, yp[d0][4 * c + 3] + oT[d0][4 * c + 3] * sc);
            *(u32x2*)(yo + d0 * 32 + 8 * c + 4 * hi) = o; }
    asm volatile("s_waitcnt lgkmcnt(0)\n\ts_barrier" ::: "memory");
}

constexpr float SB_THR = 48.f;
__device__ __forceinline__ void sb_item(int item, const bf16_t* SBQ, const bf16_t* SBK, const bf16_t* SBV, bf16_t* YSB, LAS unsigned char* lds) {
    const int tid = threadIdx.x, lane = tid & 63, wid = __builtin_amdgcn_readfirstlane(tid >> 6), hi = lane >> 5, q = lane & 31;
    const int qblk = 31 - (item & 31), bh = item >> 5, b = bh >> 3, h = bh & 7;
    const size_t rowbase = (size_t)b * SEQ; const int q0 = qblk * 256, tw0 = q0 + 32 * wid, t = tw0 + q;
    LAS unsigned* flg = (LAS unsigned*)(lds + AT_FLAG);
    const KVTile kv{SBK + rowbase * 512 + h * 64, SBV + rowbase * 512 + h * 64, 512};
    bf16x8 qf[4]; load_q(qf, SBQ + (rowbase + t) * 512 + h * 64, lane);
    f32x16 oT[2];
#pragma unroll
    for (int r = 0; r < 16; ++r) { oT[0][r] = 0.f; oT[1][r] = 0.f; }
    float carry = 0.f; bool wdone = false; f32x16 zv;
#pragma unroll
    for (int r = 0; r < 16; ++r) zv[r] = 0.f;
    const int Tmax = (q0 + 254) >> 6, NT = Tmax + 1;
    if (tid < 8) flg[tid] = 0u;
    dma_kv(lds, kv, Tmax * 64, 0, wid, lane); if (NT > 1) dma_kv(lds, kv, (Tmax - 1) * 64, 1, wid, lane);
    for (int i = 0; i < NT; ++i) {
        if (i + 1 < NT) { AT_WAIT_BAR(2); } else { AT_WAIT_BAR(0); }
        if ((flg[0] & flg[1] & flg[2] & flg[3] & flg[4] & flg[5] & flg[6] & flg[7]) != 0u) break;
        if (i + 2 < NT) dma_kv(lds, kv, (Tmax - i - 2) * 64, (i + 2) % 3, wid, lane);
        const int T = Tmax - i, slot = i % 3;
        if (!wdone && 64 * T <= tw0 + 30) {
            f32x16 p0, p1; qkt(p0, p1, lds + AT_K + slot * AT_SLOT, qf, zv, lane);
            const int lim = t - 64 * T - 4 * hi;
            f32x16 k0v, k1v;
#pragma unroll
            for (int r = 0; r < 16; ++r) {
                const int kl = CROW0(r);
                { const float z = fminf(p0[r], 64.f); const float sp = flog2(1.f + fexp2(z)); const bool v = kl < lim; k0v[r] = v ? -sp : 0.f; p0[r] = v ? z - sp : NEG; }
                { const float z = fminf(p1[r], 64.f); const float sp = flog2(1.f + fexp2(z)); const bool v = kl + 32 < lim; k1v[r] = v ? -sp : 0.f; p1[r] = v ? z - sp : NEG; }
            }
            float R = carry;
#pragma unroll
            for (int kh = 1; kh >= 0; --kh)
#pragma unroll
                for (int c = 3; c >= 0; --c) { const f32x16& kk = kh ? k1v : k0v; f32x16& pp = kh ? p1 : p0;
                    const float G = (kk[4 * c] + kk[4 * c + 1]) + (kk[4 * c + 2] + kk[4 * c + 3]); const float PG = swap_get(G);
                    const float S = R + (hi ? 0.f : PG);
                    const float w2 = kk[4 * c + 3], w1 = w2 + kk[4 * c + 2], w0 = w1 + kk[4 * c + 1];
                    pp[4 * c + 3] = fexp2(pp[4 * c + 3] + S); pp[4 * c + 2] = fexp2(pp[4 * c + 2] + S + w2); pp[4 * c + 1] = fexp2(pp[4 * c + 1] + S + w1); pp[4 * c] = fexp2(pp[4 * c] + S + w0);
                    R += G + PG; }
            carry = R;
            { VFrag vf; vload(vf, lds + AT_V + slot * AT_SLOT, lane); AT_VWAIT(); pvmm(oT, vf, p0, p1); }
            wdone = __all(carry < -SB_THR) || (T == 0);
            if (wdone && lane == 0) flg[wid] = 1u;
        }
    }
    asm volatile("s_waitcnt vmcnt(0) lgkmcnt(0)\n\ts_barrier" ::: "memory");
    bf16_t* yo = YSB + (rowbase + t) * 512 + h * 64;
#pragma unroll
    for (int d0 = 0; d0 < 2; ++d0)
#pragma unroll
        for (int c = 0; c < 4; ++c) { u32x2 o; o.x = cvtpk(oT[d0][4 * c], oT[d0][4 * c + 1]); o.y = cvtpk(oT[d0][4 * c + 2], oT[d0][4 * c + 3]); *(u32x2*)(yo + d0 * 32 + 8 * c + 4 * hi) = o; }
    asm volatile("s_waitcnt lgkmcnt(0)\n\ts_barrier" ::: "memory");
}

__device__ __forceinline__ void compress_wave(int witem, const bf16_t* src, const bf16_t* wt1, const bf16_t* w2t, const float* c1, bf16_t* out, int lane) {
    const int rb = witem & 15, bg = witem >> 4, b = bg >> 1, g = bg & 1, hi = lane >> 5, li = lane & 31;
    const int i = rb * 32 + li;
    const bool valid = i < NCMP;
    const bf16_t* xrow = src + ((size_t)b * SEQ + 16 * (valid ? i : 0)) * 128 + g * 64;
    f32x16 hT[2];
#pragma unroll
    for (int r = 0; r < 16; ++r) { hT[0][r] = 0.f; hT[1][r] = 0.f; }
#pragma unroll 4
    for (int s = 0; s < 128; ++s) {
        const int k = 16 * s + 8 * hi;
        const bf16x8 xb = *(const bf16x8*)(xrow + (size_t)(k >> 6) * 128 + (k & 63));
        const bf16x8 a0 = *(const bf16x8*)(wt1 + (size_t)li * 2048 + k), a1 = *(const bf16x8*)(wt1 + (size_t)(32 + li) * 2048 + k);
        hT[0] = __builtin_amdgcn_mfma_f32_32x32x16_bf16(a0, xb, hT[0], 0, 0, 0);
        hT[1] = __builtin_amdgcn_mfma_f32_32x32x16_bf16(a1, xb, hT[1], 0, 0, 0);
    }
    bf16x8 hb[4];
#pragma unroll
    for (int nb = 0; nb < 2; ++nb)
#pragma unroll
        for (int sh = 0; sh < 2; ++sh) { float v[8];
#pragma unroll
            for (int j = 0; j < 8; ++j) { const int r = 8 * sh + j; const float a = hT[nb][r] + c1[32 * nb + crow(r, hi)];
                const float c = 0.7978845608028654f * (a + 0.044715f * a * a * a); const float e = __expf(2.f * c); const float th = 1.f - 2.f / (e + 1.f); v[j] = 0.5f * a * (1.f + th); }
            u32x4 w; w.x = cvtpk(v[0], v[1]); w.y = cvtpk(v[2], v[3]); w.z = cvtpk(v[4], v[5]); w.w = cvtpk(v[6], v[7]); hb[nb * 2 + sh] = __builtin_bit_cast(bf16x8, w); }
    f32x16 oT[2];
#pragma unroll
    for (int r = 0; r < 16; ++r) { oT[0][r] = 0.f; oT[1][r] = 0.f; }
#pragma unroll
    for (int mb = 0; mb < 2; ++mb)
#pragma unroll
        for (int ks = 0; ks < 4; ++ks) {
            const bf16_t* wp = w2t + (size_t)(32 * mb + li) * 64 + 16 * ks + 4 * hi;
            const u32x2 lo = *(const u32x2*)wp, hh = *(const u32x2*)(wp + 8);
            const u32x4 w = {lo.x, lo.y, hh.x, hh.y};
            oT[mb] = __builtin_amdgcn_mfma_f32_32x32x16_bf16(__builtin_bit_cast(bf16x8, w), hb[ks], oT[mb], 0, 0, 0);
        }
    bf16_t* op = out + ((size_t)bg * 512 + i) * 64;
#pragma unroll
    for (int mb = 0; mb < 2; ++mb)
#pragma unroll
        for (int c = 0; c < 4; ++c) { u32x2 o; o.x = valid ? cvtpk(oT[mb][4 * c], oT[mb][4 * c + 1]) : 0u; o.y = valid ? cvtpk(oT[mb][4 * c + 2], oT[mb][4 * c + 3]) : 0u;
            *(u32x2*)(op + 32 * mb + 8 * c + 4 * hi) = o; }
}

struct AttnArgs { const bf16_t* sbq; const bf16_t* sbk; const bf16_t* sbv; const bf16_t* nq; const bf16_t* kv6; const float* ng; bf16_t* kcmp; bf16_t* vcmp;
                  bf16_t* ysb; bf16_t* ynsa; float* ypart; const bf16_t* wt1k; const bf16_t* wt1v; const bf16_t* w2tk; const bf16_t* w2tv; const float* c1k; const float* c1v; int* qhead;
                  const float* w_gu; const float* w_dn; bf16_t* wt_gu; bf16_t* wt_dn; };
__device__ __forceinline__ bool conv_chunk(const AttnArgs& a, LAS unsigned char* lds) {
    const int lane = threadIdx.x & 63, wid = __builtin_amdgcn_readfirstlane(threadIdx.x >> 6);
#ifdef PROBE_CONV2
    int cc = next_item(a.qhead + 40, lds); if (cc >= 2 * CONV_NCHUNK) return false; cc %= CONV_NCHUNK;
#else
    const int cc = next_item(a.qhead + 40, lds); if (cc >= CONV_NCHUNK) return false;
#endif
    convert_expert_weights(a.w_gu, a.w_dn, a.wt_gu, a.wt_dn, (LAS float*)(lds + wid * 16640), lane, cc * CONV_CHUNK + wid, NWAVES, (cc + 1) * CONV_CHUNK);
    asm volatile("s_waitcnt lgkmcnt(0)\n\ts_barrier" ::: "memory"); return true;
}
__device__ __forceinline__ void attn_phase1(const AttnArgs& a, LAS unsigned char* lds, int xcc) {
    const size_t S128 = (size_t)NTOK * 128; const int lane = threadIdx.x & 63, wid = __builtin_amdgcn_readfirstlane(threadIdx.x >> 6);
    for (;;) { const int it = next_item(a.qhead, lds); if (it >= 64) break;
        const int w = it * 8 + wid;
        if (w < 256) compress_wave(w, a.kv6 + 0 * S128, a.wt1k, a.w2tk, a.c1k, a.kcmp, lane); else compress_wave(w - 256, a.kv6 + 1 * S128, a.wt1v, a.w2tv, a.c1v, a.vcmp, lane);
        asm volatile("s_waitcnt vmcnt(0)" ::: "memory"); __syncthreads();
        if (threadIdx.x == 0) { __builtin_amdgcn_fence(__ATOMIC_RELEASE, "agent"); asm volatile("s_waitcnt vmcnt(0)" ::: "memory");
            (void)__hip_atomic_fetch_add((gu32*)(a.qhead + 48), 1u, __ATOMIC_RELAXED, __HIP_MEMORY_SCOPE_AGENT); } }
#ifndef REP_SB
#define REP_SB 1
#endif
#ifndef REP_WIN
#define REP_WIN 1
#endif
    { int nd = (int)((blockIdx.x >> 3) & 7);
      for (int pass = 0; pass < 8; ++pass) { const int x = (xcc + pass) & 7; int* h = a.qhead + 320 + 16 * x; int cur = next_item(h, lds);
        while (cur < 256) { QPREFETCH(h); sb_item(((8 * x + (cur & 7)) << 5) | (cur >> 3), a.sbq, a.sbk, a.sbv, a.ysb, lds); if ((++nd & 7) == 0) (void)conv_chunk(a, lds); QADVANCE(cur, lds); } } }
}
__device__ __forceinline__ void attn_phase2(const AttnArgs& a, LAS unsigned char* lds, int xcc) {
    const size_t S128 = (size_t)NTOK * 128;
    if (threadIdx.x == 0) { gu32* cd = (gu32*)(a.qhead + 48);
        for (unsigned sp = 0; __hip_atomic_load(cd, __ATOMIC_RELAXED, __HIP_MEMORY_SCOPE_AGENT) < 64u && sp < (1u << 24); ++sp) __builtin_amdgcn_s_sleep(2);
        __builtin_amdgcn_fence(__ATOMIC_ACQUIRE, "agent"); asm volatile("s_waitcnt vmcnt(0)" ::: "memory"); }
    __syncthreads();
#ifdef PROBE_ITEM
    int nitem_ = 0;
#endif
    int nd2 = (int)((blockIdx.x >> 3) % 3);
    for (int pass = 0; pass < 8; ++pass) {
        const int x = (xcc + pass) & 7;
        int* h = a.qhead + 64 + 16 * x; int it = next_item(h, lds);
        while (it < 256) {
            QPREFETCH(h);
            const int qbi = it >> 1, bg = 2 * x + (it & 1);
#ifdef PROBE_ITEM
            unsigned long long* ist = (blockIdx.x == PROBE_BLOCK && nitem_ == PROBE_ITEM) ? (unsigned long long*)(a.qhead - CT_Q + 2048) + 16 : nullptr; ++nitem_;
            cmpsel_item((bg << 7) | qbi, a.nq, a.kcmp, a.vcmp, a.kv6 + 2 * S128, a.kv6 + 3 * S128, a.kv6 + 4 * S128, a.kv6 + 5 * S128, a.ng, a.ypart, a.ynsa, lds, ist);
#else
            cmpsel_item((bg << 7) | qbi, a.nq, a.kcmp, a.vcmp, a.kv6 + 2 * S128, a.kv6 + 3 * S128, a.kv6 + 4 * S128, a.kv6 + 5 * S128, a.ng, a.ypart, a.ynsa, lds);
#endif
            if ((++nd2 % 3) == 0) (void)conv_chunk(a, lds);
            QADVANCE(it, lds);
        }
    }
    while (conv_chunk(a, lds)) { }
}
typedef float f32x4v __attribute__((ext_vector_type(4)));
__device__ __forceinline__ void router_phase(const float* U, const f32x2* stats, const float* g1, const float* b1, const float* wr, const float* br, f32x2* MR, bf16_t* H1B,
                                             int* cnt, int* list, float* topw, int* tope, int* spos, LAS unsigned char* lds, int vcu, int G) {
    const int tid = threadIdx.x, lane = tid & 63, wave = __builtin_amdgcn_readfirstlane(tid >> 6), r = lane & 15, kq = lane >> 4;
    LAS float* W = (LAS float*)lds;
    LAS float* stg = (LAS float*)(lds + 131072 + wave * 2048);
    LAS int* stB = (LAS int*)(lds + 147456);
    LAS float* G1L = (LAS float*)(lds + 151552); LAS float* B1L = (LAS float*)(lds + 155904);
    LAS int* hist = (LAS int*)(lds + 155648); LAS int* basee = hist + 32;
    if (tid < 32) hist[tid] = 0;
    if (tid < 256) { *(LAS f32x4*)(G1L + tid * 4) = *(const f32x4*)(g1 + tid * 4); *(LAS f32x4*)(B1L + tid * 4) = *(const f32x4*)(b1 + tid * 4); }
    for (int i = tid; i < 1024 * 8; i += NTHREADS) { const int k = i >> 3, c4 = (i & 7) * 4; const f32x4 v = *(const f32x4*)(wr + k * 32 + c4);
        *(LAS f32x4*)(W + k * 32 + (c4 ^ (((k >> 3) & 1) << 4))) = v; }
    __syncthreads();
    const int sw = (kq & 1) << 4;
    for (int gbase = 0; gbase < NTOK / 16; gbase += 2 * G * NWAVES) {
    if (tid < 32) hist[tid] = 0;
    __syncthreads();
    int gi = 0;
    for (int grp = gbase + vcu * NWAVES + wave; grp < NTOK / 16 && gi < 2; grp += G * NWAVES, ++gi) {
        const int tok = (NTOK / 16 - 1 - grp) * 16 + r; const char* up = (const char*)U + (size_t)tok * H1_PITCH_B + 16 * kq;
        float s = 0.f, s2 = 0.f;
        { const f32x4 q0 = *(const f32x4*)(stats + (size_t)tok * 16 + 4 * kq), q1 = *(const f32x4*)(stats + (size_t)tok * 16 + 4 * kq + 2);
          s = (q0[0] + q0[2]) + (q1[0] + q1[2]); s2 = (q0[1] + q0[3]) + (q1[1] + q1[3]); }
        s += __shfl_xor(s, 16); s += __shfl_xor(s, 32); s2 += __shfl_xor(s2, 16); s2 += __shfl_xor(s2, 32);
        const float mean = s * (1.f / DM); const float var = fmaxf(s2 * (1.f / DM) - mean * mean, 0.f); const float rstd = 1.f / sqrtf(var + LN_EPS);
        f32x4v acc0 = {0.f, 0.f, 0.f, 0.f}, acc1 = {0.f, 0.f, 0.f, 0.f};
        u32x4 ra[4];
#pragma unroll
        for (int i = 0; i < 4; ++i) ra[i] = *(const u32x4*)(up + 64 * i);
#pragma unroll 1
        for (int s4 = 0; s4 < 32; s4 += 4) {
#pragma unroll
        for (int u4 = 0; u4 < 4; ++u4) {
            const int st = s4 + u4, k0 = 32 * st + 8 * kq;
            const u32x4 raw = ra[u4];
            { const int sn = (s4 < 28) ? st + 4 : st;
              ra[u4] = *(const u32x4*)(up + 64 * sn); }
            const f32x4 a = {__uint_as_float(raw.x << 16), __uint_as_float(raw.x & 0xffff0000u), __uint_as_float(raw.y << 16), __uint_as_float(raw.y & 0xffff0000u)},
                        b = {__uint_as_float(raw.z << 16), __uint_as_float(raw.z & 0xffff0000u), __uint_as_float(raw.w << 16), __uint_as_float(raw.w & 0xffff0000u)};
            const f32x4 ga = *(const LAS f32x4*)(G1L + k0), gb = *(const LAS f32x4*)(G1L + k0 + 4), ba = *(const LAS f32x4*)(B1L + k0), bb = *(const LAS f32x4*)(B1L + k0 + 4);
            const f32x4 ha = (a - mean) * rstd * ga + ba, hb = (b - mean) * rstd * gb + bb;
            u32x4 w; w.x = pk2(ha[0], ha[1]); w.y = pk2(ha[2], ha[3]); w.z = pk2(hb[0], hb[1]); w.w = pk2(hb[2], hb[3]);
            *(u32x4*)((char*)H1B + (size_t)tok * H1_PITCH_B + (size_t)k0 * 2) = w;
            const LAS float* wp = W + k0 * 32;
#pragma unroll
            for (int j = 0; j < 8; ++j) { const float hv = (j < 4) ? ha[j & 3] : hb[j & 3];
                const float w0 = wp[j * 32 + (r ^ sw)], w1 = wp[j * 32 + ((r + 16) ^ sw)];
                acc0 = __builtin_amdgcn_mfma_f32_16x16x4f32(hv, w0, acc0, 0, 0, 0); acc1 = __builtin_amdgcn_mfma_f32_16x16x4f32(hv, w1, acc1, 0, 0, 0); }
        }
        }
        const float bi0 = br[r], bi1 = br[16 + r];
#pragma unroll
        for (int q = 0; q < 4; ++q) { stg[(4 * kq + q) * 32 + r] = acc0[q] + bi0; stg[(4 * kq + q) * 32 + 16 + r] = acc1[q] + bi1; }
        asm volatile("s_waitcnt lgkmcnt(0)" ::: "memory");
        if (lane < 16) {
            float v[32];
#pragma unroll
            for (int e = 0; e < 32; e += 4) { const f32x4 x = *(const LAS f32x4*)(stg + lane * 32 + e); v[e] = x[0]; v[e + 1] = x[1]; v[e + 2] = x[2]; v[e + 3] = x[3]; }
            float tv[4]; int ti[4];
#pragma unroll
            for (int k = 0; k < 4; ++k) { float bv = -INFINITY; int bi = 0;
#pragma unroll
                for (int e = 0; e < 32; ++e) { if (v[e] > bv) { bv = v[e]; bi = e; } }
                tv[k] = bv; ti[k] = bi;
#pragma unroll
                for (int e = 0; e < 32; ++e) if (e == bi) v[e] = -INFINITY; }
            const float e1 = expf(tv[1] - tv[0]), e2 = expf(tv[2] - tv[0]), e3 = expf(tv[3] - tv[0]); const float inv = 1.f / (1.f + e1 + e2 + e3);
            const float wv[4] = {inv, e1 * inv, e2 * inv, e3 * inv};
            const int tk = (NTOK / 16 - 1 - grp) * 16 + lane;
#pragma unroll
            for (int k = 0; k < 4; ++k) { const int slot = tk * 4 + k; topw[slot] = wv[k]; tope[slot] = ti[k];
                const int lp = __hip_atomic_fetch_add(&hist[ti[k]], 1, __ATOMIC_RELAXED, __HIP_MEMORY_SCOPE_WORKGROUP);
                const int si = (gi * NWAVES + wave) * 64 + lane * 4 + k; stB[si] = (ti[k] << 20) | lp; }
        }
        asm volatile("s_waitcnt lgkmcnt(0)" ::: "memory");
    }
    __syncthreads();
    if (tid < 32) basee[tid] = atomicAdd(&cnt[tid], hist[tid]);
    __syncthreads();
    for (int si = tid; si < 1024; si += NTHREADS) { const int g2 = si >> 9, w2 = (si >> 6) & 7; const int grp = gbase + vcu * NWAVES + w2 + g2 * G * NWAVES;
        if (grp < NTOK / 16) { const int slot = ((NTOK / 16 - 1 - grp) * 16 + ((si >> 2) & 15)) * 4 + (si & 3), pk = stB[si], e = pk >> 20, pos = basee[e] + (pk & 0xfffff); list[(size_t)e * NTOK + pos] = slot; spos[slot] = pos; } }
    __syncthreads();
    }
}
#include <hip/hip_cooperative_groups.h>
namespace cg = cooperative_groups;
struct MegaArgs {
    const float* pe_k; const float* w1_k; const float* w2_k; const float* pe_v; const float* w1_v; const float* w2_v;
    const float* x; const float* w_in; const float* w_sb; const float* w_nsa; const float* w_out; const float* w_gu; const float* w_dn;
    const float* b_gu; const float* b_dn; const float* ln1g; const float* ln1b; const float* w_r; const float* b_r; const float* ln2g; const float* ln2b;
    float* out; unsigned char* ws; int ph_lo, ph_hi;
};
struct InProjOrder : pg8::StaticOrder {
    __device__ __forceinline__ bool next(int i, pg8::Unit& u) const { if (!pg8::StaticOrder::next(i, u)) return false; u.pn = (u.pn + 11) % 19; return true; }
};
__device__ __forceinline__ void combine_phase(const MegaArgs& A, LAS unsigned char* lds, int round, bool last, int vcu, int G, float oscale) {
    unsigned char* ws = A.ws; float* Y = A.out; const bf16_t* outr0 = (const bf16_t*)(ws + WS_OUTR0); const bf16_t* outr1 = (const bf16_t*)(ws + WS_OUTR1);
    const int* tope = (const int*)(ws + WS_TOPE); const int* spos = (const int*)(ws + WS_SPOS); const float* topw = (const float*)(ws + WS_TOPW);
    const LAS int* tstart = (const LAS int*)(lds + LDS_MISC);
    const int tid = threadIdx.x, lane = tid & 63, wave = tid >> 6;
    constexpr int TU = 4;
    LAS float* G2A = (LAS float*)lds; LAS float* B2A = G2A + DM;
    __syncthreads();
    { int tl = threadIdx.x; asm volatile("" : "+v"(tl));
      for (int i = tl; i < DM; i += NTHREADS) { G2A[i] = A.ln2g[i]; B2A[i] = A.ln2b[i]; } }
    __syncthreads();
    for (int tok0 = (vcu * NWAVES + wave) * TU; tok0 < NTOK; tok0 += G * NWAVES * TU) {
        int4 ev[TU], pv_[TU]; f32x4 wv[TU];
#pragma unroll
        for (int u = 0; u < TU; ++u) { const int tok = tok0 + u; ev[u] = *(const int4*)(tope + tok * 4); pv_[u] = *(const int4*)(spos + tok * 4); wv[u] = *(const f32x4*)(topw + tok * 4); }
        f32x4 v[TU][2][2];
#pragma unroll
        for (int u = 0; u < TU; ++u) { const char* yr = (const char*)Y + (size_t)(tok0 + u) * H1_PITCH_B + lane * 16;
#pragma unroll
            for (int j = 0; j < 2; ++j) { const u32x4 q = *(const u32x4*)(yr + 1024 * j);
                v[u][j][0] = (f32x4){bflo(q.x), bfhi(q.x), bflo(q.y), bfhi(q.y)} * ALPHA; v[u][j][1] = (f32x4){bflo(q.z), bfhi(q.z), bflo(q.w), bfhi(q.w)} * ALPHA; } }
        bool any[TU];
#pragma unroll
        for (int u = 0; u < TU; ++u) { any[u] = false;
            const int es[4] = {ev[u].x, ev[u].y, ev[u].z, ev[u].w}; const int ps[4] = {pv_[u].x, pv_[u].y, pv_[u].z, pv_[u].w};
#pragma unroll
            for (int k = 0; k < 4; ++k) {
                const int tile = tstart[es[k]] + (ps[k] >> 8);
                { any[u] = true; const float w = wv[u][k]; const int rnd = tile >= TR ? 1 : 0; const bf16_t* rp = (rnd ? outr1 : outr0) + ((size_t)(tile - rnd * TR) * 256 + (ps[k] & 255)) * DM + lane * 8;
#pragma unroll
                    for (int j = 0; j < 2; ++j) { const u32x4 q = *(const u32x4*)(rp + 512 * j);
                        v[u][j][0][0] += w * bflo(q.x); v[u][j][0][1] += w * bfhi(q.x); v[u][j][0][2] += w * bflo(q.y); v[u][j][0][3] += w * bfhi(q.y);
                        v[u][j][1][0] += w * bflo(q.z); v[u][j][1][1] += w * bfhi(q.z); v[u][j][1][2] += w * bflo(q.w); v[u][j][1][3] += w * bfhi(q.w); } }
            }
            if (u == 1) asm volatile("" ::: "memory");
        }
#pragma unroll
        for (int u = 0; u < TU; ++u) { float* yr = Y + (size_t)(tok0 + u) * DM + lane * 8;
            if (last) {
                float s = 0.f;
#pragma unroll
                for (int j = 0; j < 2; ++j) s += (v[u][j][0][0] + v[u][j][0][1]) + (v[u][j][0][2] + v[u][j][0][3]) + (v[u][j][1][0] + v[u][j][1][1]) + (v[u][j][1][2] + v[u][j][1][3]);
                const float mean = wave_sum(s) * (1.f / DM); float s2 = 0.f;
#pragma unroll
                for (int j = 0; j < 2; ++j) { v[u][j][0] = v[u][j][0] - mean; v[u][j][1] = v[u][j][1] - mean;
                    s2 += (v[u][j][0][0] * v[u][j][0][0] + v[u][j][0][1] * v[u][j][0][1]) + (v[u][j][0][2] * v[u][j][0][2] + v[u][j][0][3] * v[u][j][0][3]) + (v[u][j][1][0] * v[u][j][1][0] + v[u][j][1][1] * v[u][j][1][1]) + (v[u][j][1][2] * v[u][j][1][2] + v[u][j][1][3] * v[u][j][1][3]); }
                const float rstd = 1.f / sqrtf(wave_sum(s2) * (1.f / DM) + LN_EPS);
#pragma unroll
                for (int j = 0; j < 2; ++j) { const int c = lane * 8 + 512 * j;
                    *(f32x4*)(yr + 512 * j) = (v[u][j][0] * rstd * *(const LAS f32x4*)(G2A + c) + *(const LAS f32x4*)(B2A + c)) * oscale;
                    *(f32x4*)(yr + 512 * j + 4) = (v[u][j][1] * rstd * *(const LAS f32x4*)(G2A + c + 4) + *(const LAS f32x4*)(B2A + c + 4)) * oscale; }
            } else if (any[u]) {
#pragma unroll
                for (int j = 0; j < 2; ++j) { *(f32x4*)(yr + 512 * j) = v[u][j][0]; *(f32x4*)(yr + 512 * j + 4) = v[u][j][1]; }
            }
        }
    }
}
#ifndef REP_ROUTER
#define REP_ROUTER 1
#endif
#ifndef REP_PREP
#define REP_PREP 1
#endif
#ifndef REP_INPROJ
#define REP_INPROJ 1
#endif
#ifndef REP_MERGE
#define REP_MERGE 1
#endif
#ifndef REP_OUT
#define REP_OUT 1
#endif
#ifndef REP_GU
#define REP_GU 1
#endif
#ifndef REP_DN
#define REP_DN 1
#endif
#ifndef REP_ATT1
#define REP_ATT1 1
#endif
#ifndef REP_ATT2
#define REP_ATT2 1
#endif
enum { PH_PREP = 0, PH_INPROJ, PH_ATT1, PH_ATT2, PH_MERGE, PH_OUT, PH_ROUTER, PH_GU0, PH_DN0, PH_GU1, PH_DN1, PH_FIN, PH_N };
__global__ void __launch_bounds__(NTHREADS, 2) k_mega(MegaArgs A) {
    extern __shared__ __attribute__((aligned(16))) unsigned char lds_[];
    LAS unsigned char* lds = (LAS unsigned char*)lds_;
    cg::grid_group grid = cg::this_grid();
    { int* cz = (int*)(A.ws + WS_CTL); for (int i = blockIdx.x * NTHREADS + threadIdx.x; i < 8192; i += gridDim.x * NTHREADS) cz[i] = 0; }
    grid.sync();
    if (threadIdx.x < 8) ((LAS unsigned*)(lds + LDS_BYTES - 64))[threadIdx.x] = 0u;
    __syncthreads();
    XcdBarrier bar = xcd_barrier_post((unsigned*)(A.ws + WS_CTL) + CT_BAR, (volatile LAS unsigned*)(lds + LDS_BYTES - 64));
    const int G = gridDim.x, bx = blockIdx.x; const int vcu = (G % 8 == 0) ? (bx % 8) * (G / 8) + bx / 8 : bx;
    unsigned char* ws = A.ws;
    int* ctl = (int*)(ws + WS_CTL); float* ropeT = (float*)(ws + WS_ROPE);
    bf16_t* wt_gu = (bf16_t*)(ws + WS_WGU); bf16_t* wt_dn = (bf16_t*)(ws + WS_WDN); bf16_t* wt_in = (bf16_t*)(ws + WS_WIN);
    bf16_t* wt_sb = (bf16_t*)(ws + WS_WSB); bf16_t* wt_nsa = (bf16_t*)(ws + WS_WNSA); bf16_t* wt_out = (bf16_t*)(ws + WS_WOUT);
    bf16_t* xb = (bf16_t*)(ws + WS_XB); bf16_t* sbq = (bf16_t*)(ws + WS_SBQ); bf16_t* sbk = (bf16_t*)(ws + WS_SBK); bf16_t* sbv = (bf16_t*)(ws + WS_SBV);
    bf16_t* nq = (bf16_t*)(ws + WS_NQ); bf16_t* kv6 = (bf16_t*)(ws + WS_KV6); float* ng = (float*)(ws + WS_NG);
    bf16_t* ysb = (bf16_t*)(ws + WS_YSB); bf16_t* ynsa = (bf16_t*)(ws + WS_YNSA);
    bf16_t* mg = (bf16_t*)A.out; bf16_t* merged = (bf16_t*)(ws + WS_MERGED); float* u = A.out; bf16_t* h1b = (bf16_t*)A.out;
    int* list = (int*)(ws + WS_LIST); bf16_t* hid = (bf16_t*)(ws + WS_HID); bf16_t* outr0 = (bf16_t*)(ws + WS_OUTR0); bf16_t* outr1 = (bf16_t*)(ws + WS_OUTR1);
    const int lo = A.ph_lo, hi = A.ph_hi;
#define IN(k) (lo <= (k) && (k) < hi)
#ifdef PROBE_PHASE
#define STAMP(i) do { if (blockIdx.x == 0 && threadIdx.x == 0) ((unsigned long long*)(ctl + 2048))[i] = __builtin_amdgcn_s_memrealtime(); } while (0)
#else
#define STAMP(i) do { } while (0)
#endif
#define SEAM(k) do { if (IN(k) && IN((k) + 1)) { xcd_barrier(bar); } STAMP((k) + 1); } while (0)
    STAMP(0);
    if (IN(PH_PREP)) {
        PrepArgs a{A.x, A.w_in, A.w_sb, A.w_nsa, A.w_out, A.w_gu, A.w_dn, wt_in, wt_sb, wt_nsa, wt_out, wt_gu, wt_dn, xb, ng, ropeT, A.pe_k, A.w1_k, A.w2_k, A.pe_v, A.w1_v, A.w2_v, ws + WS_CMPW, (float*)(ctl + CT_C1)};
        for (int rep = 0; rep < REP_PREP; ++rep) { if (rep) grid.sync(); prep_phase(a, lds, vcu, G); }
    }
    SEAM(PH_PREP);
    if (IN(PH_INPROJ)) {
        EpiInProj E{sbq, sbk, sbv, nq, kv6, mg, ropeT, ropeT + SEQ * 32};
        pg8::Gemm g{xb, wt_in, DM, 0}; InProjOrder S; S.init(NTOK, 4864, G, bx);
        for (int rep = 0; rep < REP_INPROJ; ++rep) { if (rep) grid.sync(); pg8::gemm_phase<EpiInProj, InProjOrder, true, false>(lds, g, S, E); }
    }
    SEAM(PH_INPROJ);
    const AttnArgs AA{sbq, sbk, sbv, nq, kv6, ng, (bf16_t*)(ws + WS_KCMP), (bf16_t*)(ws + WS_VCMP), ysb, ynsa, (float*)(ws + WS_YPART),
                      (const bf16_t*)(ws + WS_CMPW + CW_WT1K), (const bf16_t*)(ws + WS_CMPW + CW_WT1V), (const bf16_t*)(ws + WS_CMPW + CW_W2TK), (const bf16_t*)(ws + WS_CMPW + CW_W2TV),
                      (const float*)(ctl + CT_C1), (const float*)(ctl + CT_C1 + 64), ctl + CT_Q, A.w_gu, A.w_dn, wt_gu, wt_dn};
    if (IN(PH_ATT1)) for (int rep = 0; rep < REP_ATT1; ++rep) { if (rep) grid.sync(); AttnArgs A1 = AA; A1.qhead = ctl + CT_Q + 256 * rep; attn_phase1(A1, lds, (int)bar.x & 7); }
    STAMP(PH_ATT1 + 1);
    if (IN(PH_ATT2)) for (int rep = 0; rep < REP_ATT2; ++rep) { if (rep) grid.sync(); AttnArgs A2 = AA; A2.qhead = ctl + CT_Q + 256 * rep; attn_phase2(A2, lds, (int)bar.x & 7); }
    SEAM(PH_ATT2);
    if (IN(PH_MERGE)) for (int rep = 0; rep < REP_MERGE; ++rep) {
        if (rep) grid.sync();
        static_assert(WS_YNSA == WS_YSB + 64 * MiB && WS_WNSA == WS_WSB + 1 * MiB, "MergeOrder needs y_nsa right after y_sb and wt_nsa right after wt_sb");
        MergeOrder S; S.init(NTOK, DM, G, bx);
        { pg8::Gemm g{ysb, wt_sb, 512, 0}; EpiMerge E{mg, merged}; pg8::gemm_phase<EpiMerge, MergeOrder, true, false>(lds, g, S, E); }
    }
    SEAM(PH_MERGE);
    if (IN(PH_OUT)) {
        EpiOut E{A.x, u, (f32x2*)(ws + WS_STATS)}; pg8::Gemm g{merged, wt_out, DM, 0}; pg8::StaticOrder S; S.init(NTOK, DM, G, bx);
        for (int rep = 0; rep < REP_OUT; ++rep) { if (rep) grid.sync(); pg8::gemm_phase<EpiOut, pg8::StaticOrder, true, false>(lds, g, S, E); }
    }
    SEAM(PH_OUT);
    if (IN(PH_ROUTER)) for (int rep = 0; rep < REP_ROUTER; ++rep) { if (rep) grid.sync(); router_phase(u, (const f32x2*)(ws + WS_STATS), A.ln1g, A.ln1b, A.w_r, A.b_r, (f32x2*)(ws + WS_MR), h1b, ctl + (rep == REP_ROUTER - 1 ? CT_CNT : 32), list, (float*)(ws + WS_TOPW), (int*)(ws + WS_TOPE), (int*)(ws + WS_SPOS), lds, vcu, G); }
    SEAM(PH_ROUTER);
    if (hi > PH_GU0) { __syncthreads(); moe_build_table(lds, ctl + CT_CNT); }
    if (IN(PH_GU0)) { EpiGateUp E{A.b_gu, hid}; pg8::Gemm g{h1b, wt_gu, DM, 0}; MoeOrder<8> S; S.init(lds, list, 0, G, bx); for (int rep = 0; rep < REP_GU; ++rep) { if (rep) grid.sync(); pg8::gemm_phase<EpiGateUp, MoeOrder<8>, true, true>(lds, g, S, E); } }
    SEAM(PH_GU0);
    if (IN(PH_DN0)) { EpiDown E{A.b_dn, outr0}; pg8::Gemm g{hid, wt_dn, DFF, 0}; MoeOrder<4> S; S.init(lds, list, 0, G, bx); for (int rep = 0; rep < REP_DN; ++rep) { if (rep) grid.sync(); pg8::gemm_phase<EpiDown, MoeOrder<4>, true, false>(lds, g, S, E); } }
    SEAM(PH_DN0);
    if (IN(PH_GU1)) {
        { EpiGateUp E{A.b_gu, hid}; pg8::Gemm g{h1b, wt_gu, DM, 0}; MoeOrder<8> S; S.init(lds, list, 1, G, bx); for (int rep = 0; rep < 1; ++rep) { if (rep) grid.sync(); pg8::gemm_phase<EpiGateUp, MoeOrder<8>, true, true>(lds, g, S, E); } }
    }
    SEAM(PH_GU1);
    if (IN(PH_DN1)) { EpiDown E{A.b_dn, outr1}; pg8::Gemm g{hid, wt_dn, DFF, 0}; MoeOrder<4> S; S.init(lds, list, 1, G, bx); for (int rep = 0; rep < 1; ++rep) { if (rep) grid.sync(); pg8::gemm_phase<EpiDown, MoeOrder<4>, true, false>(lds, g, S, E); } }
    SEAM(PH_DN1);
#ifdef PROBE_PHASE
    if (IN(PH_FIN)) combine_phase(A, lds, 1, true, vcu, G, 1.f);
    xcd_barrier(bar); STAMP(12);
    xcd_barrier(bar);
    { const unsigned long long* ts = (const unsigned long long*)(ctl + 2048); const float dt = (float)(__hip_atomic_load(ts + PROBE_END, __ATOMIC_RELAXED, __HIP_MEMORY_SCOPE_AGENT) - __hip_atomic_load(ts + PROBE_PHASE, __ATOMIC_RELAXED, __HIP_MEMORY_SCOPE_AGENT));
      const float dtq = floorf(dt / PROBE_QUANT + PROBE_QOFF) * PROBE_QUANT; const float sc = 1.f + sqrtf(dtq * PROBE_K);
      for (size_t i = (size_t)bx * NTHREADS + threadIdx.x; i < (size_t)NTOK * DM / 4; i += (size_t)G * NTHREADS) { f32x4 v = ((f32x4*)A.out)[i]; ((f32x4*)A.out)[i] = v * sc; } }
#else
    if (IN(PH_FIN)) combine_phase(A, lds, 1, true, vcu, G, 1.f);
#endif
#undef IN
#undef SEAM
}

extern "C" void kernel_launch(void* const* d_in, const int* in_sizes, int n_in, void* d_out, int out_size, void* d_ws, size_t ws_size, hipStream_t stream) {
    const float* x = (const float*)d_in[0]; const float* w_in = (const float*)d_in[1];
    const float* pe_k = (const float*)d_in[2]; const float* w1_k = (const float*)d_in[3]; const float* w2_k = (const float*)d_in[4];
    const float* pe_v = (const float*)d_in[5]; const float* w1_v = (const float*)d_in[6]; const float* w2_v = (const float*)d_in[7];
    char* ws = (char*)d_ws; float* out = (float*)d_out;
    static int grid = 0;
    if (grid == 0) {
        int dev = 0, cus = 0, per_cu = 0; (void)hipGetDevice(&dev); (void)hipDeviceGetAttribute(&cus, hipDeviceAttributeMultiprocessorCount, dev);
        (void)hipFuncSetAttribute((const void*)k_mega, hipFuncAttributeMaxDynamicSharedMemorySize, LDS_BYTES);
        (void)hipOccupancyMaxActiveBlocksPerMultiprocessor(&per_cu, (const void*)k_mega, NTHREADS, LDS_BYTES);
        if (per_cu < 1) per_cu = 1;
        grid = (cus > 0 ? cus : 256) * 1;
        (void)hipGetLastError();
    }
    MegaArgs A{};
    A.pe_k = pe_k; A.w1_k = w1_k; A.w2_k = w2_k; A.pe_v = pe_v; A.w1_v = w1_v; A.w2_v = w2_v;
    A.x = x; A.w_in = w_in; A.w_sb = (const float*)d_in[8]; A.w_nsa = (const float*)d_in[9]; A.w_out = (const float*)d_in[10];
    A.ln1g = (const float*)d_in[11]; A.ln1b = (const float*)d_in[12]; A.w_r = (const float*)d_in[13]; A.b_r = (const float*)d_in[14];
    A.w_gu = (const float*)d_in[15]; A.b_gu = (const float*)d_in[16]; A.w_dn = (const float*)d_in[17]; A.b_dn = (const float*)d_in[18];
    A.ln2g = (const float*)d_in[19]; A.ln2b = (const float*)d_in[20]; A.out = out; A.ws = (unsigned char*)d_ws;
    int* ctl = (int*)(ws + WS_CTL);
    bf16_t* sbq = (bf16_t*)(ws + WS_SBQ); bf16_t* sbk = (bf16_t*)(ws + WS_SBK); bf16_t* sbv = (bf16_t*)(ws + WS_SBV);
    bf16_t* nq = (bf16_t*)(ws + WS_NQ); bf16_t* kv6 = (bf16_t*)(ws + WS_KV6); float* ng = (float*)(ws + WS_NG);
    bf16_t* kcmp = (bf16_t*)(ws + WS_KCMP); bf16_t* vcmp = (bf16_t*)(ws + WS_VCMP);
    bf16_t* ysb = (bf16_t*)(ws + WS_YSB); bf16_t* ynsa = (bf16_t*)(ws + WS_YNSA);
    float* u = (float*)(ws + WS_U); bf16_t* h1b = (bf16_t*)(ws + WS_H1B);
    int* tope = (int*)(ws + WS_TOPE); float* topw = (float*)(ws + WS_TOPW); int* spos = (int*)(ws + WS_SPOS); int* list = (int*)(ws + WS_LIST);
    const size_t S128 = (size_t)NTOK * 128;
    auto launch = [&](int lo, int hi) { A.ph_lo = lo; A.ph_hi = hi; void* args[] = {&A};
        (void)hipLaunchCooperativeKernel((const void*)k_mega, dim3(grid), dim3(NTHREADS), args, LDS_BYTES, stream); };
    launch(PH_PREP, PH_N);
}
```
